# Optimizing an MI355X kernel written in HIP

```python
import math
import jax
import jax.numpy as jnp
from jax import lax
import numpy as np

D_MODEL = 1024
BATCH = 1
SEQ = 16384
DEPTH = 2
DEC_BATCH = 128
DEC_SEQ = 4
PAST_LEN = 16384
PAGE_SIZE = 128

HEAD_DIM = 64
ROT_DIM = HEAD_DIM // 4
ROPE_THETA = 500000.0
NORM_EPS = 1e-6
A_Q_HEADS = 4
A_KV_HEADS = 2
A_WINDOW = 128
C_Q_HEADS = 4
C_KV_HEADS = 2
C_PATTERNS = ((128, 1), (512, 4), (2048, 16))
C_MAX_SPAN = 2048
B_HEADS = 8
B_HEADDIM = 64
B_INNER = B_HEADS * B_HEADDIM
B_GROUPS = 2
B_STATE = 128
CONV_K = 4
CONV_DIM = B_INNER + 2 * B_GROUPS * B_STATE
SSD_CHUNK = 128
A_WIDTH = A_Q_HEADS * HEAD_DIM
A_KV_WIDTH = A_KV_HEADS * HEAD_DIM
C_WIDTH = C_Q_HEADS * HEAD_DIM
C_KV_WIDTH = C_KV_HEADS * HEAD_DIM
MIX_WIDTH = A_WIDTH + B_INNER + C_WIDTH
IN_SIZES = (A_WIDTH, A_KV_WIDTH, A_KV_WIDTH, C_WIDTH, C_KV_WIDTH, C_KV_WIDTH, B_INNER, CONV_DIM, B_HEADS)
N_IN = sum(IN_SIZES)
D_FF = -(-(8 * D_MODEL) // (3 * 256)) * 256
BAND_BLOCK = 128

kernel_name = 'hymba_swa_ssd_dilated_decoder'


def _rmsnorm(x, g):
    xf = x.astype(jnp.float32)
    y = xf * lax.rsqrt(jnp.mean(xf * xf, axis=-1, keepdims=True) + NORM_EPS)
    return (y * g.astype(jnp.float32)).astype(x.dtype)


def _rope(x, pos):
    half = ROT_DIM // 2
    inv = ROPE_THETA ** (-(jnp.arange(half, dtype=jnp.float32) * 2.0 / ROT_DIM))
    ang = pos.astype(jnp.float32)[:, None] * inv[None, :]
    cos = jnp.cos(ang)[None, :, None, :]
    sin = jnp.sin(ang)[None, :, None, :]
    xf = x.astype(jnp.float32)
    x1, x2 = xf[..., :half], xf[..., half:ROT_DIM]
    return jnp.concatenate([x1 * cos - x2 * sin, x2 * cos + x1 * sin, xf[..., ROT_DIM:]], axis=-1).astype(x.dtype)


def _masked_softmax(s, valid, sinks=None):
    s = jnp.where(valid, s, -jnp.inf)
    m = jnp.max(s, axis=-1, keepdims=True)
    if sinks is not None:
        m = jnp.maximum(m, sinks)
    e = jnp.exp(s - m)
    den = jnp.sum(e, axis=-1, keepdims=True)
    if sinks is not None:
        den = den + jnp.exp(sinks - m)
    return e / den, (m + jnp.log(den))[..., 0]


def _banded_attention(q, k, v, max_dist, sinks=None):
    b, L, hq, hd = q.shape
    hkv = k.shape[2]
    rep = hq // hkv
    blk = BAND_BLOCK
    nb = -(-L // blk)
    pad = nb * blk - L
    qp = jnp.pad(q, ((0, 0), (0, pad), (0, 0), (0, 0))).reshape(b, nb, blk, hkv, rep, hd)
    kp = jnp.pad(k, ((0, 0), (blk, pad), (0, 0), (0, 0))).reshape(b, nb + 1, blk, hkv, hd)
    vp = jnp.pad(v, ((0, 0), (blk, pad), (0, 0), (0, 0))).reshape(b, nb + 1, blk, hkv, hd)
    kw = jnp.concatenate([kp[:, :-1], kp[:, 1:]], axis=2)
    vw = jnp.concatenate([vp[:, :-1], vp[:, 1:]], axis=2)
    s = jnp.einsum('bnqgrd,bnkgd->bngrqk', qp, kw, preferred_element_type=jnp.float32) * (hd ** -0.5)
    qi = jnp.arange(blk)[:, None] + blk
    ki = jnp.arange(2 * blk)[None, :]
    dist = qi - ki
    kpos = jnp.arange(nb)[:, None, None] * blk + ki[None] - blk
    valid = (dist >= 0) & (dist <= max_dist) & (kpos >= 0)
    sk = None if sinks is None else sinks.astype(jnp.float32).reshape(hkv, rep, 1, 1)
    p, lse = _masked_softmax(s, valid[:, None, None], sk)
    o = jnp.einsum('bngrqk,bnkgd->bnqgrd', p.astype(v.dtype), vw)
    o = o.reshape(b, nb * blk, hq, hd)[:, :L]
    lse = lse.transpose(0, 1, 4, 2, 3).reshape(b, nb * blk, hq)[:, :L]
    return o, lse


def _merge_by_denominator(outs, lses):
    w = jax.nn.softmax(jnp.stack(lses, axis=0), axis=0)
    return jnp.einsum('pblh,pblhd->blhd', w.astype(outs[0].dtype), jnp.stack(outs, axis=0))


def _dilated_prompt(q, k, v):
    b, L, hq, hd = q.shape
    outs, lses = [], []
    for w, d in C_PATTERNS:
        def fold(t):
            h = t.shape[2]
            return t.reshape(b, L // d, d, h, hd).transpose(0, 2, 1, 3, 4).reshape(b * d, L // d, h, hd)
        o, lse = _banded_attention(fold(q), fold(k), fold(v), w // d)
        outs.append(o.reshape(b, d, L // d, hq, hd).transpose(0, 2, 1, 3, 4).reshape(b, L, hq, hd))
        lses.append(lse.reshape(b, d, L // d, hq).transpose(0, 2, 1, 3).reshape(b, L, hq))
    return _merge_by_denominator(outs, lses)


def _dilated_sample(q, kcat, vcat):
    b, T, hq, hd = q.shape
    hkv = kcat.shape[2]
    rep = hq // hkv
    buf = kcat.shape[1] - T
    qg = q.reshape(b, T, hkv, rep, hd)
    t = jnp.arange(T)
    outs, lses = [], []
    for w, d in C_PATTERNS:
        idx = buf + t[:, None] - d * jnp.arange(w // d + 1)[None, :]
        valid = idx >= 0
        idx = jnp.maximum(idx, 0)
        kg = kcat[:, idx]
        vg = vcat[:, idx]
        s = jnp.einsum('btgrd,btkgd->bgrtk', qg, kg, preferred_element_type=jnp.float32) * (hd ** -0.5)
        p, lse = _masked_softmax(s, valid, None)
        o = jnp.einsum('bgrtk,btkgd->btgrd', p.astype(vg.dtype), vg)
        outs.append(o.reshape(b, T, hq, hd))
        lses.append(lse.transpose(0, 3, 1, 2).reshape(b, T, hq))
    return _merge_by_denominator(outs, lses)


def _window_sample(q, kcat, vcat, sinks):
    b, T, hq, hd = q.shape
    hkv = kcat.shape[2]
    rep = hq // hkv
    buf = kcat.shape[1] - T
    qg = q.reshape(b, T, hkv, rep, hd)
    s = jnp.einsum('btgrd,bkgd->bgrtk', qg, kcat, preferred_element_type=jnp.float32) * (hd ** -0.5)
    dist = (buf + jnp.arange(T))[:, None] - jnp.arange(buf + T)[None, :]
    valid = (dist >= 0) & (dist < A_WINDOW)
    p, _ = _masked_softmax(s, valid, sinks.astype(jnp.float32).reshape(hkv, rep, 1, 1))
    o = jnp.einsum('bgrtk,bkgd->btgrd', p.astype(vcat.dtype), vcat)
    return o.reshape(b, T, hq, hd)


def _causal_conv(xbc, prefix, w, bias):
    L = xbc.shape[1]
    xp = jnp.concatenate([prefix.astype(xbc.dtype), xbc], axis=1)
    out = bias + sum(xp[:, j:j + L] * w[j] for j in range(CONV_K))
    return jax.nn.silu(out), xp[:, -(CONV_K - 1):]


def _ssd(x, a, bm, cm, h0):
    b, L, H, P = x.shape
    G, N = bm.shape[2], bm.shape[3]
    rep = H // G
    T = math.gcd(L, SSD_CHUNK)
    nc = L // T
    f32 = jnp.float32
    xc = x.astype(f32).reshape(b, nc, T, G, rep, P)
    ac = a.astype(f32).reshape(b, nc, T, G, rep)
    bc = bm.astype(f32).reshape(b, nc, T, G, N)
    cc = cm.astype(f32).reshape(b, nc, T, G, N)
    acum = jnp.cumsum(ac, axis=2)
    seg = acum[:, :, :, None] - acum[:, :, None, :]
    causal = jnp.tril(jnp.ones((T, T), dtype=bool))[:, :, None, None]
    lmat = jnp.exp(jnp.where(causal, seg, -jnp.inf))
    cb = jnp.einsum('bclgn,bcsgn->bclsg', cc, bc)
    y_diag = jnp.einsum('bclsgr,bcsgrp->bclgrp', cb[..., None] * lmat, xc)
    decay_to_end = jnp.exp(acum[:, :, -1:] - acum)
    chunk_states = jnp.einsum('bcsgn,bcsgrp->bcgrpn', bc, xc * decay_to_end[..., None])
    chunk_decay = jnp.exp(acum[:, :, -1])

    def step(h, inp):
        s_c, dec = inp
        return h * dec[..., None, None] + s_c, h

    h_final, h_in = lax.scan(step, h0.astype(f32).reshape(b, G, rep, P, N),
                             (jnp.moveaxis(chunk_states, 1, 0), jnp.moveaxis(chunk_decay, 1, 0)))
    h_in = jnp.moveaxis(h_in, 0, 1)
    y_off = jnp.einsum('bclgn,bcgrpn->bclgrp', cc, h_in) * jnp.exp(acum)[..., None]
    return (y_diag + y_off).reshape(b, L, H, P), h_final.reshape(b, H, P, N)


def _mamba(xbc_act, z, dt_raw, h0, lp):
    b, L, _ = xbc_act.shape
    gn = B_GROUPS * B_STATE
    xs = xbc_act[..., :B_INNER].reshape(b, L, B_HEADS, B_HEADDIM)
    bm = xbc_act[..., B_INNER:B_INNER + gn].reshape(b, L, B_GROUPS, B_STATE)
    cm = xbc_act[..., B_INNER + gn:].reshape(b, L, B_GROUPS, B_STATE)
    dt = jax.nn.softplus(dt_raw.astype(jnp.float32) + lp['dt_bias'].astype(jnp.float32))
    a = -jnp.exp(lp['a_log'].astype(jnp.float32)) * dt
    y, h = _ssd(xs.astype(jnp.float32) * dt[..., None], a, bm, cm, h0)
    y = y + xs.astype(jnp.float32) * lp['d_skip'].astype(jnp.float32)[:, None]
    y = y.reshape(b, L, B_INNER) * jax.nn.silu(z.astype(jnp.float32))
    return _rmsnorm(y, lp['ssm_norm']), h


def _in_proj(h, pos, lp):
    b, L, _ = h.shape
    proj = _rmsnorm(h, lp['norm1']) @ lp['w_in']
    parts = []
    off = 0
    for sz in IN_SIZES:
        parts.append(proj[..., off:off + sz])
        off += sz
    aq, ak, av, cq, ck, cv, z, xbc, dt = parts

    def heads(t):
        return t.reshape(b, L, -1, HEAD_DIM)

    aq = _rope(_rmsnorm(heads(aq), lp['a_qn']), pos)
    ak = _rope(_rmsnorm(heads(ak), lp['a_kn']), pos)
    cq = _rope(_rmsnorm(heads(cq), lp['c_qn']), pos)
    ck = _rope(_rmsnorm(heads(ck), lp['c_kn']), pos)
    return aq, ak, heads(av), cq, ck, heads(cv), z, xbc, dt


def _out_ffn(h, a_o, m_o, c_o, lp):
    b, L, _ = h.shape
    mix = jnp.concatenate([a_o.reshape(b, L, A_WIDTH).astype(h.dtype), m_o.astype(h.dtype),
                           c_o.reshape(b, L, C_WIDTH).astype(h.dtype)], axis=-1)
    h = h + mix @ lp['w_out']
    u = _rmsnorm(h, lp['norm2'])
    return h + (jax.nn.silu(u @ lp['w_gate']) * (u @ lp['w_up'])) @ lp['w_down']


def _layer_prompt(h, lp):
    b, L, _ = h.shape
    pos = jnp.arange(L)
    aq, ak, av, cq, ck, cv, z, xbc, dt = _in_proj(h, pos, lp)
    a_o, _ = _banded_attention(aq, ak, av, A_WINDOW - 1, lp['a_sinks'])
    c_o = _dilated_prompt(cq, ck, cv)
    xbc_act, conv_state = _causal_conv(xbc, jnp.zeros((b, CONV_K - 1, CONV_DIM), xbc.dtype), lp['conv_w'], lp['conv_b'])
    m_o, ssm_state = _mamba(xbc_act, z, dt, jnp.zeros((b, B_HEADS, B_HEADDIM, B_STATE), jnp.float32), lp)
    h = _out_ffn(h, a_o, m_o, c_o, lp)
    wa = min(A_WINDOW, L)
    wc = min(C_MAX_SPAN, L)
    return h, (ak[:, L - wa:], av[:, L - wa:], ck[:, L - wc:], cv[:, L - wc:], ssm_state, conv_state)


def _layer_sample(h, c_ak, c_av, c_ck, c_cv, s_ssm, s_conv, lp):
    b, T, _ = h.shape
    pos = PAST_LEN + jnp.arange(T)
    aq, ak, av, cq, ck, cv, z, xbc, dt = _in_proj(h, pos, lp)
    buf_a = c_ak.shape[1]
    buf_c = c_ck.shape[1]
    ka = jnp.concatenate([c_ak.astype(ak.dtype), ak], axis=1)
    va = jnp.concatenate([c_av.astype(av.dtype), av], axis=1)
    kc = jnp.concatenate([c_ck.astype(ck.dtype), ck], axis=1)
    vc = jnp.concatenate([c_cv.astype(cv.dtype), cv], axis=1)
    a_o = _window_sample(aq, ka, va, lp['a_sinks'])
    c_o = _dilated_sample(cq, kc, vc)
    xbc_act, conv_state = _causal_conv(xbc, s_conv, lp['conv_w'], lp['conv_b'])
    m_o, ssm_state = _mamba(xbc_act, z, dt, s_ssm, lp)
    h = _out_ffn(h, a_o, m_o, c_o, lp)
    return h, (ka[:, -buf_a:], va[:, -buf_a:], kc[:, -buf_c:], vc[:, -buf_c:], ssm_state, conv_state)


def setup_inputs(seed: int = 0) -> dict:
    key = jax.random.key(seed)
    ks = iter(jax.random.split(key, 40))
    f32 = jnp.float32

    def nrm(shape, scale):
        return jax.random.normal(next(ks), shape, f32) * scale

    def gain(shape):
        return 1.0 + nrm(shape, 0.02)

    a_buf = min(A_WINDOW, PAST_LEN)
    c_buf = min(C_MAX_SPAN, PAST_LEN)
    x_prompt = nrm((BATCH, SEQ, D_MODEL), 1.0)
    x_sample = nrm((DEC_BATCH, DEC_SEQ, D_MODEL), 1.0)
    cache_a_k = nrm((DEPTH, DEC_BATCH, a_buf, A_KV_HEADS, HEAD_DIM), 1.0)
    cache_a_v = nrm((DEPTH, DEC_BATCH, a_buf, A_KV_HEADS, HEAD_DIM), 1.0)
    cache_c_k = nrm((DEPTH, DEC_BATCH, c_buf, C_KV_HEADS, HEAD_DIM), 1.0)
    cache_c_v = nrm((DEPTH, DEC_BATCH, c_buf, C_KV_HEADS, HEAD_DIM), 1.0)
    state_ssm = nrm((DEPTH, DEC_BATCH, B_HEADS, B_HEADDIM, B_STATE), 0.1)
    state_conv = nrm((DEPTH, DEC_BATCH, CONV_K - 1, CONV_DIM), 1.0)
    norm1 = gain((DEPTH, D_MODEL))
    w_in = nrm((DEPTH, D_MODEL, N_IN), D_MODEL ** -0.5)
    a_qn = gain((DEPTH, HEAD_DIM))
    a_kn = gain((DEPTH, HEAD_DIM))
    a_sinks = nrm((DEPTH, A_Q_HEADS), 0.5)
    c_qn = gain((DEPTH, HEAD_DIM))
    c_kn = gain((DEPTH, HEAD_DIM))
    conv_w = nrm((DEPTH, CONV_K, CONV_DIM), CONV_K ** -0.5)
    conv_b = nrm((DEPTH, CONV_DIM), 0.02)
    u = jax.random.uniform(next(ks), (DEPTH, B_HEADS), f32)
    dt0 = jnp.exp(u * (math.log(0.1) - math.log(0.001)) + math.log(0.001))
    dt_bias = dt0 + jnp.log(-jnp.expm1(-dt0))
    a_log = jnp.log(jax.random.uniform(next(ks), (DEPTH, B_HEADS), f32, 1.0, 16.0))
    d_skip = 1.0 + nrm((DEPTH, B_HEADS), 0.1)
    ssm_norm = gain((DEPTH, B_INNER))
    w_out = nrm((DEPTH, MIX_WIDTH, D_MODEL), MIX_WIDTH ** -0.5)
    norm2 = gain((DEPTH, D_MODEL))
    w_gate = nrm((DEPTH, D_MODEL, D_FF), D_MODEL ** -0.5)
    w_up = nrm((DEPTH, D_MODEL, D_FF), D_MODEL ** -0.5)
    w_down = nrm((DEPTH, D_FF, D_MODEL), D_FF ** -0.5)
    return {'x_prompt': x_prompt, 'x_sample': x_sample,
            'cache_a_k': cache_a_k, 'cache_a_v': cache_a_v, 'cache_c_k': cache_c_k, 'cache_c_v': cache_c_v,
            'state_ssm': state_ssm, 'state_conv': state_conv,
            'norm1': norm1, 'w_in': w_in, 'a_qn': a_qn, 'a_kn': a_kn, 'a_sinks': a_sinks,
            'c_qn': c_qn, 'c_kn': c_kn, 'conv_w': conv_w, 'conv_b': conv_b, 'dt_bias': dt_bias,
            'a_log': a_log, 'd_skip': d_skip, 'ssm_norm': ssm_norm, 'w_out': w_out, 'norm2': norm2,
            'w_gate': w_gate, 'w_up': w_up, 'w_down': w_down}


def reference(x_prompt, x_sample, cache_a_k, cache_a_v, cache_c_k, cache_c_v, state_ssm, state_conv,
              norm1, w_in, a_qn, a_kn, a_sinks, c_qn, c_kn, conv_w, conv_b, dt_bias, a_log, d_skip,
              ssm_norm, w_out, norm2, w_gate, w_up, w_down):
    hp = x_prompt
    hs = x_sample
    p_out = [[] for _ in range(6)]
    s_out = [[] for _ in range(6)]
    for l in range(DEPTH):
        lp = {'norm1': norm1[l], 'w_in': w_in[l], 'a_qn': a_qn[l], 'a_kn': a_kn[l], 'a_sinks': a_sinks[l],
              'c_qn': c_qn[l], 'c_kn': c_kn[l], 'conv_w': conv_w[l], 'conv_b': conv_b[l],
              'dt_bias': dt_bias[l], 'a_log': a_log[l], 'd_skip': d_skip[l], 'ssm_norm': ssm_norm[l],
              'w_out': w_out[l], 'norm2': norm2[l], 'w_gate': w_gate[l], 'w_up': w_up[l], 'w_down': w_down[l]}
        hp, pst = _layer_prompt(hp, lp)
        hs, sst = _layer_sample(hs, cache_a_k[l], cache_a_v[l], cache_c_k[l], cache_c_v[l],
                                state_ssm[l], state_conv[l], lp)
        for i in range(6):
            p_out[i].append(pst[i])
            s_out[i].append(sst[i])
    p_a_k, p_a_v, p_c_k, p_c_v, p_ssm, p_conv = [jnp.stack(t, axis=0) for t in p_out]
    s_a_k, s_a_v, s_c_k, s_c_v, s_ssm, s_conv = [jnp.stack(t, axis=0) for t in s_out]
    return (hp, hs, p_a_k, p_a_v, p_c_k, p_c_v, p_ssm, p_conv, s_a_k, s_a_v, s_c_k, s_c_v, s_ssm, s_conv)
```

```cpp
#include <hip/hip_runtime.h>
#include <hip/hip_bf16.h>
#include <hip/hip_cooperative_groups.h>
#include <cstdio>
namespace cg = cooperative_groups;

typedef unsigned short u16;
using bf16x8 = __attribute__((ext_vector_type(8))) short;
using f32x4 = __attribute__((ext_vector_type(4))) float;
#define DEVI __device__ __forceinline__

constexpr int DM = 1024, SEQ = 16384, NSAMP = 512, NT = SEQ + NSAMP, NB = 128;
constexpr int NINP = 2688, NIN = 2568, DFF = 2816;
constexpr float EPS = 1e-6f;
constexpr int LDS_BYTES = 73728;
#ifndef XKS
#define XKS 1024
#endif
#ifndef RSOFF
#define RSOFF 0
#endif
#ifndef OUTMASK
#define OUTMASK 0xff
#endif
#ifndef STOPAT
#define STOPAT 0
#endif
#ifndef PHM
#define PHM 0xffff
#endif

constexpr size_t OFF_Y = 0;
constexpr size_t OFF_PAK = (size_t)NT * DM;
constexpr size_t OFF_PAV = OFF_PAK + 32768;
constexpr size_t OFF_PCK = OFF_PAV + 32768;
constexpr size_t OFF_PCV = OFF_PCK + 524288;
constexpr size_t OFF_PSSM = OFF_PCV + 524288;
constexpr size_t OFF_PCONV = OFF_PSSM + 131072;
constexpr size_t OFF_SAK = OFF_PCONV + 6144;
constexpr size_t OFF_SAV = OFF_SAK + 4194304;
constexpr size_t OFF_SCK = OFF_SAV + 4194304;
constexpr size_t OFF_SCV = OFF_SCK + 67108864;
constexpr size_t OFF_SSSM = OFF_SCV + 67108864;
constexpr size_t OFF_SCONV = OFF_SSSM + 16777216;

constexpr size_t al256(size_t x) { return (x + 255) & ~(size_t)255; }
constexpr size_t WS_WIN = 0;
constexpr size_t WS_WOUT = WS_WIN + al256((size_t)2 * NINP * 1024 * 2);
constexpr size_t WS_WGU = WS_WOUT + al256((size_t)2 * 1024 * 1024 * 2);
constexpr size_t WS_WDN = WS_WGU + al256((size_t)2 * 5632 * 1024 * 2);
constexpr size_t WS_AH = WS_WDN + al256((size_t)2 * 1024 * 2816 * 2);
constexpr size_t WS_AH1 = WS_AH + al256((size_t)NT * 1024 * 2);
constexpr size_t WS_HF = WS_AH1 + al256((size_t)NT * 1024 * 2);
constexpr size_t WS_H1 = WS_HF + al256((size_t)NT * 1024 * 4);
constexpr size_t WS_QKV = WS_H1 + al256((size_t)NT * 1024 * 4);
constexpr size_t WS_Z = WS_QKV + al256((size_t)NT * 1024 * 2);
constexpr size_t WS_XBC = WS_Z + al256((size_t)NT * 512 * 2);
constexpr size_t WS_DT = WS_XBC + al256((size_t)NT * 1024 * 2);
constexpr size_t WS_G = WS_DT + al256((size_t)NT * 8 * 4);
constexpr size_t WS_MIX = WS_G + al256((size_t)NT * DFF * 2);
constexpr size_t WS_CO = WS_MIX + al256((size_t)NT * 1024 * 2);
constexpr size_t WS_LSE = WS_CO + al256((size_t)3 * SEQ * 256 * 2);
constexpr size_t WS_CS = WS_LSE + al256((size_t)3 * SEQ * 4 * 4);
constexpr size_t WS_CD = WS_CS + al256((size_t)128 * 65536 * 4);
constexpr size_t WS_HIN = WS_CD + al256((size_t)128 * 8 * 4);
constexpr size_t WS_ROPE = WS_HIN + al256((size_t)128 * 65536 * 2);
constexpr size_t WS_BAR = WS_ROPE + al256((size_t)16388 * 16 * 4);
constexpr size_t WS_END = WS_BAR + 256;

struct Params {
  const float* in[26];
  float* out;
  unsigned char* ws;
};
enum { I_XP = 0, I_XS, I_CAK, I_CAV, I_CCK, I_CCV, I_SSM, I_SCONV, I_NORM1, I_WIN, I_AQN, I_AKN, I_SINK, I_CQN, I_CKN,
       I_CONVW, I_CONVB, I_DTB, I_ALOG, I_DSKIP, I_SSMN, I_WOUT, I_NORM2, I_WGATE, I_WUP, I_WDOWN };

DEVI int opaque_tid() { int t = threadIdx.x; asm volatile("" : "+v"(t)); return t; }
DEVI u16 f2bf(float f) { unsigned u = __float_as_uint(f); u += 0x7fffu + ((u >> 16) & 1u); return (u16)(u >> 16); }
DEVI float bf2f(u16 h) { return __uint_as_float(((unsigned)h) << 16); }
DEVI unsigned pack2(float a, float b) { return (unsigned)f2bf(a) | ((unsigned)f2bf(b) << 16); }
DEVI float siluf(float x) { return x / (1.f + __expf(-x)); }
DEVI float softplusf(float x) { return x > 20.f ? x : log1pf(__expf(x)); }
DEVI float bflo(unsigned u) { return __uint_as_float(u << 16); }
DEVI float bfhi(unsigned u) { return __uint_as_float(u & 0xffff0000u); }
DEVI float sumsq8(uint4 v) {
  float s = 0.f, t;
  t = bflo(v.x); s += t * t; t = bfhi(v.x); s += t * t;
  t = bflo(v.y); s += t * t; t = bfhi(v.y); s += t * t;
  t = bflo(v.z); s += t * t; t = bfhi(v.z); s += t * t;
  t = bflo(v.w); s += t * t; t = bfhi(v.w); s += t * t;
  return s;
}
DEVI float wave_max(float v) {
#pragma unroll
  for (int o = 32; o >= 1; o >>= 1) v = fmaxf(v, __shfl_xor(v, o));
  return v;
}
DEVI float wave_sum(float v) {
#pragma unroll
  for (int o = 32; o >= 1; o >>= 1) v += __shfl_xor(v, o);
  return v;
}
DEVI f32x4 mfma16(bf16x8 a, bf16x8 b, f32x4 c) { return __builtin_amdgcn_mfma_f32_16x16x32_bf16(a, b, c, 0, 0, 0); }

enum { EPI_IN = 0, EPI_OUT = 1, EPI_GU = 2, EPI_DN = 3 };

template <int EPI>
DEVI void gemm_epilogue(const Params& P, int l, f32x4 (&acc)[4][4], float (&scv)[4][4], int row0, int col0, int wm, int wn, int fr, int fq) {
  unsigned char* ws = P.ws;
  if (EPI == EPI_IN) {
    const int cb = col0 + wn * 64;
    if (cb < 1024) {
      u16* QKV = (u16*)(ws + WS_QKV);
      const float* ROPE = (const float*)(ws + WS_ROPE);
      const int hh = cb >> 6;
      const bool isv = (hh == 6 || hh == 7 || hh == 14 || hh == 15);
      const float* gain = P.in[I_AQN];
      if (hh >= 4 && hh < 6) gain = P.in[I_AKN];
      else if (hh >= 8 && hh < 12) gain = P.in[I_CQN];
      else if (hh >= 12) gain = P.in[I_CKN];
      gain += l * 64;
      float gv[4];
#pragma unroll
      for (int ni = 0; ni < 4; ++ni) gv[ni] = isv ? 1.f : gain[ni * 16 + fr];
      const int kind = (hh == 4 || hh == 5) ? 1 : (hh == 6 || hh == 7) ? 2 : (hh == 12 || hh == 13) ? 3 : (hh >= 14) ? 4 : 0;
      const int kvh = hh & 1;
#pragma unroll
      for (int mi = 0; mi < 4; ++mi) {
#pragma unroll
        for (int r = 0; r < 4; ++r) {
          const int row = row0 + wm * 64 + mi * 16 + fq * 4 + r;
          float v[4];
#pragma unroll
          for (int ni = 0; ni < 4; ++ni) v[ni] = acc[mi][ni][r] * scv[mi][r];
          if (!isv) {
            float ss = v[0] * v[0] + v[1] * v[1] + v[2] * v[2] + v[3] * v[3];
            ss += __shfl_xor(ss, 1); ss += __shfl_xor(ss, 2); ss += __shfl_xor(ss, 4); ss += __shfl_xor(ss, 8);
            const float sc = rsqrtf(ss * (1.f / 64.f) + EPS);
#pragma unroll
            for (int ni = 0; ni < 4; ++ni) v[ni] *= sc * gv[ni];
            const int pos = row < SEQ ? row : SEQ + ((row - SEQ) & 3);
            const float partner = __shfl_xor(v[0], 8);
            const float cs = ROPE[pos * 16 + (fr & 7)], sn = ROPE[pos * 16 + 8 + (fr & 7)];
            v[0] = (fr < 8) ? (v[0] * cs - partner * sn) : (v[0] * cs + partner * sn);
          }
#pragma unroll
          for (int ni = 0; ni < 4; ++ni) QKV[(size_t)row * 1024 + cb + ni * 16 + fr] = f2bf(v[ni]);
          if (kind && (((OUTMASK >> kind) & 1))) {
            size_t base = 0;
            bool ok = false;
            if (kind <= 2) {
              if (row >= SEQ) {
                const int sb = (row - SEQ) >> 2, t = (row - SEQ) & 3;
                base = (kind == 1 ? OFF_SAK : OFF_SAV) + ((((size_t)(l * 128 + sb) * 128 + 124 + t) * 2 + kvh) * 64);
                ok = true;
              } else if (row >= SEQ - 128) {
                base = (kind == 1 ? OFF_PAK : OFF_PAV) + (((size_t)(l * 128 + (row - (SEQ - 128))) * 2 + kvh) * 64);
                ok = true;
              }
            } else {
              if (row >= SEQ) {
                const int sb = (row - SEQ) >> 2, t = (row - SEQ) & 3;
                base = (kind == 3 ? OFF_SCK : OFF_SCV) + ((((size_t)(l * 128 + sb) * 2048 + 2044 + t) * 2 + kvh) * 64);
                ok = true;
              } else if (row >= SEQ - 2048) {
                base = (kind == 3 ? OFF_PCK : OFF_PCV) + (((size_t)(l * 2048 + (row - (SEQ - 2048))) * 2 + kvh) * 64);
                ok = true;
              }
            }
            if (ok) {
#pragma unroll
              for (int ni = 0; ni < 4; ++ni) P.out[base + ni * 16 + fr] = v[ni];
            }
          }
        }
      }
    } else if (cb < 1536) {
      u16* Z = (u16*)(ws + WS_Z);
#pragma unroll
      for (int mi = 0; mi < 4; ++mi)
#pragma unroll
        for (int r = 0; r < 4; ++r) {
          const int row = row0 + wm * 64 + mi * 16 + fq * 4 + r;
#pragma unroll
          for (int ni = 0; ni < 4; ++ni) Z[(size_t)row * 512 + (cb - 1024) + ni * 16 + fr] = f2bf(acc[mi][ni][r] * scv[mi][r]);
        }
    } else if (cb < 2560) {
      u16* XBC = (u16*)(ws + WS_XBC);
#pragma unroll
      for (int mi = 0; mi < 4; ++mi)
#pragma unroll
        for (int r = 0; r < 4; ++r) {
          const int row = row0 + wm * 64 + mi * 16 + fq * 4 + r;
          size_t cbase = 0;
          bool ok = false;
          if (row >= SEQ) {
            const int sb = (row - SEQ) >> 2, t = (row - SEQ) & 3;
            if (t >= 1) { ok = true; cbase = OFF_SCONV + ((size_t)(l * 128 + sb) * 3 + (t - 1)) * 1024; }
          } else if (row >= SEQ - 3) {
            ok = true; cbase = OFF_PCONV + (size_t)(l * 3 + (row - (SEQ - 3))) * 1024;
          }
#pragma unroll
          for (int ni = 0; ni < 4; ++ni) {
            const int ch = (cb - 1536) + ni * 16 + fr;
            const float xv = acc[mi][ni][r] * scv[mi][r];
            XBC[(size_t)row * 1024 + ch] = f2bf(xv);
            if (ok && (OUTMASK & 1)) P.out[cbase + ch] = xv;
          }
        }
    } else if (cb == 2560) {
      float* DT = (float*)(ws + WS_DT);
      if (fr < 8) {
#pragma unroll
        for (int mi = 0; mi < 4; ++mi)
#pragma unroll
          for (int r = 0; r < 4; ++r) {
            const int row = row0 + wm * 64 + mi * 16 + fq * 4 + r;
            DT[(size_t)row * 8 + fr] = acc[mi][0][r] * scv[mi][r];
          }
      }
    }
  } else if (EPI == EPI_OUT) {
    float* H1 = (float*)(ws + WS_H1);
    u16* AH1 = (u16*)(ws + WS_AH1);
    const float* HF = (const float*)(ws + WS_HF);
#pragma unroll
    for (int mi = 0; mi < 4; ++mi)
#pragma unroll
      for (int r = 0; r < 4; ++r) {
        const int row = row0 + wm * 64 + mi * 16 + fq * 4 + r;
        const float* res = (l == 0) ? (row < SEQ ? P.in[I_XP] + (size_t)row * 1024 : P.in[I_XS] + (size_t)(row - SEQ) * 1024)
                                    : HF + (size_t)row * 1024;
#pragma unroll
        for (int ni = 0; ni < 4; ++ni) {
          const int col = col0 + wn * 64 + ni * 16 + fr;
          const float h = res[col] + acc[mi][ni][r];
          H1[(size_t)row * 1024 + col] = h;
          AH1[(size_t)row * 1024 + col] = f2bf(h);
        }
      }
  } else if (EPI == EPI_GU) {
    u16* G = (u16*)(ws + WS_G);
#pragma unroll
    for (int mi = 0; mi < 4; ++mi)
#pragma unroll
      for (int r = 0; r < 4; ++r) {
        const int row = row0 + wm * 64 + mi * 16 + fq * 4 + r;
#pragma unroll
        for (int q = 0; q < 2; ++q) {
          const int j = ((col0 + wn * 64) >> 1) + q * 16 + fr;
          const float g = acc[mi][2 * q][r] * scv[mi][r], u = acc[mi][2 * q + 1][r] * scv[mi][r];
          G[(size_t)row * DFF + j] = f2bf(siluf(g) * u);
        }
      }
  } else {
    const float* H1 = (const float*)(ws + WS_H1);
    float* HF = (float*)(ws + WS_HF);
    u16* AH = (u16*)(ws + WS_AH);
#pragma unroll
    for (int mi = 0; mi < 4; ++mi)
#pragma unroll
      for (int r = 0; r < 4; ++r) {
        const int row = row0 + wm * 64 + mi * 16 + fq * 4 + r;
#pragma unroll
        for (int ni = 0; ni < 4; ++ni) {
          const int col = col0 + wn * 64 + ni * 16 + fr;
          const float h = H1[(size_t)row * 1024 + col] + acc[mi][ni][r];
          if (l == 0) {
            HF[(size_t)row * 1024 + col] = h;
            AH[(size_t)row * 1024 + col] = f2bf(h);
          } else {
            P.out[OFF_Y + (size_t)row * 1024 + col] = h;
          }
        }
      }
  }
}

template <int EPI>
__device__ void gemm_tile(const Params& P, int l, const u16* __restrict__ A, int lda, const u16* __restrict__ Bt, int ldb,
                          int K, int KS, int row0, int col0, unsigned char* smem) {
  const int tid = opaque_tid(), lane = tid & 63, w = tid >> 6, wm = w >> 1, wn = w & 1;
  const int fr = lane & 15, fq = lane >> 4;
  f32x4 acc[4][4];
#pragma unroll
  for (int mi = 0; mi < 4; ++mi)
#pragma unroll
    for (int ni = 0; ni < 4; ++ni) acc[mi][ni] = (f32x4){0.f, 0.f, 0.f, 0.f};
  const int lrow = tid >> 3, lch = tid & 7;
  const u16* Ag = A + (size_t)(row0 + lrow) * lda + lch * 8;
  const u16* Bg = Bt + (size_t)(col0 + lrow) * ldb + lch * 8;
  const int swz = ((lch ^ (lrow & 7)) << 4);
  uint4 ra[4], rb[4];
  float ss[4] = {0.f, 0.f, 0.f, 0.f};
  float scv[4][4];
#pragma unroll
  for (int mi = 0; mi < 4; ++mi)
#pragma unroll
    for (int r = 0; r < 4; ++r) scv[mi][r] = 1.f;
  const int nk = K >> 6;
  const int ksS = (KS >> 6) - 1;
#pragma unroll
  for (int i = 0; i < 4; ++i) {
    ra[i] = *(const uint4*)(Ag + (size_t)(32 * i) * lda);
    rb[i] = *(const uint4*)(Bg + (size_t)(32 * i) * ldb);
  }
  if (0 <= ksS) {
#pragma unroll
    for (int i = 0; i < 4; ++i) ss[i] += sumsq8(ra[i]);
  }
#pragma unroll
  for (int i = 0; i < 4; ++i) {
    const int off = (lrow + 32 * i) * 128 + swz;
    *(uint4*)(smem + off) = ra[i];
    *(uint4*)(smem + 16384 + off) = rb[i];
  }
  __syncthreads();
  for (int ks = 0; ks < nk; ++ks) {
    const bool more = (ks + 1 < nk);
    if (more) {
#pragma unroll
      for (int i = 0; i < 4; ++i) {
        ra[i] = *(const uint4*)(Ag + (size_t)(32 * i) * lda + (ks + 1) * 64);
        rb[i] = *(const uint4*)(Bg + (size_t)(32 * i) * ldb + (ks + 1) * 64);
      }
    }
    const unsigned char* As = smem + (ks & 1) * 32768;
    const unsigned char* Bs = As + 16384;
#pragma unroll
    for (int kk = 0; kk < 2; ++kk) {
      bf16x8 af[4], bq[4];
#pragma unroll
      for (int mi = 0; mi < 4; ++mi) {
        const int row = wm * 64 + mi * 16 + fr;
        af[mi] = *(const bf16x8*)(As + row * 128 + (((kk * 4 + fq) ^ (row & 7)) << 4));
      }
#pragma unroll
      for (int ni = 0; ni < 4; ++ni) {
        const int row = wn * 64 + ni * 16 + fr;
        bq[ni] = *(const bf16x8*)(Bs + row * 128 + (((kk * 4 + fq) ^ (row & 7)) << 4));
      }
#pragma unroll
      for (int mi = 0; mi < 4; ++mi)
#pragma unroll
        for (int ni = 0; ni < 4; ++ni) acc[mi][ni] = mfma16(af[mi], bq[ni], acc[mi][ni]);
    }
    __builtin_amdgcn_sched_barrier(0);
    asm volatile("s_nop 7\n\ts_nop 7\n\ts_nop 7\n\ts_nop 7" ::: "memory");
    __builtin_amdgcn_sched_barrier(0);
    if (more) {
      if (ks + 1 <= ksS) {
#pragma unroll
        for (int i = 0; i < 4; ++i) ss[i] += sumsq8(ra[i]);
      }
      unsigned char* Ad = smem + ((ks + 1) & 1) * 32768;
#pragma unroll
      for (int i = 0; i < 4; ++i) {
        const int off = (lrow + 32 * i) * 128 + swz;
        *(uint4*)(Ad + off) = ra[i];
        *(uint4*)(Ad + 16384 + off) = rb[i];
      }
    }
    float* rsL = (float*)(smem + ((ks + 1) & 1) * 32768 + RSOFF);
    if (ks == ksS) {
#pragma unroll
      for (int i = 0; i < 4; ++i) {
        float s = ss[i];
        s += __shfl_xor(s, 1); s += __shfl_xor(s, 2); s += __shfl_xor(s, 4);
        if (lch == 0) rsL[lrow + 32 * i] = rsqrtf(s / (float)KS + EPS);
      }
    }
    __syncthreads();
    if (ks == ksS) {
#pragma unroll
      for (int mi = 0; mi < 4; ++mi)
#pragma unroll
        for (int r = 0; r < 4; ++r) scv[mi][r] = rsL[wm * 64 + mi * 16 + fq * 4 + r];
      __syncthreads();
    }
  }
  gemm_epilogue<EPI>(P, l, acc, scv, row0, col0, wm, wn, fr, fq);
}

__device__ void wconv_item(const Params& P, int mode, int l, int kt, int nt, unsigned char* smem) {
  float* tile = (float*)smem;
  const int tid = opaque_tid();
  const float* src; int ldsrc, Nsrc; u16* dst; int lddst;
  const float* gain = nullptr;
  unsigned char* ws = P.ws;
  if (mode == 0) { src = P.in[I_WIN] + (size_t)l * 1024 * NIN; ldsrc = NIN; Nsrc = NIN; dst = (u16*)(ws + WS_WIN) + (size_t)l * NINP * 1024; lddst = 1024; gain = P.in[I_NORM1] + l * 1024; }
  else if (mode == 1) { src = P.in[I_WOUT] + (size_t)l * 1024 * 1024; ldsrc = 1024; Nsrc = 1024; dst = (u16*)(ws + WS_WOUT) + (size_t)l * 1024 * 1024; lddst = 1024; }
  else if (mode == 2) { src = P.in[I_WGATE] + (size_t)l * 1024 * DFF; ldsrc = DFF; Nsrc = DFF; dst = (u16*)(ws + WS_WGU) + (size_t)l * 5632 * 1024; lddst = 1024; gain = P.in[I_NORM2] + l * 1024; }
  else if (mode == 3) { src = P.in[I_WUP] + (size_t)l * 1024 * DFF; ldsrc = DFF; Nsrc = DFF; dst = (u16*)(ws + WS_WGU) + (size_t)l * 5632 * 1024; lddst = 1024; gain = P.in[I_NORM2] + l * 1024; }
  else { src = P.in[I_WDOWN] + (size_t)l * DFF * 1024; ldsrc = 1024; Nsrc = 1024; dst = (u16*)(ws + WS_WDN) + (size_t)l * 1024 * DFF; lddst = DFF; }
  const int k0 = kt * 64, n0 = nt * 64;
  {
    const int j = tid & 63, ig = tid >> 6;
    const int n = n0 + j;
#pragma unroll 4
    for (int ii = 0; ii < 16; ++ii) {
      const int i = ig * 16 + ii, k = k0 + i;
      float v = 0.f;
      if (n < Nsrc) {
        v = src[(size_t)k * ldsrc + n];
        if (mode == 1) { if (k >= 256 && k < 768) v *= P.in[I_SSMN][l * 512 + (k - 256)]; }
        else if (gain) v *= gain[k];
      }
      tile[i * 65 + j] = v;
    }
  }
  __syncthreads();
  {
    const int i8 = tid & 7;
    int kd = k0 + i8 * 8;
    if (mode == 1) kd = (kd < 256) ? kd + 512 : (kd < 768 ? kd - 256 : kd);
#pragma unroll
    for (int jj = 0; jj < 2; ++jj) {
      const int j = (tid >> 3) + 32 * jj;
      const int n = n0 + j;
      int nd = n;
      if (mode == 2) nd = ((n >> 4) << 5) + (n & 15);
      else if (mode == 3) nd = ((n >> 4) << 5) + (n & 15) + 16;
      uint4 o;
      o.x = pack2(tile[(i8 * 8 + 0) * 65 + j], tile[(i8 * 8 + 1) * 65 + j]);
      o.y = pack2(tile[(i8 * 8 + 2) * 65 + j], tile[(i8 * 8 + 3) * 65 + j]);
      o.z = pack2(tile[(i8 * 8 + 4) * 65 + j], tile[(i8 * 8 + 5) * 65 + j]);
      o.w = pack2(tile[(i8 * 8 + 6) * 65 + j], tile[(i8 * 8 + 7) * 65 + j]);
      *(uint4*)(dst + (size_t)nd * lddst + kd) = o;
    }
  }
  __syncthreads();
}

__device__ void xconv_item(const Params& P, int item) {
  u16* AH = (u16*)(P.ws + WS_AH);
#pragma unroll
  for (int i = 0; i < 4; ++i) {
    const size_t e = ((size_t)item * 1024 + i * 256 + threadIdx.x) * 8;
    const float* src = (e < (size_t)SEQ * 1024) ? P.in[I_XP] + e : P.in[I_XS] + (e - (size_t)SEQ * 1024);
    const float4 a = *(const float4*)src, b = *(const float4*)(src + 4);
    uint4 o;
    o.x = pack2(a.x, a.y); o.y = pack2(a.z, a.w); o.z = pack2(b.x, b.y); o.w = pack2(b.z, b.w);
    *(uint4*)(AH + e) = o;
  }
}

__device__ void rope_item(const Params& P, int item) {
  const int e = item * 256 + threadIdx.x;
  if (e >= 16388 * 8) return;
  const int pos = e >> 3, i = e & 7;
  const double inv[8] = {1.0, 0.19392274474868576, 0.03760603093086393, 0.007292664737217109,
                         0.001414213562373095, 0.0002742481756762073, 5.318295896944988e-05, 1.031338537721246e-05};
  double invv = inv[0];
#pragma unroll
  for (int q = 1; q < 8; ++q) invv = (i == q) ? inv[q] : invv;
  const double ang = (double)pos * invv;
  const double n = rint(ang * 0.15915494309189535);
  double r = fma(-n, 6.283185307179586, ang);
  r = fma(-n, 2.4492935982947064e-16, r);
  const double r2 = r * r;
  double S = 1.0, C = 1.0;
#pragma unroll
  for (int k = 14; k >= 1; --k) {
    S = 1.0 - r2 * (1.0 / ((2.0 * k) * (2.0 * k + 1.0))) * S;
    C = 1.0 - r2 * (1.0 / ((2.0 * k - 1.0) * (2.0 * k))) * C;
  }
  float* ROPE = (float*)(P.ws + WS_ROPE);
  ROPE[pos * 16 + i] = (float)C;
  ROPE[pos * 16 + 8 + i] = (float)(r * S);
}

__device__ void attn_item(const Params& P, int l, int variant, int idx, unsigned char* smem) {
  const int tid = opaque_tid(), lane = tid & 63, w = tid >> 6, fr = lane & 15, fq = lane >> 4;
  const int h = idx & 3, qb = idx >> 2;
  const int dil = (variant <= 1) ? 1 : (variant == 2 ? 4 : 16);
  const int maxd = (variant == 0) ? 127 : 128;
  const int nbr = SEQ / dil / 64;
  const int res = qb / nbr, ib = qb % nbr;
  const int i0 = ib * 64;
  const int qofs = (variant == 0 ? 0 : 512) + h * 64;
  const int kofs = (variant == 0 ? 256 : 768) + (h >> 1) * 64;
  const int vofs = kofs + 128;
  const u16* QKV = (const u16*)(P.ws + WS_QKV);
  u16* Qs = (u16*)smem;
  u16* Ks = (u16*)(smem + 9216);
  u16* Vt = (u16*)(smem + 9216 + 27648);
  u16* Ps = Ks;
  {
    const int r = tid >> 2, c = (tid & 3) * 16;
    {
      const size_t pos = (size_t)res + (size_t)dil * (i0 + r);
      const uint4* g = (const uint4*)(QKV + pos * 1024 + qofs + c);
      const uint4 a = g[0], b = g[1];
      *(uint4*)(Qs + r * 72 + c) = a;
      *(uint4*)(Qs + r * 72 + c + 8) = b;
    }
#pragma unroll
    for (int pss = 0; pss < 3; ++pss) {
      const int kk = pss * 64 + r;
      const int ik = i0 - 128 + kk;
      uint4 a = make_uint4(0, 0, 0, 0), b = a, va = a, vb = a;
      if (ik >= 0) {
        const size_t pos = (size_t)res + (size_t)dil * ik;
        const uint4* g = (const uint4*)(QKV + pos * 1024 + kofs + c);
        a = g[0]; b = g[1];
        const uint4* gv = (const uint4*)(QKV + pos * 1024 + vofs + c);
        va = gv[0]; vb = gv[1];
      }
      *(uint4*)(Ks + kk * 72 + c) = a;
      *(uint4*)(Ks + kk * 72 + c + 8) = b;
      const unsigned vv[8] = {va.x, va.y, va.z, va.w, vb.x, vb.y, vb.z, vb.w};
#pragma unroll
      for (int e = 0; e < 8; ++e) {
        Vt[(c + 2 * e) * 200 + kk] = (u16)(vv[e] & 0xffffu);
        Vt[(c + 2 * e + 1) * 200 + kk] = (u16)(vv[e] >> 16);
      }
    }
  }
  __syncthreads();
  f32x4 s[12];
  {
    bf16x8 qa[2];
#pragma unroll
    for (int kk = 0; kk < 2; ++kk) qa[kk] = *(const bf16x8*)(Qs + (w * 16 + fr) * 72 + kk * 32 + fq * 8);
#pragma unroll
    for (int kb = 0; kb < 12; ++kb) {
      f32x4 a = (f32x4){0.f, 0.f, 0.f, 0.f};
#pragma unroll
      for (int kk = 0; kk < 2; ++kk) {
        const bf16x8 kf = *(const bf16x8*)(Ks + (kb * 16 + fr) * 72 + kk * 32 + fq * 8);
        a = mfma16(qa[kk], kf, a);
      }
      s[kb] = a;
    }
  }
  float sink = 0.f;
  if (variant == 0) sink = P.in[I_SINK][l * 4 + h];
  float m[4], den[4];
#pragma unroll
  for (int r = 0; r < 4; ++r) {
    const int iq = i0 + w * 16 + fq * 4 + r;
    float mx = -INFINITY;
#pragma unroll
    for (int kb = 0; kb < 12; ++kb) {
      const int ik = i0 - 128 + kb * 16 + fr;
      const int dist = iq - ik;
      const bool valid = (dist >= 0) && (dist <= maxd) && (ik >= 0);
      const float v = valid ? s[kb][r] * 0.125f : -INFINITY;
      s[kb][r] = v;
      mx = fmaxf(mx, v);
    }
    mx = fmaxf(mx, __shfl_xor(mx, 1)); mx = fmaxf(mx, __shfl_xor(mx, 2));
    mx = fmaxf(mx, __shfl_xor(mx, 4)); mx = fmaxf(mx, __shfl_xor(mx, 8));
    if (variant == 0) mx = fmaxf(mx, sink);
    float sum = 0.f;
#pragma unroll
    for (int kb = 0; kb < 12; ++kb) {
      const float e = __expf(s[kb][r] - mx);
      s[kb][r] = e;
      sum += e;
    }
    sum += __shfl_xor(sum, 1); sum += __shfl_xor(sum, 2); sum += __shfl_xor(sum, 4); sum += __shfl_xor(sum, 8);
    if (variant == 0) sum += __expf(sink - mx);
    m[r] = mx; den[r] = sum;
  }
  __syncthreads();
#pragma unroll
  for (int kb = 0; kb < 12; ++kb)
#pragma unroll
    for (int r = 0; r < 4; ++r) Ps[(w * 16 + fq * 4 + r) * 200 + kb * 16 + fr] = f2bf(s[kb][r]);
  __syncthreads();
  f32x4 o[4];
#pragma unroll
  for (int nb = 0; nb < 4; ++nb) o[nb] = (f32x4){0.f, 0.f, 0.f, 0.f};
#pragma unroll
  for (int ks = 0; ks < 6; ++ks) {
    const bf16x8 pa = *(const bf16x8*)(Ps + (w * 16 + fr) * 200 + ks * 32 + fq * 8);
#pragma unroll
    for (int nb = 0; nb < 4; ++nb) {
      const bf16x8 vf = *(const bf16x8*)(Vt + (nb * 16 + fr) * 200 + ks * 32 + fq * 8);
      o[nb] = mfma16(pa, vf, o[nb]);
    }
  }
#pragma unroll
  for (int r = 0; r < 4; ++r) {
    const int iq = i0 + w * 16 + fq * 4 + r;
    const size_t pos = (size_t)res + (size_t)dil * iq;
    const float inv = 1.f / den[r];
    if (variant == 0) {
      u16* MIX = (u16*)(P.ws + WS_MIX);
#pragma unroll
      for (int nb = 0; nb < 4; ++nb) MIX[pos * 1024 + 512 + h * 64 + nb * 16 + fr] = f2bf(o[nb][r] * inv);
    } else {
      u16* CO = (u16*)(P.ws + WS_CO) + (size_t)(variant - 1) * SEQ * 256;
#pragma unroll
      for (int nb = 0; nb < 4; ++nb) CO[pos * 256 + h * 64 + nb * 16 + fr] = f2bf(o[nb][r] * inv);
      if (fr == 0) {
        float* LSE = (float*)(P.ws + WS_LSE) + (size_t)(variant - 1) * SEQ * 4;
        LSE[pos * 4 + h] = m[r] + __logf(den[r]);
      }
    }
  }
  __syncthreads();
}

__device__ void cmerge_item(const Params& P, int item) {
  const int tid = opaque_tid();
  const int tok = item * 8 + (tid >> 5), ch = tid & 31;
  const int h = ch >> 3;
  const float* LSE = (const float*)(P.ws + WS_LSE);
  const u16* CO = (const u16*)(P.ws + WS_CO);
  const float l0 = LSE[(size_t)tok * 4 + h], l1 = LSE[(size_t)(SEQ + tok) * 4 + h], l2 = LSE[(size_t)(2 * SEQ + tok) * 4 + h];
  const float mx = fmaxf(l0, fmaxf(l1, l2));
  float w0 = __expf(l0 - mx), w1 = __expf(l1 - mx), w2 = __expf(l2 - mx);
  const float inv = 1.f / (w0 + w1 + w2);
  w0 *= inv; w1 *= inv; w2 *= inv;
  const uint4 a = *(const uint4*)(CO + (size_t)tok * 256 + ch * 8);
  const uint4 b = *(const uint4*)(CO + ((size_t)SEQ + tok) * 256 + ch * 8);
  const uint4 c = *(const uint4*)(CO + ((size_t)2 * SEQ + tok) * 256 + ch * 8);
  uint4 o;
  o.x = pack2(w0 * bflo(a.x) + w1 * bflo(b.x) + w2 * bflo(c.x), w0 * bfhi(a.x) + w1 * bfhi(b.x) + w2 * bfhi(c.x));
  o.y = pack2(w0 * bflo(a.y) + w1 * bflo(b.y) + w2 * bflo(c.y), w0 * bfhi(a.y) + w1 * bfhi(b.y) + w2 * bfhi(c.y));
  o.z = pack2(w0 * bflo(a.z) + w1 * bflo(b.z) + w2 * bflo(c.z), w0 * bfhi(a.z) + w1 * bfhi(b.z) + w2 * bfhi(c.z));
  o.w = pack2(w0 * bflo(a.w) + w1 * bflo(b.w) + w2 * bflo(c.w), w0 * bfhi(a.w) + w1 * bfhi(b.w) + w2 * bfhi(c.w));
  u16* MIX = (u16*)(P.ws + WS_MIX);
  *(uint4*)(MIX + (size_t)tok * 1024 + 768 + ch * 8) = o;
}

__device__ void sattn_item(const Params& P, int l, int isC, int item, unsigned char* smem) {
  const int tid = opaque_tid(), lane = tid & 63, t = tid >> 6;
  const int b = item >> 1, kvh = item & 1;
  float* qf = (float*)smem + t * 128;
  float* sb = (float*)smem + 512 + t * 784;
  const int row = SEQ + b * 4 + t;
  const u16* QKV = (const u16*)(P.ws + WS_QKV);
  const int nkeys = isC ? 387 : 128;
  const int buf = isC ? 2048 : 128;
  const float* cK = (isC ? P.in[I_CCK] : P.in[I_CAK]) + ((size_t)(l * 128 + b) * buf) * 128 + kvh * 64;
  const float* cV = (isC ? P.in[I_CCV] : P.in[I_CAV]) + ((size_t)(l * 128 + b) * buf) * 128 + kvh * 64;
  const float* nK = P.out + (isC ? OFF_SCK : OFF_SAK) + ((size_t)(l * 128 + b) * buf + (buf - 4)) * 128 + kvh * 64;
  const float* nV = P.out + (isC ? OFF_SCV : OFF_SAV) + ((size_t)(l * 128 + b) * buf + (buf - 4)) * 128 + kvh * 64;
#pragma unroll
  for (int hh = 0; hh < 2; ++hh)
    qf[hh * 64 + lane] = bf2f(QKV[(size_t)row * 1024 + (isC ? 512 : 0) + (kvh * 2 + hh) * 64 + lane]);
  __syncthreads();
  float m0 = -INFINITY, m1 = -INFINITY;
  for (int j = lane; j < nkeys; j += 64) {
    int idx;
    if (isC) { const int pi = j / 129, jj = j - pi * 129; const int d = (pi == 0) ? 1 : (pi == 1 ? 4 : 16); idx = 2048 + t - d * jj; }
    else idx = t + 1 + j;
    const float* kp = (idx < buf) ? cK + (size_t)idx * 128 : nK + (size_t)(idx - buf) * 128;
    float s0 = 0.f, s1 = 0.f;
#pragma unroll
    for (int c4 = 0; c4 < 16; ++c4) {
      const float4 kv = ((const float4*)kp)[c4];
      const float4 q0 = ((const float4*)qf)[c4], q1 = ((const float4*)(qf + 64))[c4];
      s0 += kv.x * q0.x + kv.y * q0.y + kv.z * q0.z + kv.w * q0.w;
      s1 += kv.x * q1.x + kv.y * q1.y + kv.z * q1.z + kv.w * q1.w;
    }
    s0 *= 0.125f; s1 *= 0.125f;
    sb[j] = s0; sb[392 + j] = s1;
    m0 = fmaxf(m0, s0); m1 = fmaxf(m1, s1);
  }
  m0 = wave_max(m0); m1 = wave_max(m1);
  float sk0 = 0.f, sk1 = 0.f;
  if (!isC) {
    sk0 = P.in[I_SINK][l * 4 + kvh * 2]; sk1 = P.in[I_SINK][l * 4 + kvh * 2 + 1];
    m0 = fmaxf(m0, sk0); m1 = fmaxf(m1, sk1);
  }
  float d0 = 0.f, d1 = 0.f;
  for (int j = lane; j < nkeys; j += 64) {
    const float e0 = __expf(sb[j] - m0), e1 = __expf(sb[392 + j] - m1);
    sb[j] = e0; sb[392 + j] = e1;
    d0 += e0; d1 += e1;
  }
  d0 = wave_sum(d0); d1 = wave_sum(d1);
  if (!isC) { d0 += __expf(sk0 - m0); d1 += __expf(sk1 - m1); }
  __syncthreads();
  float o0 = 0.f, o1 = 0.f;
#pragma unroll 8
  for (int j = 0; j < nkeys; ++j) {
    int idx;
    if (isC) { const int pi = j / 129, jj = j - pi * 129; const int d = (pi == 0) ? 1 : (pi == 1 ? 4 : 16); idx = 2048 + t - d * jj; }
    else idx = t + 1 + j;
    const float* vp = (idx < buf) ? cV + (size_t)idx * 128 : nV + (size_t)(idx - buf) * 128;
    const float v = vp[lane];
    o0 += sb[j] * v; o1 += sb[392 + j] * v;
  }
  u16* MIX = (u16*)(P.ws + WS_MIX);
  const int mo = isC ? 768 : 512;
  MIX[(size_t)row * 1024 + mo + (kvh * 2) * 64 + lane] = f2bf(o0 / d0);
  MIX[(size_t)row * 1024 + mo + (kvh * 2 + 1) * 64 + lane] = f2bf(o1 / d1);
  __syncthreads();
}

__device__ void smamba_item(const Params& P, int l, int item, unsigned char* smem) {
  const int tid = opaque_tid();
  const int b = item >> 3, h = item & 7, g = h >> 2;
  float* xa = (float*)smem;
  float* Ba = xa + 256;
  float* Ca = Ba + 512;
  const u16* XBC = (const u16*)(P.ws + WS_XBC);
  const float* DT = (const float*)(P.ws + WS_DT);
  const u16* Z = (const u16*)(P.ws + WS_Z);
  const int row0 = SEQ + b * 4;
  for (int ci = tid; ci < 320; ci += 256) {
    int ch; float* dst; int dl;
    if (ci < 64) { ch = h * 64 + ci; dst = xa + ci; dl = 64; }
    else if (ci < 192) { ch = 512 + g * 128 + (ci - 64); dst = Ba + (ci - 64); dl = 128; }
    else { ch = 768 + g * 128 + (ci - 192); dst = Ca + (ci - 192); dl = 128; }
    float sq[7];
#pragma unroll
    for (int j = 0; j < 3; ++j) sq[j] = P.in[I_SCONV][((size_t)(l * 128 + b) * 3 + j) * 1024 + ch];
#pragma unroll
    for (int j = 0; j < 4; ++j) sq[3 + j] = bf2f(XBC[(size_t)(row0 + j) * 1024 + ch]);
    const float w0 = P.in[I_CONVW][(l * 4 + 0) * 1024 + ch], w1 = P.in[I_CONVW][(l * 4 + 1) * 1024 + ch];
    const float w2 = P.in[I_CONVW][(l * 4 + 2) * 1024 + ch], w3 = P.in[I_CONVW][(l * 4 + 3) * 1024 + ch];
    const float bs = P.in[I_CONVB][l * 1024 + ch];
#pragma unroll
    for (int t = 0; t < 4; ++t) dst[t * dl] = siluf(bs + w0 * sq[t] + w1 * sq[t + 1] + w2 * sq[t + 2] + w3 * sq[t + 3]);
  }
  __syncthreads();
  const int p = tid >> 2, nq = tid & 3;
  float hs[32];
  const float* sp = P.in[I_SSM] + (((size_t)(l * 128 + b) * 8 + h) * 64 + p) * 128 + nq * 32;
#pragma unroll
  for (int i = 0; i < 8; ++i) {
    const float4 v = ((const float4*)sp)[i];
    hs[4 * i] = v.x; hs[4 * i + 1] = v.y; hs[4 * i + 2] = v.z; hs[4 * i + 3] = v.w;
  }
  const float dtb = P.in[I_DTB][l * 8 + h], aneg = -__expf(P.in[I_ALOG][l * 8 + h]), dsk = P.in[I_DSKIP][l * 8 + h];
  u16* MIX = (u16*)(P.ws + WS_MIX);
#pragma unroll
  for (int t = 0; t < 4; ++t) {
    const float dt = softplusf(DT[(size_t)(row0 + t) * 8 + h] + dtb);
    const float dA = __expf(aneg * dt);
    const float xv = xa[t * 64 + p];
    const float xdt = xv * dt;
    float yp = 0.f;
#pragma unroll
    for (int i = 0; i < 32; ++i) {
      hs[i] = hs[i] * dA + xdt * Ba[t * 128 + nq * 32 + i];
      yp += Ca[t * 128 + nq * 32 + i] * hs[i];
    }
    yp += __shfl_xor(yp, 1); yp += __shfl_xor(yp, 2);
    float y = yp + xv * dsk;
    y *= siluf(bf2f(Z[(size_t)(row0 + t) * 512 + h * 64 + p]));
    if (nq == 0) MIX[(size_t)(row0 + t) * 1024 + h * 64 + p] = f2bf(y);
  }
  float* op = P.out + OFF_SSSM + (((size_t)(l * 128 + b) * 8 + h) * 64 + p) * 128 + nq * 32;
#pragma unroll
  for (int i = 0; i < 8; ++i) ((float4*)op)[i] = make_float4(hs[4 * i], hs[4 * i + 1], hs[4 * i + 2], hs[4 * i + 3]);
  __syncthreads();
}

DEVI void ssd_dt_acum(const Params& P, int l, int c, int h, float* dtv, float* acum) {
  const int tid = opaque_tid();
  const float* DT = (const float*)(P.ws + WS_DT);
  if (tid < 128) dtv[tid] = softplusf(DT[(size_t)(c * 128 + tid) * 8 + h] + P.in[I_DTB][l * 8 + h]);
  __syncthreads();
  if (tid == 0) {
    const float aneg = -__expf(P.in[I_ALOG][l * 8 + h]);
    float s = 0.f;
    for (int t = 0; t < 128; ++t) { s += aneg * dtv[t]; acum[t] = s; }
  }
  __syncthreads();
}

template <class F>
DEVI void conv_rows(const Params& P, int l, int tok0, int n, int ch, F f) {
  const u16* XBC = (const u16*)(P.ws + WS_XBC);
  const float w0 = P.in[I_CONVW][(l * 4 + 0) * 1024 + ch], w1 = P.in[I_CONVW][(l * 4 + 1) * 1024 + ch];
  const float w2 = P.in[I_CONVW][(l * 4 + 2) * 1024 + ch], w3 = P.in[I_CONVW][(l * 4 + 3) * 1024 + ch];
  const float bs = P.in[I_CONVB][l * 1024 + ch];
  float x0 = (tok0 - 3 >= 0) ? bf2f(XBC[(size_t)(tok0 - 3) * 1024 + ch]) : 0.f;
  float x1 = (tok0 - 2 >= 0) ? bf2f(XBC[(size_t)(tok0 - 2) * 1024 + ch]) : 0.f;
  float x2 = (tok0 - 1 >= 0) ? bf2f(XBC[(size_t)(tok0 - 1) * 1024 + ch]) : 0.f;
#pragma unroll 8
  for (int t = 0; t < n; ++t) {
    const float x3 = bf2f(XBC[(size_t)(tok0 + t) * 1024 + ch]);
    f(t, siluf(bs + w0 * x0 + w1 * x1 + w2 * x2 + w3 * x3));
    x0 = x1; x1 = x2; x2 = x3;
  }
}

__device__ void ssd_cs_item(const Params& P, int l, int item, unsigned char* smem) {
  const int tid = opaque_tid(), lane = tid & 63, w = tid >> 6, fr = lane & 15, fq = lane >> 4;
  const int c = item >> 3, h = item & 7, g = h >> 2;
  u16* xT = (u16*)smem;
  u16* BT = (u16*)(smem + 17408);
  float* acum = (float*)(smem + 17408 + 34816);
  float* dtv = acum + 128;
  ssd_dt_acum(P, l, c, h, dtv, acum);
  const float aend = acum[127];
  {
    const int ch = tid & 63, rg = tid >> 6;
    conv_rows(P, l, c * 128 + rg * 32, 32, h * 64 + ch, [&](int t, float v) {
      const int s = rg * 32 + t;
      xT[ch * 136 + s] = f2bf(v * dtv[s] * __expf(aend - acum[s]));
    });
  }
  {
    const int ch = tid & 127, rg = tid >> 7;
    conv_rows(P, l, c * 128 + rg * 64, 64, 512 + g * 128 + ch, [&](int t, float v) {
      BT[ch * 136 + rg * 64 + t] = f2bf(v);
    });
  }
  __syncthreads();
  float* CS = (float*)(P.ws + WS_CS) + (size_t)(c * 8 + h) * 8192;
  bf16x8 xa[4];
#pragma unroll
  for (int ks = 0; ks < 4; ++ks) xa[ks] = *(const bf16x8*)(xT + (w * 16 + fr) * 136 + ks * 32 + fq * 8);
#pragma unroll
  for (int nb = 0; nb < 8; ++nb) {
    f32x4 a = (f32x4){0.f, 0.f, 0.f, 0.f};
#pragma unroll
    for (int ks = 0; ks < 4; ++ks) {
      const bf16x8 bfg = *(const bf16x8*)(BT + (nb * 16 + fr) * 136 + ks * 32 + fq * 8);
      a = mfma16(xa[ks], bfg, a);
    }
#pragma unroll
    for (int r = 0; r < 4; ++r) CS[(w * 16 + fq * 4 + r) * 128 + nb * 16 + fr] = a[r];
  }
  if (tid == 0) ((float*)(P.ws + WS_CD))[c * 8 + h] = __expf(aend);
  __syncthreads();
}

__device__ void ssd_scan_item(const Params& P, int l, int item) {
  const int e = item * 256 + threadIdx.x;
  const int h = e >> 13;
  const float* CS = (const float*)(P.ws + WS_CS);
  const float* CD = (const float*)(P.ws + WS_CD);
  u16* HIN = (u16*)(P.ws + WS_HIN);
  float hc = 0.f;
#pragma unroll 8
  for (int c = 0; c < 128; ++c) {
    HIN[(size_t)c * 65536 + e] = f2bf(hc);
    hc = hc * CD[c * 8 + h] + CS[(size_t)c * 65536 + e];
  }
  P.out[OFF_PSSM + (size_t)l * 65536 + e] = hc;
}

__device__ void ssd_y_item(const Params& P, int l, int item, unsigned char* smem) {
  const int tid = opaque_tid(), lane = tid & 63, w = tid >> 6, fr = lane & 15, fq = lane >> 4;
  const int half = item & 1, h = (item >> 1) & 7, c = item >> 4, g = h >> 2;
  const int l0 = half * 64;
  u16* Cs = (u16*)smem;
  u16* Hs = (u16*)(smem + 17408);
  u16* Bs = (u16*)(smem + 34816);
  float* acum = (float*)(smem + 69632);
  float* dtv = acum + 128;
  u16* Gs = Hs;
  u16* xT = Bs;
  ssd_dt_acum(P, l, c, h, dtv, acum);
  {
    const int ch = tid & 127, rg = tid >> 7;
    conv_rows(P, l, c * 128 + l0 + rg * 32, 32, 768 + g * 128 + ch, [&](int t, float v) {
      Cs[(rg * 32 + t) * 136 + ch] = f2bf(v);
    });
    conv_rows(P, l, c * 128 + rg * 64, 64, 512 + g * 128 + ch, [&](int t, float v) {
      Bs[(rg * 64 + t) * 136 + ch] = f2bf(v);
    });
    const u16* HIN = (const u16*)(P.ws + WS_HIN) + (size_t)(c * 8 + h) * 8192;
    const int r = tid >> 2, cq = (tid & 3) * 32;
#pragma unroll
    for (int i = 0; i < 4; ++i) *(uint4*)(Hs + r * 136 + cq + i * 8) = *(const uint4*)(HIN + r * 128 + cq + i * 8);
  }
  __syncthreads();
  f32x4 y[4];
  f32x4 cb[8];
  {
    bf16x8 ca[4];
#pragma unroll
    for (int ks = 0; ks < 4; ++ks) ca[ks] = *(const bf16x8*)(Cs + (w * 16 + fr) * 136 + ks * 32 + fq * 8);
#pragma unroll
    for (int nb = 0; nb < 4; ++nb) {
      f32x4 a = (f32x4){0.f, 0.f, 0.f, 0.f};
#pragma unroll
      for (int ks = 0; ks < 4; ++ks) a = mfma16(ca[ks], *(const bf16x8*)(Hs + (nb * 16 + fr) * 136 + ks * 32 + fq * 8), a);
      y[nb] = a;
    }
#pragma unroll
    for (int sbk = 0; sbk < 8; ++sbk) {
      f32x4 a = (f32x4){0.f, 0.f, 0.f, 0.f};
#pragma unroll
      for (int ks = 0; ks < 4; ++ks) a = mfma16(ca[ks], *(const bf16x8*)(Bs + (sbk * 16 + fr) * 136 + ks * 32 + fq * 8), a);
      cb[sbk] = a;
    }
  }
  float al[4];
#pragma unroll
  for (int r = 0; r < 4; ++r) al[r] = acum[l0 + w * 16 + fq * 4 + r];
  __syncthreads();
#pragma unroll
  for (int sbk = 0; sbk < 8; ++sbk) {
    const int s = sbk * 16 + fr;
    const float as = acum[s];
#pragma unroll
    for (int r = 0; r < 4; ++r) {
      const int ll = l0 + w * 16 + fq * 4 + r;
      const float gval = (s <= ll) ? cb[sbk][r] * __expf(al[r] - as) : 0.f;
      Gs[(w * 16 + fq * 4 + r) * 136 + s] = f2bf(gval);
    }
  }
  {
    const int ch = tid & 63, rg = tid >> 6;
    conv_rows(P, l, c * 128 + rg * 32, 32, h * 64 + ch, [&](int t, float v) {
      const int s = rg * 32 + t;
      xT[ch * 136 + s] = f2bf(v * dtv[s]);
    });
  }
  __syncthreads();
  f32x4 yd[4];
#pragma unroll
  for (int nb = 0; nb < 4; ++nb) yd[nb] = (f32x4){0.f, 0.f, 0.f, 0.f};
#pragma unroll
  for (int ks = 0; ks < 4; ++ks) {
    const bf16x8 ga = *(const bf16x8*)(Gs + (w * 16 + fr) * 136 + ks * 32 + fq * 8);
#pragma unroll
    for (int nb = 0; nb < 4; ++nb) yd[nb] = mfma16(ga, *(const bf16x8*)(xT + (nb * 16 + fr) * 136 + ks * 32 + fq * 8), yd[nb]);
  }
  const float dsk = P.in[I_DSKIP][l * 8 + h];
  const u16* Z = (const u16*)(P.ws + WS_Z);
  u16* MIX = (u16*)(P.ws + WS_MIX);
#pragma unroll
  for (int r = 0; r < 4; ++r) {
    const int ll = l0 + w * 16 + fq * 4 + r;
    const size_t tok = (size_t)c * 128 + ll;
    const float idt = 1.f / dtv[ll];
    const float eal = __expf(al[r]);
#pragma unroll
    for (int nb = 0; nb < 4; ++nb) {
      const int p = nb * 16 + fr;
      float yv = yd[nb][r] + y[nb][r] * eal + bf2f(xT[p * 136 + ll]) * idt * dsk;
      yv *= siluf(bf2f(Z[tok * 512 + h * 64 + p]));
      MIX[tok * 1024 + h * 64 + p] = f2bf(yv);
    }
  }
  __syncthreads();
}

__device__ void mixnorm_item(const Params& P, int item) {
  const int tid = opaque_tid(), lane = tid & 63, w = tid >> 6;
  const int row = item * 4 + w;
  u16* MIX = (u16*)(P.ws + WS_MIX) + (size_t)row * 1024 + lane * 8;
  const uint4 v = *(const uint4*)MIX;
  float f[8] = {bflo(v.x), bfhi(v.x), bflo(v.y), bfhi(v.y), bflo(v.z), bfhi(v.z), bflo(v.w), bfhi(v.w)};
  float s = 0.f;
#pragma unroll
  for (int i = 0; i < 8; ++i) s += f[i] * f[i];
  s = wave_sum(s);
  const float sc = rsqrtf(s * (1.f / 512.f) + EPS);
  uint4 o;
  o.x = pack2(f[0] * sc, f[1] * sc); o.y = pack2(f[2] * sc, f[3] * sc);
  o.z = pack2(f[4] * sc, f[5] * sc); o.w = pack2(f[6] * sc, f[7] * sc);
  *(uint4*)MIX = o;
}

__device__ void copy_item(const Params& P, int l, int item) {
  const float* src; float* dst; int n4;
  int s4;
  if (item < 4096) {
    const int part = item & 15, kv = (item >> 4) & 1, b = item >> 5;
    const size_t base = (size_t)(l * 128 + b) * 262144;
    src = (kv ? P.in[I_CCV] : P.in[I_CCK]) + base + 512;
    dst = P.out + (kv ? OFF_SCV : OFF_SCK) + base;
    s4 = part * 4096;
    n4 = min(4096, 65408 - s4);
  } else {
    const int it = item - 4096;
    const int kv = it & 1, b = it >> 1;
    const size_t base = (size_t)(l * 128 + b) * 16384;
    src = (kv ? P.in[I_CAV] : P.in[I_CAK]) + base + 512;
    dst = P.out + (kv ? OFF_SAV : OFF_SAK) + base;
    s4 = 0; n4 = 3968;
  }
  const f32x4* s = (const f32x4*)src + s4;
  f32x4* d = (f32x4*)dst + s4;
#pragma unroll 4
  for (int i = threadIdx.x; i < n4; i += 256) {
    const f32x4 v = __builtin_nontemporal_load(s + i);
    __builtin_nontemporal_store(v, d + i);
  }
}

struct GBar { unsigned* bar; unsigned epoch; };
DEVI void gsync(GBar& g) {
  asm volatile("s_waitcnt vmcnt(0) lgkmcnt(0)" ::: "memory");
  __syncthreads();
  g.epoch++;
  if (threadIdx.x == 0) {
    __builtin_amdgcn_fence(__ATOMIC_RELEASE, "agent");
    asm volatile("s_waitcnt vmcnt(0)" ::: "memory");
    const unsigned target = g.epoch * gridDim.x;
    __hip_atomic_fetch_add(g.bar, 1u, __ATOMIC_RELAXED, __HIP_MEMORY_SCOPE_AGENT);
    while (__hip_atomic_load(g.bar, __ATOMIC_RELAXED, __HIP_MEMORY_SCOPE_AGENT) < target) __builtin_amdgcn_s_sleep(2);
    __builtin_amdgcn_fence(__ATOMIC_ACQUIRE, "agent");
    asm volatile("s_waitcnt vmcnt(0)" ::: "memory");
  }
  __syncthreads();
}

__global__ void __launch_bounds__(256, 2) hymba_megakernel(Params P) {
  extern __shared__ __attribute__((aligned(16))) unsigned char smem[];
  cg::grid_group cgrid = cg::this_grid();
  GBar grid; grid.bar = (unsigned*)(P.ws + WS_BAR); grid.epoch = 0;
  cgrid.sync();
  const int nb = gridDim.x, bid = blockIdx.x;
  unsigned char* ws = P.ws;

#ifdef NANFILL
  {
    uint4* w4 = (uint4*)ws;
    const size_t n4 = WS_END / 16;
    const uint4 pat = make_uint4(0xffffffffu, 0xffffffffu, 0xffffffffu, 0xffffffffu);
    for (size_t i = (size_t)bid * 256 + threadIdx.x; i < n4; i += (size_t)nb * 256) w4[i] = pat;
    for (int i = threadIdx.x; i < LDS_BYTES / 16; i += 256) ((uint4*)smem)[i] = pat;
  }
  gsync(grid);
#endif
  {
    const int NW = 2 * 3040, NX = 2112, NR = 513;
    for (int it = bid; it < NW + NX + NR; it += nb) {
      if ((PHM & 1) && it < NW) {
        const int l = it / 3040;
        int r = it % 3040;
        if (r < 672) wconv_item(P, 0, l, r / 42, r % 42, smem);
        else if ((r -= 672) < 256) wconv_item(P, 1, l, r / 16, r % 16, smem);
        else if ((r -= 256) < 704) wconv_item(P, 2, l, r / 44, r % 44, smem);
        else if ((r -= 704) < 704) wconv_item(P, 3, l, r / 44, r % 44, smem);
        else { r -= 704; wconv_item(P, 4, l, r / 16, r % 16, smem); }
      } else if (it < NW + NX) { if (PHM & 2) xconv_item(P, it - NW); }
      else if (PHM & 2) rope_item(P, it - NW - NX);
    }
  }
  gsync(grid);

#ifdef DELAYTEST
  {
    const unsigned long long t0 = wall_clock64();
    while (wall_clock64() - t0 < 200000ull) __builtin_amdgcn_s_sleep(8);
    __syncthreads();
    if (threadIdx.x == 0) __builtin_amdgcn_fence(__ATOMIC_ACQUIRE, "agent");
    asm volatile("s_waitcnt vmcnt(0)" ::: "memory");
    __syncthreads();
  }
#endif
#ifdef E2TEST
  {
    const u16* AHp = (const u16*)(ws + WS_AH);
    const u16* WTp = (const u16*)(ws + WS_WIN);
    for (size_t i = (size_t)bid * 256 + threadIdx.x; i < (size_t)NT * 1024; i += (size_t)nb * 256) P.out[OFF_Y + i] = bf2f(AHp[i]) * 1.2345678f + 0.1f;
    for (size_t i = (size_t)bid * 256 + threadIdx.x; i < (size_t)2 * NINP * 1024; i += (size_t)nb * 256) P.out[OFF_SCK + i] = bf2f(WTp[i]) * 1.2345678f + 0.001f;
    return;
  }
#endif
#pragma unroll 1
  for (int l = 0; l < 2; ++l) {
    {
      const u16* A = (const u16*)(ws + WS_AH);
      const u16* Bt = (const u16*)(ws + WS_WIN) + (size_t)l * NINP * 1024;
      for (int t = bid; t < 132 * 21; t += nb) {
        const int rt = t / 21, ct = t % 21;
        if (PHM & 4) gemm_tile<EPI_IN>(P, l, A, 1024, Bt, 1024, 1024, XKS, rt * 128, ct * 128, smem);
      }
    }
    gsync(grid);
    if (STOPAT == 1) return;
    {
      const int N_SC = 256, N_SA = 256, N_AT = 4096, N_CS = 1024, N_SM = 1024, N_CP = 4352;
      const int tot = N_SC + N_SA + N_AT + N_CS + N_SM + N_CP;
      for (int it = bid; it < tot; it += nb) {
        int r = it;
        int lq = l;
        asm volatile("" : "+s"(lq));
        if (r < N_SC) { if (PHM & 8) sattn_item(P, lq, 1, r, smem); }
        else if ((r -= N_SC) < N_SA) { if (PHM & 8) sattn_item(P, lq, 0, r, smem); }
        else if ((r -= N_SA) < N_AT) { if (PHM & 16) attn_item(P, lq, r >> 10, r & 1023, smem); }
        else if ((r -= N_AT) < N_CS) { if (PHM & 32) ssd_cs_item(P, lq, r, smem); }
        else if ((r -= N_CS) < N_SM) { if (PHM & 64) smamba_item(P, lq, r, smem); }
        else { r -= N_SM; if (PHM & 128) copy_item(P, lq, r); }
      }
    }
    gsync(grid);
    if (STOPAT == 2) return;
    {
      for (int it = bid; it < 256 + 2048; it += nb) {
        if (it < 256) { if (PHM & 256) ssd_scan_item(P, l, it); }
        else if (PHM & 256) cmerge_item(P, it - 256);
      }
    }
    gsync(grid);
    if (STOPAT == 3) return;
    for (int it = bid; it < 2048; it += nb) { if (PHM & 512) ssd_y_item(P, l, it, smem); }
    gsync(grid);
    for (int it = bid; it < NT / 4; it += nb) mixnorm_item(P, it);
    gsync(grid);
    if (STOPAT == 4) return;
    {
      const u16* A = (const u16*)(ws + WS_MIX);
      const u16* Bt = (const u16*)(ws + WS_WOUT) + (size_t)l * 1024 * 1024;
      for (int t = bid; t < 132 * 8; t += nb) {
        const int rt = t / 8, ct = t % 8;
        if (PHM & 1024) gemm_tile<EPI_OUT>(P, l, A, 1024, Bt, 1024, 1024, 0, rt * 128, ct * 128, smem);
      }
    }
    gsync(grid);
    if (STOPAT == 5) return;
    {
      const u16* A = (const u16*)(ws + WS_AH1);
      const u16* Bt = (const u16*)(ws + WS_WGU) + (size_t)l * 5632 * 1024;
      for (int t = bid; t < 132 * 44; t += nb) {
        const int rt = t / 44, ct = t % 44;
        if (PHM & 2048) gemm_tile<EPI_GU>(P, l, A, 1024, Bt, 1024, 1024, 1024, rt * 128, ct * 128, smem);
      }
    }
    gsync(grid);
    if (STOPAT == 6) return;
    {
      const u16* A = (const u16*)(ws + WS_G);
      const u16* Bt = (const u16*)(ws + WS_WDN) + (size_t)l * 1024 * DFF;
      for (int t = bid; t < 132 * 8; t += nb) {
        const int rt = t / 8, ct = t % 8;
        if (PHM & 4096) gemm_tile<EPI_DN>(P, l, A, DFF, Bt, DFF, DFF, 0, rt * 128, ct * 128, smem);
      }
    }
    if (l == 0) gsync(grid);
  }
}

extern "C" void kernel_launch(void* const* d_in, const int* in_sizes, int n_in, void* d_out, int out_size, void* d_ws,
                              size_t ws_size, hipStream_t stream) {
  static int grid_blocks = 0;
  if (!grid_blocks) {
    int dev = 0, cus = 0, per_cu = 0;
    (void)hipGetDevice(&dev);
    (void)hipDeviceGetAttribute(&cus, hipDeviceAttributeMultiprocessorCount, dev);
    (void)hipFuncSetAttribute((const void*)hymba_megakernel, hipFuncAttributeMaxDynamicSharedMemorySize, LDS_BYTES);
    (void)hipOccupancyMaxActiveBlocksPerMultiprocessor(&per_cu, hymba_megakernel, 256, LDS_BYTES);
    if (per_cu < 1) per_cu = 1;
    if (per_cu > 2) per_cu = 2;
    grid_blocks = cus * per_cu;
  }
  Params p{};
  for (int i = 0; i < 26; ++i) p.in[i] = (const float*)d_in[i];
  p.out = (float*)d_out;
  p.ws = (unsigned char*)d_ws;
  (void)hipMemsetAsync((unsigned char*)d_ws + WS_BAR, 0, 256, stream);
  void* args[] = {&p};
  hipError_t e = hipLaunchCooperativeKernel((void*)hymba_megakernel, dim3(grid_blocks), dim3(256), args, LDS_BYTES, stream);
  if (e != hipSuccess) fprintf(stderr, "cooperative launch failed: %s (grid %d)\n", hipGetErrorString(e), grid_blocks);
}
```

```cpp
#include <hip/hip_runtime.h>
#include <hip/hip_bf16.h>
#include <hip/hip_cooperative_groups.h>
#include <cstdio>
namespace cg = cooperative_groups;

typedef unsigned short u16;
using bf16x8 = __attribute__((ext_vector_type(8))) short;
using f32x4 = __attribute__((ext_vector_type(4))) float;
using u32x4 = __attribute__((ext_vector_type(4))) unsigned int;
#define DEVI __device__ __forceinline__

constexpr int DM = 1024, SEQ = 16384, NSAMP = 512, NT = SEQ + NSAMP, NB = 128;
constexpr int NINP = 2688, NIN = 2568, DFF = 2816;
constexpr float EPS = 1e-6f;
constexpr int LDS_BYTES = 73728;
#ifndef XKS
#define XKS 1024
#endif
#ifndef RSOFF
#define RSOFF 0
#endif
#ifndef OUTMASK
#define OUTMASK 0xff
#endif
#ifndef STOPAT
#define STOPAT 0
#endif
#ifndef PHM
#define PHM 0xffff
#endif

constexpr size_t OFF_Y = 0;
constexpr size_t OFF_PAK = (size_t)NT * DM;
constexpr size_t OFF_PAV = OFF_PAK + 32768;
constexpr size_t OFF_PCK = OFF_PAV + 32768;
constexpr size_t OFF_PCV = OFF_PCK + 524288;
constexpr size_t OFF_PSSM = OFF_PCV + 524288;
constexpr size_t OFF_PCONV = OFF_PSSM + 131072;
constexpr size_t OFF_SAK = OFF_PCONV + 6144;
constexpr size_t OFF_SAV = OFF_SAK + 4194304;
constexpr size_t OFF_SCK = OFF_SAV + 4194304;
constexpr size_t OFF_SCV = OFF_SCK + 67108864;
constexpr size_t OFF_SSSM = OFF_SCV + 67108864;
constexpr size_t OFF_SCONV = OFF_SSSM + 16777216;

constexpr size_t al256(size_t x) { return (x + 255) & ~(size_t)255; }
constexpr size_t WS_WIN = 0;
constexpr size_t WS_WOUT = WS_WIN + al256((size_t)2 * NINP * 1024 * 2);
constexpr size_t WS_WGU = WS_WOUT + al256((size_t)2 * 1024 * 1024 * 2);
constexpr size_t WS_WDN = WS_WGU + al256((size_t)2 * 5632 * 1024 * 2);
constexpr size_t WS_AH = WS_WDN + al256((size_t)2 * 1024 * 2816 * 2);
constexpr size_t WS_AH1 = WS_AH + al256((size_t)NT * 1024 * 2);
constexpr size_t WS_HF = WS_AH1 + al256((size_t)NT * 1024 * 2);
constexpr size_t WS_H1 = WS_HF + al256((size_t)NT * 1024 * 4);
constexpr size_t WS_QKV = WS_H1 + al256((size_t)NT * 1024 * 4);
constexpr size_t WS_Z = WS_QKV + al256((size_t)NT * 1024 * 2);
constexpr size_t WS_XBC = WS_Z + al256((size_t)NT * 512 * 2);
constexpr size_t WS_DT = WS_XBC + al256((size_t)NT * 1024 * 2);
constexpr size_t WS_G = WS_DT + al256((size_t)NT * 8 * 4);
constexpr size_t WS_MIX = WS_G + al256((size_t)NT * DFF * 2);
constexpr size_t WS_CO = WS_MIX + al256((size_t)NT * 1024 * 2);
constexpr size_t WS_LSE = WS_CO + al256((size_t)3 * SEQ * 256 * 2);
constexpr size_t WS_CS = WS_LSE + al256((size_t)3 * SEQ * 4 * 4);
constexpr size_t WS_CD = WS_CS + al256((size_t)128 * 65536 * 4);
constexpr size_t WS_HIN = WS_CD + al256((size_t)128 * 8 * 4);
constexpr size_t WS_ROPE = WS_HIN + al256((size_t)128 * 65536 * 2);
constexpr size_t WS_BAR = WS_ROPE + al256((size_t)16388 * 16 * 4);
constexpr size_t WS_PS1 = WS_BAR + 2048;
constexpr size_t WS_END = WS_PS1 + al256((size_t)NT * 16 * 4);

struct Params {
  const float* in[26];
  float* out;
  unsigned char* ws;
};
enum { I_XP = 0, I_XS, I_CAK, I_CAV, I_CCK, I_CCV, I_SSM, I_SCONV, I_NORM1, I_WIN, I_AQN, I_AKN, I_SINK, I_CQN, I_CKN,
       I_CONVW, I_CONVB, I_DTB, I_ALOG, I_DSKIP, I_SSMN, I_WOUT, I_NORM2, I_WGATE, I_WUP, I_WDOWN };

DEVI int opaque_tid() { int t = threadIdx.x; asm volatile("" : "+v"(t)); return t; }
DEVI u16 f2bf(float f) { unsigned u = __float_as_uint(f); u += 0x7fffu + ((u >> 16) & 1u); return (u16)(u >> 16); }
DEVI float bf2f(u16 h) { return __uint_as_float(((unsigned)h) << 16); }
DEVI unsigned pack2(float a, float b) { return (unsigned)f2bf(a) | ((unsigned)f2bf(b) << 16); }
DEVI float siluf(float x) { return x / (1.f + __expf(-x)); }
DEVI float softplusf(float x) { return x > 20.f ? x : log1pf(__expf(x)); }
DEVI float bflo(unsigned u) { return __uint_as_float(u << 16); }
DEVI float bfhi(unsigned u) { return __uint_as_float(u & 0xffff0000u); }
DEVI u32x4 gload16_async(const void* p) {
  u32x4 v;
  asm volatile("global_load_dwordx4 %0, %1, off" : "=v"(v) : "v"(p) : "memory");
  return v;
}
DEVI void gwait8(u32x4& a0, u32x4& a1, u32x4& a2, u32x4& a3, u32x4& b0, u32x4& b1, u32x4& b2, u32x4& b3) {
  asm volatile("s_waitcnt vmcnt(0)" : "+v"(a0), "+v"(a1), "+v"(a2), "+v"(a3), "+v"(b0), "+v"(b1), "+v"(b2), "+v"(b3) : : "memory");
}
DEVI float sumsq8(u32x4 v) {
  float s = 0.f, t;
  t = bflo(v.x); s += t * t; t = bfhi(v.x); s += t * t;
  t = bflo(v.y); s += t * t; t = bfhi(v.y); s += t * t;
  t = bflo(v.z); s += t * t; t = bfhi(v.z); s += t * t;
  t = bflo(v.w); s += t * t; t = bfhi(v.w); s += t * t;
  return s;
}
DEVI float wave_max(float v) {
#pragma unroll
  for (int o = 32; o >= 1; o >>= 1) v = fmaxf(v, __shfl_xor(v, o));
  return v;
}
DEVI float wave_sum(float v) {
#pragma unroll
  for (int o = 32; o >= 1; o >>= 1) v += __shfl_xor(v, o);
  return v;
}
DEVI f32x4 mfma16(bf16x8 a, bf16x8 b, f32x4 c) { return __builtin_amdgcn_mfma_f32_16x16x32_bf16(a, b, c, 0, 0, 0); }

enum { EPI_IN = 0, EPI_OUT = 1, EPI_GU = 2, EPI_DN = 3 };

DEVI uint2 pack4(float a, float b, float c, float d) { uint2 o; o.x = pack2(a, b); o.y = pack2(c, d); return o; }

template <int EPI>
DEVI void gemm_epilogue(const Params& P, int l, f32x4 (&acc)[4][4], float (&scv)[4], int row0, int col0, int wm, int wn, int fr, int fq) {
  unsigned char* ws = P.ws;
  if (EPI == EPI_IN) {
    const int cb = col0 + wn * 64;
    if (cb < 1024) {
      u16* QKV = (u16*)(ws + WS_QKV);
      const float* ROPE = (const float*)(ws + WS_ROPE);
      const int hh = cb >> 6;
      const bool isv = (hh == 6 || hh == 7 || hh == 14 || hh == 15);
      const float* gain = P.in[I_AQN];
      if (hh >= 4 && hh < 6) gain = P.in[I_AKN];
      else if (hh >= 8 && hh < 12) gain = P.in[I_CQN];
      else if (hh >= 12) gain = P.in[I_CKN];
      gain += l * 64;
      float gv[4][4];
#pragma unroll
      for (int ni = 0; ni < 4; ++ni)
#pragma unroll
        for (int r = 0; r < 4; ++r) gv[ni][r] = isv ? 1.f : gain[ni * 16 + fq * 4 + r];
      const int kind = (hh == 4 || hh == 5) ? 1 : (hh == 6 || hh == 7) ? 2 : (hh == 12 || hh == 13) ? 3 : (hh >= 14) ? 4 : 0;
      const int kvh = hh & 1;
#pragma unroll
      for (int mi = 0; mi < 4; ++mi) {
        const int row = row0 + wm * 64 + mi * 16 + fr;
        float v[4][4];
        float ss = 0.f;
#pragma unroll
        for (int ni = 0; ni < 4; ++ni)
#pragma unroll
          for (int r = 0; r < 4; ++r) { v[ni][r] = acc[mi][ni][r] * scv[mi]; ss += v[ni][r] * v[ni][r]; }
        if (!isv) {
          ss += __shfl_xor(ss, 16); ss += __shfl_xor(ss, 32);
          const float sc = rsqrtf(ss * (1.f / 64.f) + EPS);
#pragma unroll
          for (int ni = 0; ni < 4; ++ni)
#pragma unroll
            for (int r = 0; r < 4; ++r) v[ni][r] *= sc * gv[ni][r];
          const int pos = row < SEQ ? row : SEQ + ((row - SEQ) & 3);
#pragma unroll
          for (int r = 0; r < 4; ++r) {
            const float partner = __shfl_xor(v[0][r], 32);
            const int i = (fq & 1) * 4 + r;
            const float cs = ROPE[pos * 16 + i], sn = ROPE[pos * 16 + 8 + i];
            v[0][r] = (fq < 2) ? (v[0][r] * cs - partner * sn) : (v[0][r] * cs + partner * sn);
          }
        }
#pragma unroll
        for (int ni = 0; ni < 4; ++ni)
          *(uint2*)(QKV + (size_t)row * 1024 + cb + ni * 16 + fq * 4) = pack4(v[ni][0], v[ni][1], v[ni][2], v[ni][3]);
        if (kind) {
          size_t base = 0;
          bool ok = false;
          if (kind <= 2) {
            if (row >= SEQ) {
              const int sb = (row - SEQ) >> 2, t = (row - SEQ) & 3;
              base = (kind == 1 ? OFF_SAK : OFF_SAV) + ((((size_t)(l * 128 + sb) * 128 + 124 + t) * 2 + kvh) * 64);
              ok = true;
            } else if (row >= SEQ - 128) {
              base = (kind == 1 ? OFF_PAK : OFF_PAV) + (((size_t)(l * 128 + (row - (SEQ - 128))) * 2 + kvh) * 64);
              ok = true;
            }
          } else {
            if (row >= SEQ) {
              const int sb = (row - SEQ) >> 2, t = (row - SEQ) & 3;
              base = (kind == 3 ? OFF_SCK : OFF_SCV) + ((((size_t)(l * 128 + sb) * 2048 + 2044 + t) * 2 + kvh) * 64);
              ok = true;
            } else if (row >= SEQ - 2048) {
              base = (kind == 3 ? OFF_PCK : OFF_PCV) + (((size_t)(l * 2048 + (row - (SEQ - 2048))) * 2 + kvh) * 64);
              ok = true;
            }
          }
          if (ok) {
#pragma unroll
            for (int ni = 0; ni < 4; ++ni)
              *(float4*)(P.out + base + ni * 16 + fq * 4) = make_float4(v[ni][0], v[ni][1], v[ni][2], v[ni][3]);
          }
        }
      }
    } else if (cb < 1536) {
      u16* Z = (u16*)(ws + WS_Z);
#pragma unroll
      for (int mi = 0; mi < 4; ++mi) {
        const int row = row0 + wm * 64 + mi * 16 + fr;
        const float sc = scv[mi];
#pragma unroll
        for (int ni = 0; ni < 4; ++ni)
          *(uint2*)(Z + (size_t)row * 512 + (cb - 1024) + ni * 16 + fq * 4) =
              pack4(acc[mi][ni][0] * sc, acc[mi][ni][1] * sc, acc[mi][ni][2] * sc, acc[mi][ni][3] * sc);
      }
    } else if (cb < 2560) {
      u16* XBC = (u16*)(ws + WS_XBC);
#pragma unroll
      for (int mi = 0; mi < 4; ++mi) {
        const int row = row0 + wm * 64 + mi * 16 + fr;
        const float sc = scv[mi];
        size_t cbase = 0;
        bool ok = false;
        if (row >= SEQ) {
          const int sb = (row - SEQ) >> 2, t = (row - SEQ) & 3;
          if (t >= 1) { ok = true; cbase = OFF_SCONV + ((size_t)(l * 128 + sb) * 3 + (t - 1)) * 1024; }
        } else if (row >= SEQ - 3) {
          ok = true; cbase = OFF_PCONV + (size_t)(l * 3 + (row - (SEQ - 3))) * 1024;
        }
#pragma unroll
        for (int ni = 0; ni < 4; ++ni) {
          const int ch = (cb - 1536) + ni * 16 + fq * 4;
          const float x0 = acc[mi][ni][0] * sc, x1 = acc[mi][ni][1] * sc, x2 = acc[mi][ni][2] * sc, x3 = acc[mi][ni][3] * sc;
          *(uint2*)(XBC + (size_t)row * 1024 + ch) = pack4(x0, x1, x2, x3);
          if (ok) *(float4*)(P.out + cbase + ch) = make_float4(x0, x1, x2, x3);
        }
      }
    } else if (cb == 2560) {
      float* DT = (float*)(ws + WS_DT);
      if (fq < 2) {
#pragma unroll
        for (int mi = 0; mi < 4; ++mi) {
          const int row = row0 + wm * 64 + mi * 16 + fr;
          const float sc = scv[mi];
          *(float4*)(DT + (size_t)row * 8 + fq * 4) = make_float4(acc[mi][0][0] * sc, acc[mi][0][1] * sc, acc[mi][0][2] * sc, acc[mi][0][3] * sc);
        }
      }
    }
  } else if (EPI == EPI_OUT) {
    float* H1 = (float*)(ws + WS_H1);
    u16* AH1 = (u16*)(ws + WS_AH1);
    const float* HF = (const float*)(ws + WS_HF);
#pragma unroll
    for (int mi = 0; mi < 4; ++mi) {
      const int row = row0 + wm * 64 + mi * 16 + fr;
      const float* res = (l == 0) ? (row < SEQ ? P.in[I_XP] + (size_t)row * 1024 : P.in[I_XS] + (size_t)(row - SEQ) * 1024)
                                  : HF + (size_t)row * 1024;
      float psum = 0.f;
#pragma unroll
      for (int ni = 0; ni < 4; ++ni) {
        const int col = col0 + wn * 64 + ni * 16 + fq * 4;
        const float4 rv = *(const float4*)(res + col);
        const float h0 = rv.x + acc[mi][ni][0], h1 = rv.y + acc[mi][ni][1], h2 = rv.z + acc[mi][ni][2], h3 = rv.w + acc[mi][ni][3];
        *(float4*)(H1 + (size_t)row * 1024 + col) = make_float4(h0, h1, h2, h3);
        const uint2 hb = pack4(h0, h1, h2, h3);
        *(uint2*)(AH1 + (size_t)row * 1024 + col) = hb;
        const float q0 = bflo(hb.x), q1 = bfhi(hb.x), q2 = bflo(hb.y), q3 = bfhi(hb.y);
        psum += (q0 * q0 + q1 * q1) + (q2 * q2 + q3 * q3);
      }
      psum += __shfl_xor(psum, 16); psum += __shfl_xor(psum, 32);
      if (fq == 0) ((float*)(ws + WS_PS1))[(size_t)row * 16 + (col0 >> 7) * 2 + wn] = psum;
    }
  } else if (EPI == EPI_GU) {
    u16* G = (u16*)(ws + WS_G);
#pragma unroll
    for (int mi = 0; mi < 4; ++mi) {
      const int row = row0 + wm * 64 + mi * 16 + fr;
      const float sc = scv[mi];
#pragma unroll
      for (int q = 0; q < 2; ++q) {
        const int j = ((col0 + wn * 64) >> 1) + q * 16 + fq * 4;
        float o[4];
#pragma unroll
        for (int r = 0; r < 4; ++r) o[r] = siluf(acc[mi][2 * q][r] * sc) * (acc[mi][2 * q + 1][r] * sc);
        *(uint2*)(G + (size_t)row * DFF + j) = pack4(o[0], o[1], o[2], o[3]);
      }
    }
  } else {
    const float* H1 = (const float*)(ws + WS_H1);
    float* HF = (float*)(ws + WS_HF);
    u16* AH = (u16*)(ws + WS_AH);
#pragma unroll
    for (int mi = 0; mi < 4; ++mi) {
      const int row = row0 + wm * 64 + mi * 16 + fr;
#pragma unroll
      for (int ni = 0; ni < 4; ++ni) {
        const int col = col0 + wn * 64 + ni * 16 + fq * 4;
        const float4 rv = *(const float4*)(H1 + (size_t)row * 1024 + col);
        const float h0 = rv.x + acc[mi][ni][0], h1 = rv.y + acc[mi][ni][1], h2 = rv.z + acc[mi][ni][2], h3 = rv.w + acc[mi][ni][3];
        if (l == 0) {
          *(float4*)(HF + (size_t)row * 1024 + col) = make_float4(h0, h1, h2, h3);
          *(uint2*)(AH + (size_t)row * 1024 + col) = pack4(h0, h1, h2, h3);
        } else {
          *(float4*)(P.out + OFF_Y + (size_t)row * 1024 + col) = make_float4(h0, h1, h2, h3);
        }
      }
    }
  }
}

template <int EPI>
DEVI void gemm_tile(const Params& P, int l, const u16* __restrict__ A, int lda, const u16* __restrict__ Bt, int ldb,
                          int K, int KS, int row0, int col0, unsigned char* smem, const float* PSp = nullptr) {
  const int tid = opaque_tid(), lane = tid & 63, w = tid >> 6, wm = w >> 1, wn = w & 1;
  const int fr = lane & 15, fq = lane >> 4;
  f32x4 acc[4][4];
#pragma unroll
  for (int mi = 0; mi < 4; ++mi)
#pragma unroll
    for (int ni = 0; ni < 4; ++ni) acc[mi][ni] = (f32x4){0.f, 0.f, 0.f, 0.f};
  const int lrow = tid >> 3, lch = tid & 7;
  const int gch = lch ^ (lrow & 7);
  const u16* Ag = A + (size_t)(row0 + lrow) * lda + gch * 8;
  const u16* Bg = Bt + (size_t)(col0 + lrow) * ldb + gch * 8;
  unsigned char* ldsT = smem + tid * 16;
  f32x4 gr0 = (f32x4){0.f, 0.f, 0.f, 0.f}, gr1 = gr0;
  float scv[4] = {1.f, 1.f, 1.f, 1.f};
  const int nk = K >> 6;
  const int ksS = (KS >> 6) - 1;
#pragma unroll
  for (int i = 0; i < 4; ++i) {
    __builtin_amdgcn_global_load_lds((const unsigned*)(Ag + (size_t)(32 * i) * lda), (unsigned*)(ldsT + i * 4096), 16, 0, 0);
    __builtin_amdgcn_global_load_lds((const unsigned*)(Bg + (size_t)(32 * i) * ldb), (unsigned*)(ldsT + 16384 + i * 4096), 16, 0, 0);
  }
  float* rsP = (float*)(smem + 66560);
  if (PSp) {
    if (tid < 128) {
      const float4* pp = (const float4*)(PSp + (size_t)(row0 + tid) * 16);
      const float4 p0 = pp[0], p1 = pp[1], p2 = pp[2], p3 = pp[3];
      const float sq = ((p0.x + p0.y) + (p0.z + p0.w)) + ((p1.x + p1.y) + (p1.z + p1.w)) + ((p2.x + p2.y) + (p2.z + p2.w)) + ((p3.x + p3.y) + (p3.z + p3.w));
      rsP[tid] = rsqrtf(sq * (1.f / 1024.f) + EPS);
    }
  }
  asm volatile("s_waitcnt vmcnt(0)" ::: "memory");
  __syncthreads();
  if (PSp) {
#pragma unroll
    for (int mi = 0; mi < 4; ++mi) scv[mi] = rsP[wm * 64 + mi * 16 + fr];
  }
  for (int ks = 0; ks < nk; ++ks) {
    const bool more = (ks + 1 < nk);
    if (more) {
      unsigned char* dst = ldsT + ((ks + 1) & 1) * 32768;
#pragma unroll
      for (int i = 0; i < 4; ++i) {
        __builtin_amdgcn_global_load_lds((const unsigned*)(Ag + (size_t)(32 * i) * lda + (ks + 1) * 64), (unsigned*)(dst + i * 4096), 16, 0, 0);
        __builtin_amdgcn_global_load_lds((const unsigned*)(Bg + (size_t)(32 * i) * ldb + (ks + 1) * 64), (unsigned*)(dst + 16384 + i * 4096), 16, 0, 0);
      }
    }
    const unsigned char* As = smem + (ks & 1) * 32768;
    const unsigned char* Bs = As + 16384;
#pragma unroll
    for (int kk = 0; kk < 2; ++kk) {
      bf16x8 af[4], bq[4];
#pragma unroll
      for (int mi = 0; mi < 4; ++mi) {
        const int row = wm * 64 + mi * 16 + fr;
        af[mi] = *(const bf16x8*)(As + row * 128 + (((kk * 4 + fq) ^ (row & 7)) << 4));
      }
#pragma unroll
      for (int ni = 0; ni < 4; ++ni) {
        const int row = wn * 64 + ni * 16 + fr;
        bq[ni] = *(const bf16x8*)(Bs + row * 128 + (((kk * 4 + fq) ^ (row & 7)) << 4));
      }
      if (ks <= ksS) {
        if (wn == 0) { gr0 = mfma16(af[0], af[0], gr0); gr1 = mfma16(af[1], af[1], gr1); }
        else { gr0 = mfma16(af[2], af[2], gr0); gr1 = mfma16(af[3], af[3], gr1); }
      }
      __builtin_amdgcn_s_setprio(1);
#pragma unroll
      for (int mi = 0; mi < 4; ++mi)
#pragma unroll
        for (int ni = 0; ni < 4; ++ni) acc[mi][ni] = mfma16(bq[ni], af[mi], acc[mi][ni]);
      __builtin_amdgcn_s_setprio(0);
    }
    float* rsL = (float*)(smem + ((ks + 1) & 1) * 32768);
    if (ks == ksS) {
      if ((fr >> 2) == fq) {
        const int r = fr & 3;
        const float d0 = r == 0 ? gr0[0] : r == 1 ? gr0[1] : r == 2 ? gr0[2] : gr0[3];
        const float d1 = r == 0 ? gr1[0] : r == 1 ? gr1[1] : r == 2 ? gr1[2] : gr1[3];
        rsL[wm * 64 + (wn * 2) * 16 + fr] = rsqrtf(d0 / (float)KS + EPS);
        rsL[wm * 64 + (wn * 2 + 1) * 16 + fr] = rsqrtf(d1 / (float)KS + EPS);
      }
    }
    asm volatile("s_waitcnt vmcnt(0)" ::: "memory");
    __syncthreads();
    if (ks == ksS) {
#pragma unroll
      for (int mi = 0; mi < 4; ++mi) scv[mi] = rsL[wm * 64 + mi * 16 + fr];
      __syncthreads();
    }
  }
  gemm_epilogue<EPI>(P, l, acc, scv, row0, col0, wm, wn, fr, fq);
}

DEVI void wconv_item(const Params& P, int mode, int l, int kt, int nt, unsigned char* smem) {
  float* tile = (float*)smem;
  const int tid = opaque_tid();
  const float* src; int ldsrc, Nsrc; u16* dst; int lddst;
  const float* gain = nullptr;
  unsigned char* ws = P.ws;
  if (mode == 0) { src = P.in[I_WIN] + (size_t)l * 1024 * NIN; ldsrc = NIN; Nsrc = NIN; dst = (u16*)(ws + WS_WIN) + (size_t)l * NINP * 1024; lddst = 1024; gain = P.in[I_NORM1] + l * 1024; }
  else if (mode == 1) { src = P.in[I_WOUT] + (size_t)l * 1024 * 1024; ldsrc = 1024; Nsrc = 1024; dst = (u16*)(ws + WS_WOUT) + (size_t)l * 1024 * 1024; lddst = 1024; }
  else if (mode == 2) { src = P.in[I_WGATE] + (size_t)l * 1024 * DFF; ldsrc = DFF; Nsrc = DFF; dst = (u16*)(ws + WS_WGU) + (size_t)l * 5632 * 1024; lddst = 1024; gain = P.in[I_NORM2] + l * 1024; }
  else if (mode == 3) { src = P.in[I_WUP] + (size_t)l * 1024 * DFF; ldsrc = DFF; Nsrc = DFF; dst = (u16*)(ws + WS_WGU) + (size_t)l * 5632 * 1024; lddst = 1024; gain = P.in[I_NORM2] + l * 1024; }
  else { src = P.in[I_WDOWN] + (size_t)l * DFF * 1024; ldsrc = 1024; Nsrc = 1024; dst = (u16*)(ws + WS_WDN) + (size_t)l * 1024 * DFF; lddst = DFF; }
  const int k0 = kt * 64, n0 = nt * 64;
  {
    const int j = tid & 63, ig = tid >> 6;
    const int n = n0 + j;
#pragma unroll
    for (int ii = 0; ii < 16; ++ii) {
      const int i = ig * 16 + ii, k = k0 + i;
      float v = 0.f;
      if (n < Nsrc) {
        v = src[(size_t)k * ldsrc + n];
        if (mode == 1) { if (k >= 256 && k < 768) v *= P.in[I_SSMN][l * 512 + (k - 256)]; }
        else if (gain) v *= gain[k];
      }
      tile[i * 65 + j] = v;
    }
  }
  __syncthreads();
  {
    const int i8 = tid & 7;
    int kd = k0 + i8 * 8;
    if (mode == 1) kd = (kd < 256) ? kd + 512 : (kd < 768 ? kd - 256 : kd);
#pragma unroll
    for (int jj = 0; jj < 2; ++jj) {
      const int j = (tid >> 3) + 32 * jj;
      const int n = n0 + j;
      int nd = n;
      if (mode == 2) nd = ((n >> 4) << 5) + (n & 15);
      else if (mode == 3) nd = ((n >> 4) << 5) + (n & 15) + 16;
      uint4 o;
      o.x = pack2(tile[(i8 * 8 + 0) * 65 + j], tile[(i8 * 8 + 1) * 65 + j]);
      o.y = pack2(tile[(i8 * 8 + 2) * 65 + j], tile[(i8 * 8 + 3) * 65 + j]);
      o.z = pack2(tile[(i8 * 8 + 4) * 65 + j], tile[(i8 * 8 + 5) * 65 + j]);
      o.w = pack2(tile[(i8 * 8 + 6) * 65 + j], tile[(i8 * 8 + 7) * 65 + j]);
      *(uint4*)(dst + (size_t)nd * lddst + kd) = o;
    }
  }
  __syncthreads();
}

DEVI void xconv_item(const Params& P, int item) {
  u16* AH = (u16*)(P.ws + WS_AH);
#pragma unroll
  for (int i = 0; i < 4; ++i) {
    const size_t e = ((size_t)item * 1024 + i * 256 + threadIdx.x) * 8;
    const float* src = (e < (size_t)SEQ * 1024) ? P.in[I_XP] + e : P.in[I_XS] + (e - (size_t)SEQ * 1024);
    const float4 a = *(const float4*)src, b = *(const float4*)(src + 4);
    uint4 o;
    o.x = pack2(a.x, a.y); o.y = pack2(a.z, a.w); o.z = pack2(b.x, b.y); o.w = pack2(b.z, b.w);
    *(uint4*)(AH + e) = o;
  }
}

DEVI void rope_item(const Params& P, int item) {
  const int e = item * 256 + threadIdx.x;
  if (e >= 16388 * 8) return;
  const int pos = e >> 3, i = e & 7;
  const double inv[8] = {1.0, 0.19392274474868576, 0.03760603093086393, 0.007292664737217109,
                         0.001414213562373095, 0.0002742481756762073, 5.318295896944988e-05, 1.031338537721246e-05};
  double invv = inv[0];
#pragma unroll
  for (int q = 1; q < 8; ++q) invv = (i == q) ? inv[q] : invv;
  const double ang = (double)pos * invv;
  const double n = rint(ang * 0.15915494309189535);
  double r = fma(-n, 6.283185307179586, ang);
  r = fma(-n, 2.4492935982947064e-16, r);
  const double r2 = r * r;
  double S = 1.0, C = 1.0;
#pragma unroll
  for (int k = 14; k >= 1; --k) {
    S = 1.0 - r2 * (1.0 / ((2.0 * k) * (2.0 * k + 1.0))) * S;
    C = 1.0 - r2 * (1.0 / ((2.0 * k - 1.0) * (2.0 * k))) * C;
  }
  float* ROPE = (float*)(P.ws + WS_ROPE);
  ROPE[pos * 16 + i] = (float)C;
  ROPE[pos * 16 + 8 + i] = (float)(r * S);
}

DEVI void attn_item(const Params& P, int l, int variant, int idx, unsigned char* smem) {
  const int tid = opaque_tid(), lane = tid & 63, w = tid >> 6, fr = lane & 15, fq = lane >> 4;
  const int h = idx & 3, qb = idx >> 2;
  const int dil = (variant <= 1) ? 1 : (variant == 2 ? 4 : 16);
  const int maxd = (variant == 0) ? 127 : 128;
  const int nbr = SEQ / dil / 64;
  const int res = qb / nbr, ib = qb % nbr;
  const int i0 = ib * 64;
  const int qofs = (variant == 0 ? 0 : 512) + h * 64;
  const int kofs = (variant == 0 ? 256 : 768) + (h >> 1) * 64;
  const int vofs = kofs + 128;
  const u16* QKV = (const u16*)(P.ws + WS_QKV);
  u16* Qs = (u16*)smem;
  u16* Ks = (u16*)(smem + 9216);
  u16* Vt = (u16*)(smem + 9216 + 27648);
  u16* Ps = Ks;
  {
    const int r = tid >> 2, c = (tid & 3) * 16;
    {
      const size_t pos = (size_t)res + (size_t)dil * (i0 + r);
      const uint4* g = (const uint4*)(QKV + pos * 1024 + qofs + c);
      const uint4 a = g[0], b = g[1];
      *(uint4*)(Qs + r * 72 + c) = a;
      *(uint4*)(Qs + r * 72 + c + 8) = b;
    }
#pragma unroll
    for (int pss = 0; pss < 3; ++pss) {
      const int kk = pss * 64 + r;
      const int ik = i0 - 128 + kk;
      uint4 a = make_uint4(0, 0, 0, 0), b = a, va = a, vb = a;
      if (ik >= 0) {
        const size_t pos = (size_t)res + (size_t)dil * ik;
        const uint4* g = (const uint4*)(QKV + pos * 1024 + kofs + c);
        a = g[0]; b = g[1];
        const uint4* gv = (const uint4*)(QKV + pos * 1024 + vofs + c);
        va = gv[0]; vb = gv[1];
      }
      *(uint4*)(Ks + kk * 72 + c) = a;
      *(uint4*)(Ks + kk * 72 + c + 8) = b;
      const unsigned vv[8] = {va.x, va.y, va.z, va.w, vb.x, vb.y, vb.z, vb.w};
#pragma unroll
      for (int e = 0; e < 8; ++e) {
        Vt[(c + 2 * e) * 200 + kk] = (u16)(vv[e] & 0xffffu);
        Vt[(c + 2 * e + 1) * 200 + kk] = (u16)(vv[e] >> 16);
      }
    }
  }
  __syncthreads();
  f32x4 s[12];
  {
    bf16x8 qa[2];
#pragma unroll
    for (int kk = 0; kk < 2; ++kk) qa[kk] = *(const bf16x8*)(Qs + (w * 16 + fr) * 72 + kk * 32 + fq * 8);
#pragma unroll
    for (int kb = 0; kb < 12; ++kb) {
      f32x4 a = (f32x4){0.f, 0.f, 0.f, 0.f};
#pragma unroll
      for (int kk = 0; kk < 2; ++kk) {
        const bf16x8 kf = *(const bf16x8*)(Ks + (kb * 16 + fr) * 72 + kk * 32 + fq * 8);
        a = mfma16(kf, qa[kk], a);
      }
      s[kb] = a;
    }
  }
  float sink = 0.f;
  if (variant == 0) sink = P.in[I_SINK][l * 4 + h];
  const int iq = i0 + w * 16 + fr;
  float mx = -INFINITY;
#pragma unroll
  for (int kb = 0; kb < 12; ++kb)
#pragma unroll
    for (int r = 0; r < 4; ++r) {
      const int ik = i0 - 128 + kb * 16 + fq * 4 + r;
      const int dist = iq - ik;
      const bool valid = (dist >= 0) && (dist <= maxd) && (ik >= 0);
      const float v = valid ? s[kb][r] * 0.125f : -INFINITY;
      s[kb][r] = v;
      mx = fmaxf(mx, v);
    }
  mx = fmaxf(mx, __shfl_xor(mx, 16)); mx = fmaxf(mx, __shfl_xor(mx, 32));
  if (variant == 0) mx = fmaxf(mx, sink);
  float den = 0.f;
#pragma unroll
  for (int kb = 0; kb < 12; ++kb)
#pragma unroll
    for (int r = 0; r < 4; ++r) {
      const float e = __expf(s[kb][r] - mx);
      s[kb][r] = e;
      den += e;
    }
  den += __shfl_xor(den, 16); den += __shfl_xor(den, 32);
  if (variant == 0) den += __expf(sink - mx);
  __syncthreads();
#pragma unroll
  for (int kb = 0; kb < 12; ++kb)
    *(uint2*)(Ps + (w * 16 + fr) * 200 + kb * 16 + fq * 4) = pack4(s[kb][0], s[kb][1], s[kb][2], s[kb][3]);
  __syncthreads();
  f32x4 o[4];
#pragma unroll
  for (int nb = 0; nb < 4; ++nb) o[nb] = (f32x4){0.f, 0.f, 0.f, 0.f};
#pragma unroll
  for (int ks = 0; ks < 6; ++ks) {
    const bf16x8 pa = *(const bf16x8*)(Ps + (w * 16 + fr) * 200 + ks * 32 + fq * 8);
#pragma unroll
    for (int nb = 0; nb < 4; ++nb) {
      const bf16x8 vf = *(const bf16x8*)(Vt + (nb * 16 + fr) * 200 + ks * 32 + fq * 8);
      o[nb] = mfma16(vf, pa, o[nb]);
    }
  }
  {
    const size_t pos = (size_t)res + (size_t)dil * iq;
    const float inv = 1.f / den;
    if (variant == 0) {
      u16* MIX = (u16*)(P.ws + WS_MIX);
#pragma unroll
      for (int nb = 0; nb < 4; ++nb)
        *(uint2*)(MIX + pos * 1024 + 512 + h * 64 + nb * 16 + fq * 4) = pack4(o[nb][0] * inv, o[nb][1] * inv, o[nb][2] * inv, o[nb][3] * inv);
    } else {
      u16* CO = (u16*)(P.ws + WS_CO) + (size_t)(variant - 1) * SEQ * 256;
#pragma unroll
      for (int nb = 0; nb < 4; ++nb)
        *(uint2*)(CO + pos * 256 + h * 64 + nb * 16 + fq * 4) = pack4(o[nb][0] * inv, o[nb][1] * inv, o[nb][2] * inv, o[nb][3] * inv);
      if (fq == 0) {
        float* LSE = (float*)(P.ws + WS_LSE) + (size_t)(variant - 1) * SEQ * 4;
        LSE[pos * 4 + h] = mx + __logf(den);
      }
    }
  }
  __syncthreads();
}

DEVI void cmerge_item(const Params& P, int item) {
  const int tid = opaque_tid();
  const int tok = item * 8 + (tid >> 5), ch = tid & 31;
  const int h = ch >> 3;
  const float* LSE = (const float*)(P.ws + WS_LSE);
  const u16* CO = (const u16*)(P.ws + WS_CO);
  const float l0 = LSE[(size_t)tok * 4 + h], l1 = LSE[(size_t)(SEQ + tok) * 4 + h], l2 = LSE[(size_t)(2 * SEQ + tok) * 4 + h];
  const float mx = fmaxf(l0, fmaxf(l1, l2));
  float w0 = __expf(l0 - mx), w1 = __expf(l1 - mx), w2 = __expf(l2 - mx);
  const float inv = 1.f / (w0 + w1 + w2);
  w0 *= inv; w1 *= inv; w2 *= inv;
  const uint4 a = *(const uint4*)(CO + (size_t)tok * 256 + ch * 8);
  const uint4 b = *(const uint4*)(CO + ((size_t)SEQ + tok) * 256 + ch * 8);
  const uint4 c = *(const uint4*)(CO + ((size_t)2 * SEQ + tok) * 256 + ch * 8);
  uint4 o;
  o.x = pack2(w0 * bflo(a.x) + w1 * bflo(b.x) + w2 * bflo(c.x), w0 * bfhi(a.x) + w1 * bfhi(b.x) + w2 * bfhi(c.x));
  o.y = pack2(w0 * bflo(a.y) + w1 * bflo(b.y) + w2 * bflo(c.y), w0 * bfhi(a.y) + w1 * bfhi(b.y) + w2 * bfhi(c.y));
  o.z = pack2(w0 * bflo(a.z) + w1 * bflo(b.z) + w2 * bflo(c.z), w0 * bfhi(a.z) + w1 * bfhi(b.z) + w2 * bfhi(c.z));
  o.w = pack2(w0 * bflo(a.w) + w1 * bflo(b.w) + w2 * bflo(c.w), w0 * bfhi(a.w) + w1 * bfhi(b.w) + w2 * bfhi(c.w));
  u16* MIX = (u16*)(P.ws + WS_MIX);
  *(uint4*)(MIX + (size_t)tok * 1024 + 768 + ch * 8) = o;
}

DEVI void sattn_item(const Params& P, int l, int isC, int item, unsigned char* smem) {
  const int tid = opaque_tid(), lane = tid & 63, t = tid >> 6;
  const int b = item >> 1, kvh = item & 1;
  float* qf = (float*)smem + t * 128;
  float* sb = (float*)smem + 512 + t * 784;
  const int row = SEQ + b * 4 + t;
  const u16* QKV = (const u16*)(P.ws + WS_QKV);
  const int nkeys = isC ? 387 : 128;
  const int buf = isC ? 2048 : 128;
  const float* cK = (isC ? P.in[I_CCK] : P.in[I_CAK]) + ((size_t)(l * 128 + b) * buf) * 128 + kvh * 64;
  const float* cV = (isC ? P.in[I_CCV] : P.in[I_CAV]) + ((size_t)(l * 128 + b) * buf) * 128 + kvh * 64;
  const float* nK = P.out + (isC ? OFF_SCK : OFF_SAK) + ((size_t)(l * 128 + b) * buf + (buf - 4)) * 128 + kvh * 64;
  const float* nV = P.out + (isC ? OFF_SCV : OFF_SAV) + ((size_t)(l * 128 + b) * buf + (buf - 4)) * 128 + kvh * 64;
#pragma unroll
  for (int hh = 0; hh < 2; ++hh)
    qf[hh * 64 + lane] = bf2f(QKV[(size_t)row * 1024 + (isC ? 512 : 0) + (kvh * 2 + hh) * 64 + lane]);
  __syncthreads();
  float m0 = -INFINITY, m1 = -INFINITY;
  for (int j = lane; j < nkeys; j += 64) {
    int idx;
    if (isC) { const int pi = j / 129, jj = j - pi * 129; const int d = (pi == 0) ? 1 : (pi == 1 ? 4 : 16); idx = 2048 + t - d * jj; }
    else idx = t + 1 + j;
    const float* kp = (idx < buf) ? cK + (size_t)idx * 128 : nK + (size_t)(idx - buf) * 128;
    float s0 = 0.f, s1 = 0.f;
#pragma unroll
    for (int c4 = 0; c4 < 16; ++c4) {
      const float4 kv = ((const float4*)kp)[c4];
      const float4 q0 = ((const float4*)qf)[c4], q1 = ((const float4*)(qf + 64))[c4];
      s0 += kv.x * q0.x + kv.y * q0.y + kv.z * q0.z + kv.w * q0.w;
      s1 += kv.x * q1.x + kv.y * q1.y + kv.z * q1.z + kv.w * q1.w;
    }
    s0 *= 0.125f; s1 *= 0.125f;
    sb[j] = s0; sb[392 + j] = s1;
    m0 = fmaxf(m0, s0); m1 = fmaxf(m1, s1);
  }
  m0 = wave_max(m0); m1 = wave_max(m1);
  float sk0 = 0.f, sk1 = 0.f;
  if (!isC) {
    sk0 = P.in[I_SINK][l * 4 + kvh * 2]; sk1 = P.in[I_SINK][l * 4 + kvh * 2 + 1];
    m0 = fmaxf(m0, sk0); m1 = fmaxf(m1, sk1);
  }
  float d0 = 0.f, d1 = 0.f;
  for (int j = lane; j < nkeys; j += 64) {
    const float e0 = __expf(sb[j] - m0), e1 = __expf(sb[392 + j] - m1);
    sb[j] = e0; sb[392 + j] = e1;
    d0 += e0; d1 += e1;
  }
  d0 = wave_sum(d0); d1 = wave_sum(d1);
  if (!isC) { d0 += __expf(sk0 - m0); d1 += __expf(sk1 - m1); }
  __syncthreads();
  const int g4 = lane >> 4, c4 = lane & 15;
  float a0[4] = {0.f, 0.f, 0.f, 0.f}, a1[4] = {0.f, 0.f, 0.f, 0.f};
  const int nsteps = (nkeys + 3) >> 2;
#pragma unroll 8
  for (int js = 0; js < nsteps; ++js) {
    const int jraw = js * 4 + g4;
    const int j = jraw < nkeys ? jraw : nkeys - 1;
    int idx;
    if (isC) { const int pi = j / 129, jj = j - pi * 129; const int d = (pi == 0) ? 1 : (pi == 1 ? 4 : 16); idx = 2048 + t - d * jj; }
    else idx = t + 1 + j;
    const float* vp = (idx < buf) ? cV + (size_t)idx * 128 : nV + (size_t)(idx - buf) * 128;
    const float4 v = ((const float4*)vp)[c4];
    const float p0 = jraw < nkeys ? sb[j] : 0.f, p1 = jraw < nkeys ? sb[392 + j] : 0.f;
    a0[0] += p0 * v.x; a0[1] += p0 * v.y; a0[2] += p0 * v.z; a0[3] += p0 * v.w;
    a1[0] += p1 * v.x; a1[1] += p1 * v.y; a1[2] += p1 * v.z; a1[3] += p1 * v.w;
  }
#pragma unroll
  for (int i = 0; i < 4; ++i) {
    a0[i] += __shfl_xor(a0[i], 16); a0[i] += __shfl_xor(a0[i], 32);
    a1[i] += __shfl_xor(a1[i], 16); a1[i] += __shfl_xor(a1[i], 32);
  }
  u16* MIX = (u16*)(P.ws + WS_MIX);
  const int mo = isC ? 768 : 512;
  if (g4 == 0) {
    const float i0 = 1.f / d0, i1 = 1.f / d1;
    uint2 w0, w1;
    w0.x = pack2(a0[0] * i0, a0[1] * i0); w0.y = pack2(a0[2] * i0, a0[3] * i0);
    w1.x = pack2(a1[0] * i1, a1[1] * i1); w1.y = pack2(a1[2] * i1, a1[3] * i1);
    *(uint2*)(MIX + (size_t)row * 1024 + mo + (kvh * 2) * 64 + c4 * 4) = w0;
    *(uint2*)(MIX + (size_t)row * 1024 + mo + (kvh * 2 + 1) * 64 + c4 * 4) = w1;
  }
  __syncthreads();
}

DEVI void smamba_item(const Params& P, int l, int item, unsigned char* smem) {
  const int tid = opaque_tid();
  const int b = item >> 3, h = item & 7, g = h >> 2;
  float* xa = (float*)smem;
  float* Ba = xa + 256;
  float* Ca = Ba + 512;
  const u16* XBC = (const u16*)(P.ws + WS_XBC);
  const float* DT = (const float*)(P.ws + WS_DT);
  const u16* Z = (const u16*)(P.ws + WS_Z);
  const int row0 = SEQ + b * 4;
  for (int ci = tid; ci < 320; ci += 256) {
    int ch; float* dst; int dl;
    if (ci < 64) { ch = h * 64 + ci; dst = xa + ci; dl = 64; }
    else if (ci < 192) { ch = 512 + g * 128 + (ci - 64); dst = Ba + (ci - 64); dl = 128; }
    else { ch = 768 + g * 128 + (ci - 192); dst = Ca + (ci - 192); dl = 128; }
    float sq[7];
#pragma unroll
    for (int j = 0; j < 3; ++j) sq[j] = P.in[I_SCONV][((size_t)(l * 128 + b) * 3 + j) * 1024 + ch];
#pragma unroll
    for (int j = 0; j < 4; ++j) sq[3 + j] = bf2f(XBC[(size_t)(row0 + j) * 1024 + ch]);
    const float w0 = P.in[I_CONVW][(l * 4 + 0) * 1024 + ch], w1 = P.in[I_CONVW][(l * 4 + 1) * 1024 + ch];
    const float w2 = P.in[I_CONVW][(l * 4 + 2) * 1024 + ch], w3 = P.in[I_CONVW][(l * 4 + 3) * 1024 + ch];
    const float bs = P.in[I_CONVB][l * 1024 + ch];
#pragma unroll
    for (int t = 0; t < 4; ++t) dst[t * dl] = siluf(bs + w0 * sq[t] + w1 * sq[t + 1] + w2 * sq[t + 2] + w3 * sq[t + 3]);
  }
  __syncthreads();
  const int p = tid >> 2, nq = tid & 3;
  float hs[32];
  const float* sp = P.in[I_SSM] + (((size_t)(l * 128 + b) * 8 + h) * 64 + p) * 128 + nq * 32;
#pragma unroll
  for (int i = 0; i < 8; ++i) {
    const float4 v = ((const float4*)sp)[i];
    hs[4 * i] = v.x; hs[4 * i + 1] = v.y; hs[4 * i + 2] = v.z; hs[4 * i + 3] = v.w;
  }
  const float dtb = P.in[I_DTB][l * 8 + h], aneg = -__expf(P.in[I_ALOG][l * 8 + h]), dsk = P.in[I_DSKIP][l * 8 + h];
  u16* MIX = (u16*)(P.ws + WS_MIX);
#pragma unroll
  for (int t = 0; t < 4; ++t) {
    const float dt = softplusf(DT[(size_t)(row0 + t) * 8 + h] + dtb);
    const float dA = __expf(aneg * dt);
    const float xv = xa[t * 64 + p];
    const float xdt = xv * dt;
    float yp = 0.f;
#pragma unroll
    for (int i = 0; i < 32; ++i) {
      hs[i] = hs[i] * dA + xdt * Ba[t * 128 + nq * 32 + i];
      yp += Ca[t * 128 + nq * 32 + i] * hs[i];
    }
    yp += __shfl_xor(yp, 1); yp += __shfl_xor(yp, 2);
    float y = yp + xv * dsk;
    y *= siluf(bf2f(Z[(size_t)(row0 + t) * 512 + h * 64 + p]));
    if (nq == 0) MIX[(size_t)(row0 + t) * 1024 + h * 64 + p] = f2bf(y);
  }
  float* op = P.out + OFF_SSSM + (((size_t)(l * 128 + b) * 8 + h) * 64 + p) * 128 + nq * 32;
#pragma unroll
  for (int i = 0; i < 8; ++i) ((float4*)op)[i] = make_float4(hs[4 * i], hs[4 * i + 1], hs[4 * i + 2], hs[4 * i + 3]);
  __syncthreads();
}

DEVI void ssd_dt_acum(const Params& P, int l, int c, int h, float* dtv, float* acum) {
  const int tid = opaque_tid(), lane = tid & 63;
  const float* DT = (const float*)(P.ws + WS_DT);
  const float aneg = -__expf(P.in[I_ALOG][l * 8 + h]);
  float a = 0.f;
  if (tid < 128) {
    const float dt = softplusf(DT[(size_t)(c * 128 + tid) * 8 + h] + P.in[I_DTB][l * 8 + h]);
    dtv[tid] = dt;
    a = aneg * dt;
  }
#pragma unroll
  for (int o = 1; o < 64; o <<= 1) {
    const float n = __shfl_up(a, o);
    if (lane >= o) a += n;
  }
  if (tid == 63) dtv[128] = a;
  __syncthreads();
  if (tid >= 64 && tid < 128) a += dtv[128];
  if (tid < 128) acum[tid] = a;
  __syncthreads();
}

template <class F>
DEVI void conv_rows(const Params& P, int l, int tok0, int n, int ch, F f) {
  const u16* XBC = (const u16*)(P.ws + WS_XBC);
  const float w0 = P.in[I_CONVW][(l * 4 + 0) * 1024 + ch], w1 = P.in[I_CONVW][(l * 4 + 1) * 1024 + ch];
  const float w2 = P.in[I_CONVW][(l * 4 + 2) * 1024 + ch], w3 = P.in[I_CONVW][(l * 4 + 3) * 1024 + ch];
  const float bs = P.in[I_CONVB][l * 1024 + ch];
  float x0 = (tok0 - 3 >= 0) ? bf2f(XBC[(size_t)(tok0 - 3) * 1024 + ch]) : 0.f;
  float x1 = (tok0 - 2 >= 0) ? bf2f(XBC[(size_t)(tok0 - 2) * 1024 + ch]) : 0.f;
  float x2 = (tok0 - 1 >= 0) ? bf2f(XBC[(size_t)(tok0 - 1) * 1024 + ch]) : 0.f;
  for (int b = 0; b < n; b += 32) {
    u16 raw[32];
#pragma unroll
    for (int t = 0; t < 32; ++t) raw[t] = XBC[(size_t)(tok0 + b + t) * 1024 + ch];
#pragma unroll
    for (int t = 0; t < 32; ++t) {
      const float x3 = bf2f(raw[t]);
      f(b + t, siluf(bs + w0 * x0 + w1 * x1 + w2 * x2 + w3 * x3));
      x0 = x1; x1 = x2; x2 = x3;
    }
  }
}

template <int N>
struct ConvBuf2 { unsigned raw[N + 3]; float wa[5], wb[5]; };
template <int N>
DEVI void conv2_load(const Params& P, int l, int tok0, int ch, ConvBuf2<N>& cb) {
  const u16* XBC = (const u16*)(P.ws + WS_XBC);
#pragma unroll
  for (int j = 0; j < 3; ++j) cb.raw[j] = (tok0 - 3 + j >= 0) ? *(const unsigned*)(XBC + (size_t)(tok0 - 3 + j) * 1024 + ch) : 0u;
#pragma unroll
  for (int t = 0; t < N; ++t) cb.raw[3 + t] = *(const unsigned*)(XBC + (size_t)(tok0 + t) * 1024 + ch);
#pragma unroll
  for (int j = 0; j < 4; ++j) {
    cb.wa[j] = P.in[I_CONVW][(l * 4 + j) * 1024 + ch];
    cb.wb[j] = P.in[I_CONVW][(l * 4 + j) * 1024 + ch + 1];
  }
  cb.wa[4] = P.in[I_CONVB][l * 1024 + ch];
  cb.wb[4] = P.in[I_CONVB][l * 1024 + ch + 1];
}
template <int N, class F>
DEVI void conv2_apply(const ConvBuf2<N>& cb, F f) {
#pragma unroll
  for (int t = 0; t < N; ++t) {
    const float va = siluf(cb.wa[4] + cb.wa[0] * bflo(cb.raw[t]) + cb.wa[1] * bflo(cb.raw[t + 1]) + cb.wa[2] * bflo(cb.raw[t + 2]) + cb.wa[3] * bflo(cb.raw[t + 3]));
    const float vb = siluf(cb.wb[4] + cb.wb[0] * bfhi(cb.raw[t]) + cb.wb[1] * bfhi(cb.raw[t + 1]) + cb.wb[2] * bfhi(cb.raw[t + 2]) + cb.wb[3] * bfhi(cb.raw[t + 3]));
    f(t, va, vb);
  }
}

DEVI void ssd_cs_item(const Params& P, int l, int item, unsigned char* smem) {
  const int tid = opaque_tid(), lane = tid & 63, w = tid >> 6, fr = lane & 15, fq = lane >> 4;
  const int c = item >> 3, h = item & 7, g = h >> 2;
  u16* xT = (u16*)smem;
  u16* BT = (u16*)(smem + 17408);
  float* acum = (float*)(smem + 17408 + 34816);
  float* dtv = acum + 128;
  ConvBuf2<16> cX;
  ConvBuf2<32> cB;
  conv2_load<16>(P, l, c * 128 + (tid >> 5) * 16, h * 64 + 2 * (tid & 31), cX);
  conv2_load<32>(P, l, c * 128 + (tid >> 6) * 32, 512 + g * 128 + 2 * (tid & 63), cB);
  ssd_dt_acum(P, l, c, h, dtv, acum);
  const float aend = acum[127];
  {
    const int cp = tid & 31, rg = tid >> 5;
    conv2_apply<16>(cX, [&](int t, float va, float vb) {
      const int s = rg * 16 + t;
      const float e = dtv[s] * __expf(aend - acum[s]);
      xT[(2 * cp) * 136 + s] = f2bf(va * e);
      xT[(2 * cp + 1) * 136 + s] = f2bf(vb * e);
    });
  }
  {
    const int cp = tid & 63, rg = tid >> 6;
    conv2_apply<32>(cB, [&](int t, float va, float vb) {
      BT[(2 * cp) * 136 + rg * 32 + t] = f2bf(va);
      BT[(2 * cp + 1) * 136 + rg * 32 + t] = f2bf(vb);
    });
  }
  __syncthreads();
  float* CS = (float*)(P.ws + WS_CS) + (size_t)(c * 8 + h) * 8192;
  bf16x8 xa[4];
#pragma unroll
  for (int ks = 0; ks < 4; ++ks) xa[ks] = *(const bf16x8*)(xT + (w * 16 + fr) * 136 + ks * 32 + fq * 8);
#pragma unroll
  for (int nb = 0; nb < 8; ++nb) {
    f32x4 a = (f32x4){0.f, 0.f, 0.f, 0.f};
#pragma unroll
    for (int ks = 0; ks < 4; ++ks) {
      const bf16x8 bfg = *(const bf16x8*)(BT + (nb * 16 + fr) * 136 + ks * 32 + fq * 8);
      a = mfma16(bfg, xa[ks], a);
    }
    *(float4*)(CS + (w * 16 + fr) * 128 + nb * 16 + fq * 4) = make_float4(a[0], a[1], a[2], a[3]);
  }
  if (tid == 0) ((float*)(P.ws + WS_CD))[c * 8 + h] = __expf(aend);
  __syncthreads();
}

DEVI void ssd_scan_item(const Params& P, int l, int item) {
  const int e = item * 256 + threadIdx.x;
  const int h = e >> 13;
  const float* CS = (const float*)(P.ws + WS_CS);
  const float* CD = (const float*)(P.ws + WS_CD);
  u16* HIN = (u16*)(P.ws + WS_HIN);
  float hc = 0.f;
#pragma unroll 32
  for (int c = 0; c < 128; ++c) {
    HIN[(size_t)c * 65536 + e] = f2bf(hc);
    hc = hc * CD[c * 8 + h] + CS[(size_t)c * 65536 + e];
  }
  P.out[OFF_PSSM + (size_t)l * 65536 + e] = hc;
}

DEVI void ssd_y_item(const Params& P, int l, int item, unsigned char* smem) {
  const int tid = opaque_tid(), lane = tid & 63, w = tid >> 6, fr = lane & 15, fq = lane >> 4;
  const int half = item & 1, h = (item >> 1) & 7, c = item >> 4, g = h >> 2;
  const int l0 = half * 64;
  u16* Cs = (u16*)smem;
  u16* Hs = (u16*)(smem + 17408);
  u16* Bs = (u16*)(smem + 34816);
  float* acum = (float*)(smem + 69632);
  float* dtv = acum + 128;
  u16* Gs = Hs;
  u16* xT = Bs;
  ConvBuf2<16> cC, cX;
  ConvBuf2<32> cB;
  u32x4 hin[4];
  conv2_load<16>(P, l, c * 128 + l0 + (tid >> 6) * 16, 768 + g * 128 + 2 * (tid & 63), cC);
  conv2_load<32>(P, l, c * 128 + (tid >> 6) * 32, 512 + g * 128 + 2 * (tid & 63), cB);
  conv2_load<16>(P, l, c * 128 + (tid >> 5) * 16, h * 64 + 2 * (tid & 31), cX);
  {
    const u16* HIN = (const u16*)(P.ws + WS_HIN) + (size_t)(c * 8 + h) * 8192;
    const int r = tid >> 2, cq = (tid & 3) * 32;
#pragma unroll
    for (int i = 0; i < 4; ++i) hin[i] = *(const u32x4*)(HIN + r * 128 + cq + i * 8);
  }
  ssd_dt_acum(P, l, c, h, dtv, acum);
  {
    const int cp = tid & 63, rg = tid >> 6;
    conv2_apply<16>(cC, [&](int t, float va, float vb) {
      *(unsigned*)(Cs + (rg * 16 + t) * 136 + 2 * cp) = pack2(va, vb);
    });
    conv2_apply<32>(cB, [&](int t, float va, float vb) {
      *(unsigned*)(Bs + (rg * 32 + t) * 136 + 2 * cp) = pack2(va, vb);
    });
    const int r = tid >> 2, cq = (tid & 3) * 32;
#pragma unroll
    for (int i = 0; i < 4; ++i) *(u32x4*)(Hs + r * 136 + cq + i * 8) = hin[i];
  }
  __syncthreads();
  f32x4 y[4];
  f32x4 cb[8];
  {
    bf16x8 ca[4];
#pragma unroll
    for (int ks = 0; ks < 4; ++ks) ca[ks] = *(const bf16x8*)(Cs + (w * 16 + fr) * 136 + ks * 32 + fq * 8);
#pragma unroll
    for (int nb = 0; nb < 4; ++nb) {
      f32x4 a = (f32x4){0.f, 0.f, 0.f, 0.f};
#pragma unroll
      for (int ks = 0; ks < 4; ++ks) a = mfma16(*(const bf16x8*)(Hs + (nb * 16 + fr) * 136 + ks * 32 + fq * 8), ca[ks], a);
      y[nb] = a;
    }
#pragma unroll
    for (int sbk = 0; sbk < 8; ++sbk) {
      f32x4 a = (f32x4){0.f, 0.f, 0.f, 0.f};
#pragma unroll
      for (int ks = 0; ks < 4; ++ks) a = mfma16(*(const bf16x8*)(Bs + (sbk * 16 + fr) * 136 + ks * 32 + fq * 8), ca[ks], a);
      cb[sbk] = a;
    }
  }
  const int ll = l0 + w * 16 + fr;
  const float al = acum[ll];
  __syncthreads();
#pragma unroll
  for (int sbk = 0; sbk < 8; ++sbk) {
    float gq[4];
#pragma unroll
    for (int r = 0; r < 4; ++r) {
      const int sx = sbk * 16 + fq * 4 + r;
      gq[r] = (sx <= ll) ? cb[sbk][r] * __expf(al - acum[sx]) : 0.f;
    }
    *(uint2*)(Gs + (w * 16 + fr) * 136 + sbk * 16 + fq * 4) = pack4(gq[0], gq[1], gq[2], gq[3]);
  }
  {
    const int cp = tid & 31, rg = tid >> 5;
    conv2_apply<16>(cX, [&](int t, float va, float vb) {
      const int sx = rg * 16 + t;
      xT[(2 * cp) * 136 + sx] = f2bf(va * dtv[sx]);
      xT[(2 * cp + 1) * 136 + sx] = f2bf(vb * dtv[sx]);
    });
  }
  __syncthreads();
  f32x4 yd[4];
#pragma unroll
  for (int nb = 0; nb < 4; ++nb) yd[nb] = (f32x4){0.f, 0.f, 0.f, 0.f};
#pragma unroll
  for (int ks = 0; ks < 4; ++ks) {
    const bf16x8 ga = *(const bf16x8*)(Gs + (w * 16 + fr) * 136 + ks * 32 + fq * 8);
#pragma unroll
    for (int nb = 0; nb < 4; ++nb) yd[nb] = mfma16(*(const bf16x8*)(xT + (nb * 16 + fr) * 136 + ks * 32 + fq * 8), ga, yd[nb]);
  }
  {
    const float dsk = P.in[I_DSKIP][l * 8 + h];
    const u16* Z = (const u16*)(P.ws + WS_Z);
    u16* MIX = (u16*)(P.ws + WS_MIX);
    const size_t tok = (size_t)c * 128 + ll;
    const float idt = dsk / dtv[ll];
    const float eal = __expf(al);
#pragma unroll
    for (int nb = 0; nb < 4; ++nb) {
      const int p0 = nb * 16 + fq * 4;
      const uint2 zz = *(const uint2*)(Z + tok * 512 + h * 64 + p0);
      const float zf[4] = {bflo(zz.x), bfhi(zz.x), bflo(zz.y), bfhi(zz.y)};
      float yo[4];
#pragma unroll
      for (int r = 0; r < 4; ++r) {
        const float yv = yd[nb][r] + y[nb][r] * eal + bf2f(xT[(p0 + r) * 136 + ll]) * idt;
        yo[r] = yv * siluf(zf[r]);
      }
      *(uint2*)(MIX + tok * 1024 + h * 64 + p0) = pack4(yo[0], yo[1], yo[2], yo[3]);
    }
  }
  __syncthreads();
}

DEVI void mixnorm_item(const Params& P, int item) {
  const int tid = opaque_tid(), lane = tid & 63, w = tid >> 6;
  const int row = item * 4 + w;
  u16* MIX = (u16*)(P.ws + WS_MIX) + (size_t)row * 1024 + lane * 8;
  const uint4 v = *(const uint4*)MIX;
  float f[8] = {bflo(v.x), bfhi(v.x), bflo(v.y), bfhi(v.y), bflo(v.z), bfhi(v.z), bflo(v.w), bfhi(v.w)};
  float s = 0.f;
#pragma unroll
  for (int i = 0; i < 8; ++i) s += f[i] * f[i];
  s = wave_sum(s);
  const float sc = rsqrtf(s * (1.f / 512.f) + EPS);
  uint4 o;
  o.x = pack2(f[0] * sc, f[1] * sc); o.y = pack2(f[2] * sc, f[3] * sc);
  o.z = pack2(f[4] * sc, f[5] * sc); o.w = pack2(f[6] * sc, f[7] * sc);
  *(uint4*)MIX = o;
}

DEVI void copy_item(const Params& P, int l, int item) {
  const float* src; float* dst; int n4;
  int s4;
  if (item < 4096) {
    const int part = item & 15, kv = (item >> 4) & 1, b = item >> 5;
    const size_t base = (size_t)(l * 128 + b) * 262144;
    src = (kv ? P.in[I_CCV] : P.in[I_CCK]) + base + 512;
    dst = P.out + (kv ? OFF_SCV : OFF_SCK) + base;
    s4 = part * 4096;
    n4 = min(4096, 65408 - s4);
  } else {
    const int it = item - 4096;
    const int kv = it & 1, b = it >> 1;
    const size_t base = (size_t)(l * 128 + b) * 16384;
    src = (kv ? P.in[I_CAV] : P.in[I_CAK]) + base + 512;
    dst = P.out + (kv ? OFF_SAV : OFF_SAK) + base;
    s4 = 0; n4 = 3968;
  }
  const f32x4* s = (const f32x4*)src + s4;
  f32x4* d = (f32x4*)dst + s4;
  const int t = threadIdx.x;
  f32x4 v[16];
#pragma unroll
  for (int i = 0; i < 16; ++i)
    if (i * 256 + t < n4) v[i] = __builtin_nontemporal_load(s + i * 256 + t);
#pragma unroll
  for (int i = 0; i < 16; ++i)
    if (i * 256 + t < n4) __builtin_nontemporal_store(v[i], d + i * 256 + t);
}

DEVI void copy_ptrs(const Params& P, int l, int item, const f32x4*& s, f32x4*& d, int& n4) {
  if (item < 4096) {
    const int part = item & 15, kv = (item >> 4) & 1, b = item >> 5;
    const size_t base = (size_t)(l * 128 + b) * 262144;
    s = (const f32x4*)((kv ? P.in[I_CCV] : P.in[I_CCK]) + base + 512) + part * 4096;
    d = (f32x4*)(P.out + (kv ? OFF_SCV : OFF_SCK) + base) + part * 4096;
    n4 = min(4096, 65408 - part * 4096);
  } else {
    const int it = item - 4096;
    const int kv = it & 1, b = it >> 1;
    const size_t base = (size_t)(l * 128 + b) * 16384;
    s = (const f32x4*)((kv ? P.in[I_CAV] : P.in[I_CAK]) + base + 512);
    d = (f32x4*)(P.out + (kv ? OFF_SAV : OFF_SAK) + base);
    n4 = 3968;
  }
}

struct GBar { unsigned* bar; unsigned epoch; unsigned x; unsigned nloc; unsigned nx; };
DEVI unsigned bar_ld(unsigned* p) { return __hip_atomic_load(p, __ATOMIC_RELAXED, __HIP_MEMORY_SCOPE_AGENT); }
DEVI unsigned bar_add(unsigned* p, unsigned v) { return __hip_atomic_fetch_add(p, v, __ATOMIC_RELAXED, __HIP_MEMORY_SCOPE_AGENT); }
DEVI void gsync_flat(GBar& g) {
  asm volatile("s_waitcnt vmcnt(0) lgkmcnt(0)" ::: "memory");
  __syncthreads();
  if (threadIdx.x == 0) {
    __builtin_amdgcn_fence(__ATOMIC_RELEASE, "agent");
    asm volatile("s_waitcnt vmcnt(0)" ::: "memory");
    bar_add(g.bar, 1u);
    while (bar_ld(g.bar) < gridDim.x) __builtin_amdgcn_s_sleep(2);
    __builtin_amdgcn_fence(__ATOMIC_ACQUIRE, "agent");
    asm volatile("s_waitcnt vmcnt(0)" ::: "memory");
  }
  __syncthreads();
}
DEVI void gsync(GBar& g) {
  asm volatile("s_waitcnt vmcnt(0) lgkmcnt(0)" ::: "memory");
  __syncthreads();
  g.epoch++;
  if (threadIdx.x == 0) {
    const unsigned old = bar_add(g.bar + 32 * (1 + g.x), 1u);
    if (old == g.epoch * g.nloc - 1u) {
      __builtin_amdgcn_fence(__ATOMIC_RELEASE, "agent");
      asm volatile("s_waitcnt vmcnt(0)" ::: "memory");
      bar_add(g.bar + 32 * 9, 1u);
    }
    const unsigned target = g.epoch * g.nx;
    while (bar_ld(g.bar + 32 * 9) < target) __builtin_amdgcn_s_sleep(1);
    __builtin_amdgcn_fence(__ATOMIC_ACQUIRE, "agent");
    asm volatile("s_waitcnt vmcnt(0)" ::: "memory");
  }
  __syncthreads();
}

__global__ void __launch_bounds__(256, 2) hymba_megakernel(Params P) {
  extern __shared__ __attribute__((aligned(16))) unsigned char smem[];
  cg::grid_group cgrid = cg::this_grid();
  GBar grid; grid.bar = (unsigned*)(P.ws + WS_BAR); grid.epoch = 0;
  grid.x = (unsigned)__builtin_amdgcn_s_getreg((3 << 11) | 20) & 7u;
  if (threadIdx.x == 0) bar_add(grid.bar + 32 * 10 + grid.x, 1u);
  const int nb = gridDim.x, bid = blockIdx.x;
  const int vbid = ((nb & 7) == 0) ? (bid & 7) * (nb >> 3) + (bid >> 3) : bid;
  unsigned char* ws = P.ws;

#ifdef NANFILL
  {
    uint4* w4 = (uint4*)ws;
    const size_t n4 = WS_END / 16;
    const uint4 pat = make_uint4(0xffffffffu, 0xffffffffu, 0xffffffffu, 0xffffffffu);
    for (size_t i = (size_t)bid * 256 + threadIdx.x; i < n4; i += (size_t)nb * 256) w4[i] = pat;
    for (int i = threadIdx.x; i < LDS_BYTES / 16; i += 256) ((uint4*)smem)[i] = pat;
  }
  gsync(grid);
#endif
  {
    const int NW = 2 * 3040, NX = 2112, NR = 513;
    for (int it = bid; it < NW + NX + NR; it += nb) {
      if ((PHM & 1) && it < NW) {
        const int l = it / 3040;
        int r = it % 3040;
        if (r < 672) wconv_item(P, 0, l, r / 42, r % 42, smem);
        else if ((r -= 672) < 256) wconv_item(P, 1, l, r / 16, r % 16, smem);
        else if ((r -= 256) < 704) wconv_item(P, 2, l, r / 44, r % 44, smem);
        else if ((r -= 704) < 704) wconv_item(P, 3, l, r / 44, r % 44, smem);
        else { r -= 704; wconv_item(P, 4, l, r / 16, r % 16, smem); }
      } else if (it < NW + NX) { if (PHM & 2) xconv_item(P, it - NW); }
      else if (PHM & 2) rope_item(P, it - NW - NX);
    }
  }
  asm volatile("s_waitcnt vmcnt(0) lgkmcnt(0)" ::: "memory");
  __syncthreads();
  cgrid.sync();
  if (threadIdx.x == 0) __builtin_amdgcn_fence(__ATOMIC_ACQUIRE, "agent");
  asm volatile("s_waitcnt vmcnt(0)" ::: "memory");
  __syncthreads();
  {
    unsigned nx = 0;
#pragma unroll
    for (int i = 0; i < 8; ++i) nx += (bar_ld(grid.bar + 32 * 10 + i) != 0u) ? 1u : 0u;
    grid.nx = nx;
    grid.nloc = bar_ld(grid.bar + 32 * 10 + grid.x);
  }

#ifdef DELAYTEST
  {
    const unsigned long long t0 = wall_clock64();
    while (wall_clock64() - t0 < 200000ull) __builtin_amdgcn_s_sleep(8);
    __syncthreads();
    if (threadIdx.x == 0) __builtin_amdgcn_fence(__ATOMIC_ACQUIRE, "agent");
    asm volatile("s_waitcnt vmcnt(0)" ::: "memory");
    __syncthreads();
  }
#endif
#ifdef E2TEST
  {
    const u16* AHp = (const u16*)(ws + WS_AH);
    const u16* WTp = (const u16*)(ws + WS_WIN);
    for (size_t i = (size_t)bid * 256 + threadIdx.x; i < (size_t)NT * 1024; i += (size_t)nb * 256) P.out[OFF_Y + i] = bf2f(AHp[i]) * 1.2345678f + 0.1f;
    for (size_t i = (size_t)bid * 256 + threadIdx.x; i < (size_t)2 * NINP * 1024; i += (size_t)nb * 256) P.out[OFF_SCK + i] = bf2f(WTp[i]) * 1.2345678f + 0.001f;
    return;
  }
#endif
#pragma unroll 1
  for (int l = 0; l < 2; ++l) {
    {
      const u16* A = (const u16*)(ws + WS_AH);
      const u16* Bt = (const u16*)(ws + WS_WIN) + (size_t)l * NINP * 1024;
      for (int t = vbid; t < 132 * 21; t += nb) {
        const int rt = t / 21, ct = t % 21;
        if (PHM & 4) gemm_tile<EPI_IN>(P, l, A, 1024, Bt, 1024, 1024, XKS, rt * 128, ct * 128, smem);
      }
    }
    gsync(grid);
    if (STOPAT == 1) return;
    {
      const int N_SC = 256, N_SA = 256, N_AT = 4096, N_CS = 1024, N_SM = 1024, N_CP = 1952;
      const int tot = N_SC + N_SA + N_AT + N_CS + N_SM + N_CP;
      for (int it = bid; it < tot; it += nb) {
        int r = it;
        int lq = l;
        asm volatile("" : "+s"(lq));
        if (r < N_SC) { if (PHM & 8) sattn_item(P, lq, 1, r, smem); }
        else if ((r -= N_SC) < N_SA) { if (PHM & 8) sattn_item(P, lq, 0, r, smem); }
        else if ((r -= N_SA) < N_AT) { if (PHM & 16) attn_item(P, lq, r >> 10, r & 1023, smem); }
        else if ((r -= N_AT) < N_CS) { if (PHM & 32) ssd_cs_item(P, lq, r, smem); }
        else if ((r -= N_CS) < N_SM) { if (PHM & 64) smamba_item(P, lq, r, smem); }
        else { r -= N_SM; if (PHM & 128) copy_item(P, lq, r); }
      }
    }
    gsync(grid);
    if (STOPAT == 2) return;
    {
      for (int it = bid; it < 256 + 2048 + 800; it += nb) {
        if (it < 256) { if (PHM & 256) ssd_scan_item(P, l, it); }
        else if (it < 2304) { if (PHM & 256) cmerge_item(P, it - 256); }
        else copy_item(P, l, 1952 + (it - 2304));
      }
    }
    gsync(grid);
    if (STOPAT == 3) return;
    for (int k = 0;; ++k) {
      const int yi = bid + k * nb, ci = 2752 + bid + k * nb;
      if (yi >= 2048 && ci >= 4352) break;
      if (yi < 2048) ssd_y_item(P, l, yi, smem);
      if (ci < 4352) copy_item(P, l, ci);
    }
    gsync(grid);
    for (int it = bid; it < NT / 4; it += nb) mixnorm_item(P, it);
    gsync(grid);
    if (STOPAT == 4) return;
    {
      const u16* A = (const u16*)(ws + WS_MIX);
      const u16* Bt = (const u16*)(ws + WS_WOUT) + (size_t)l * 1024 * 1024;
      for (int t = vbid; t < 132 * 8; t += nb) {
        const int rt = t / 8, ct = t % 8;
        if (PHM & 1024) gemm_tile<EPI_OUT>(P, l, A, 1024, Bt, 1024, 1024, 0, rt * 128, ct * 128, smem);
      }
    }
    gsync(grid);
    if (STOPAT == 5) return;
    {
      const u16* A = (const u16*)(ws + WS_AH1);
      const u16* Bt = (const u16*)(ws + WS_WGU) + (size_t)l * 5632 * 1024;
      const int NCP = 0, NTL = 132 * 44;
      for (int it = vbid; it < NTL + NCP; it += nb) {
        int t;
        if (it < 2 * NCP) {
          if (!(it & 1)) { copy_item(P, l, it >> 1); continue; }
          t = it >> 1;
        } else t = it - NCP;
        const int rt = t / 44, ct = t % 44;
        if (PHM & 2048) gemm_tile<EPI_GU>(P, l, A, 1024, Bt, 1024, 1024, 0, rt * 128, ct * 128, smem, (const float*)(ws + WS_PS1));
      }
    }
    gsync(grid);
    if (STOPAT == 6) return;
    {
      const u16* A = (const u16*)(ws + WS_G);
      const u16* Bt = (const u16*)(ws + WS_WDN) + (size_t)l * 1024 * DFF;
      for (int t = vbid; t < 132 * 8; t += nb) {
        const int rt = t / 8, ct = t % 8;
        if (PHM & 4096) gemm_tile<EPI_DN>(P, l, A, DFF, Bt, DFF, DFF, 0, rt * 128, ct * 128, smem);
      }
    }
    if (l == 0) gsync(grid);
  }
}

extern "C" void kernel_launch(void* const* d_in, const int* in_sizes, int n_in, void* d_out, int out_size, void* d_ws,
                              size_t ws_size, hipStream_t stream) {
  static int grid_blocks = 0;
  if (!grid_blocks) {
    int dev = 0, cus = 0, per_cu = 0;
    (void)hipGetDevice(&dev);
    (void)hipDeviceGetAttribute(&cus, hipDeviceAttributeMultiprocessorCount, dev);
    (void)hipFuncSetAttribute((const void*)hymba_megakernel, hipFuncAttributeMaxDynamicSharedMemorySize, LDS_BYTES);
    (void)hipOccupancyMaxActiveBlocksPerMultiprocessor(&per_cu, hymba_megakernel, 256, LDS_BYTES);
    if (per_cu < 1) per_cu = 1;
    if (per_cu > 2) per_cu = 2;
    grid_blocks = cus * per_cu;
  }
  Params p{};
  for (int i = 0; i < 26; ++i) p.in[i] = (const float*)d_in[i];
  p.out = (float*)d_out;
  p.ws = (unsigned char*)d_ws;
  (void)hipMemsetAsync((unsigned char*)d_ws + WS_BAR, 0, 2048, stream);
  void* args[] = {&p};
  hipError_t e = hipLaunchCooperativeKernel((void*)hymba_megakernel, dim3(grid_blocks), dim3(256), args, LDS_BYTES, stream);
  if (e != hipSuccess) fprintf(stderr, "cooperative launch failed: %s (grid %d)\n", hipGetErrorString(e), grid_blocks);
}
```

```cpp
#include <hip/hip_runtime.h>
#include <hip/hip_bf16.h>
#include <hip/hip_cooperative_groups.h>
#include <cstdio>
namespace cg = cooperative_groups;

typedef unsigned short u16;
using bf16x8 = __attribute__((ext_vector_type(8))) short;
using f32x4 = __attribute__((ext_vector_type(4))) float;
using u32x4 = __attribute__((ext_vector_type(4))) unsigned int;
#define DEVI __device__ __forceinline__

constexpr int DM = 1024, SEQ = 16384, NSAMP = 512, NT = SEQ + NSAMP, NB = 128;
constexpr int NINP = 2688, NIN = 2568, DFF = 2816;
constexpr float EPS = 1e-6f;
constexpr int LDS_BYTES = 73728;
#ifndef XKS
#define XKS 1024
#endif
#ifndef RSOFF
#define RSOFF 0
#endif
#ifndef OUTMASK
#define OUTMASK 0xff
#endif
#ifndef STOPAT
#define STOPAT 0
#endif
#ifndef PHM
#define PHM 0xffff
#endif

constexpr size_t OFF_Y = 0;
constexpr size_t OFF_PAK = (size_t)NT * DM;
constexpr size_t OFF_PAV = OFF_PAK + 32768;
constexpr size_t OFF_PCK = OFF_PAV + 32768;
constexpr size_t OFF_PCV = OFF_PCK + 524288;
constexpr size_t OFF_PSSM = OFF_PCV + 524288;
constexpr size_t OFF_PCONV = OFF_PSSM + 131072;
constexpr size_t OFF_SAK = OFF_PCONV + 6144;
constexpr size_t OFF_SAV = OFF_SAK + 4194304;
constexpr size_t OFF_SCK = OFF_SAV + 4194304;
constexpr size_t OFF_SCV = OFF_SCK + 67108864;
constexpr size_t OFF_SSSM = OFF_SCV + 67108864;
constexpr size_t OFF_SCONV = OFF_SSSM + 16777216;

constexpr size_t al256(size_t x) { return (x + 255) & ~(size_t)255; }
constexpr size_t WS_WIN = 0;
constexpr size_t WS_WOUT = WS_WIN + al256((size_t)2 * NINP * 1024 * 2);
constexpr size_t WS_WGU = WS_WOUT + al256((size_t)2 * 1024 * 1024 * 2);
constexpr size_t WS_WDN = WS_WGU + al256((size_t)2 * 5632 * 1024 * 2);
constexpr size_t WS_AH = WS_WDN + al256((size_t)2 * 1024 * 2816 * 2);
constexpr size_t WS_AH1 = WS_AH + al256((size_t)NT * 1024 * 2);
constexpr size_t WS_HF = WS_AH1 + al256((size_t)NT * 1024 * 2);
constexpr size_t WS_H1 = WS_HF + al256((size_t)NT * 1024 * 4);
constexpr size_t WS_QKV = WS_H1 + al256((size_t)NT * 1024 * 4);
constexpr size_t WS_Z = WS_QKV + al256((size_t)NT * 1024 * 2);
constexpr size_t WS_XBC = WS_Z + al256((size_t)NT * 512 * 2);
constexpr size_t WS_DT = WS_XBC + al256((size_t)NT * 1024 * 2);
constexpr size_t WS_G = WS_DT + al256((size_t)NT * 8 * 4);
constexpr size_t WS_MIX = WS_G + al256((size_t)NT * DFF * 2);
constexpr size_t WS_CO = WS_MIX + al256((size_t)NT * 1024 * 2);
constexpr size_t WS_LSE = WS_CO + al256((size_t)3 * SEQ * 256 * 2);
constexpr size_t WS_CS = WS_LSE + al256((size_t)3 * SEQ * 4 * 4);
constexpr size_t WS_CD = WS_CS + al256((size_t)128 * 65536 * 4);
constexpr size_t WS_HIN = WS_CD + al256((size_t)128 * 8 * 4);
constexpr size_t WS_ROPE = WS_HIN + al256((size_t)128 * 65536 * 2);
constexpr size_t WS_BAR = WS_ROPE + al256((size_t)16388 * 16 * 4);
constexpr size_t WS_END = WS_BAR + 2048;

struct Params {
  const float* in[26];
  float* out;
  unsigned char* ws;
};
enum { I_XP = 0, I_XS, I_CAK, I_CAV, I_CCK, I_CCV, I_SSM, I_SCONV, I_NORM1, I_WIN, I_AQN, I_AKN, I_SINK, I_CQN, I_CKN,
       I_CONVW, I_CONVB, I_DTB, I_ALOG, I_DSKIP, I_SSMN, I_WOUT, I_NORM2, I_WGATE, I_WUP, I_WDOWN };

DEVI int opaque_tid() { int t = threadIdx.x; asm volatile("" : "+v"(t)); return t; }
DEVI u16 f2bf(float f) { unsigned u = __float_as_uint(f); u += 0x7fffu + ((u >> 16) & 1u); return (u16)(u >> 16); }
DEVI float bf2f(u16 h) { return __uint_as_float(((unsigned)h) << 16); }
DEVI unsigned pack2(float a, float b) { return (unsigned)f2bf(a) | ((unsigned)f2bf(b) << 16); }
DEVI float siluf(float x) { return x / (1.f + __expf(-x)); }
DEVI float softplusf(float x) { return x > 20.f ? x : log1pf(__expf(x)); }
DEVI float bflo(unsigned u) { return __uint_as_float(u << 16); }
DEVI float bfhi(unsigned u) { return __uint_as_float(u & 0xffff0000u); }
DEVI u32x4 gload16_async(const void* p) {
  u32x4 v;
  asm volatile("global_load_dwordx4 %0, %1, off" : "=v"(v) : "v"(p) : "memory");
  return v;
}
DEVI void gwait8(u32x4& a0, u32x4& a1, u32x4& a2, u32x4& a3, u32x4& b0, u32x4& b1, u32x4& b2, u32x4& b3) {
  asm volatile("s_waitcnt vmcnt(0)" : "+v"(a0), "+v"(a1), "+v"(a2), "+v"(a3), "+v"(b0), "+v"(b1), "+v"(b2), "+v"(b3) : : "memory");
}
DEVI float sumsq8(u32x4 v) {
  float s = 0.f, t;
  t = bflo(v.x); s += t * t; t = bfhi(v.x); s += t * t;
  t = bflo(v.y); s += t * t; t = bfhi(v.y); s += t * t;
  t = bflo(v.z); s += t * t; t = bfhi(v.z); s += t * t;
  t = bflo(v.w); s += t * t; t = bfhi(v.w); s += t * t;
  return s;
}
DEVI float wave_max(float v) {
#pragma unroll
  for (int o = 32; o >= 1; o >>= 1) v = fmaxf(v, __shfl_xor(v, o));
  return v;
}
DEVI float wave_sum(float v) {
#pragma unroll
  for (int o = 32; o >= 1; o >>= 1) v += __shfl_xor(v, o);
  return v;
}
DEVI f32x4 mfma16(bf16x8 a, bf16x8 b, f32x4 c) { return __builtin_amdgcn_mfma_f32_16x16x32_bf16(a, b, c, 0, 0, 0); }

enum { EPI_IN = 0, EPI_OUT = 1, EPI_GU = 2, EPI_DN = 3 };

DEVI uint2 pack4(float a, float b, float c, float d) { uint2 o; o.x = pack2(a, b); o.y = pack2(c, d); return o; }

template <int EPI>
DEVI void gemm_epilogue(const Params& P, int l, f32x4 (&acc)[4][4], float (&scv)[4], int row0, int col0, int wm, int wn, int fr, int fq) {
  unsigned char* ws = P.ws;
  if (EPI == EPI_IN) {
    const int cb = col0 + wn * 64;
    if (cb < 1024) {
      u16* QKV = (u16*)(ws + WS_QKV);
      const float* ROPE = (const float*)(ws + WS_ROPE);
      const int hh = cb >> 6;
      const bool isv = (hh == 6 || hh == 7 || hh == 14 || hh == 15);
      const float* gain = P.in[I_AQN];
      if (hh >= 4 && hh < 6) gain = P.in[I_AKN];
      else if (hh >= 8 && hh < 12) gain = P.in[I_CQN];
      else if (hh >= 12) gain = P.in[I_CKN];
      gain += l * 64;
      float gv[4][4];
#pragma unroll
      for (int ni = 0; ni < 4; ++ni)
#pragma unroll
        for (int r = 0; r < 4; ++r) gv[ni][r] = isv ? 1.f : gain[ni * 16 + fq * 4 + r];
      const int kind = (hh == 4 || hh == 5) ? 1 : (hh == 6 || hh == 7) ? 2 : (hh == 12 || hh == 13) ? 3 : (hh >= 14) ? 4 : 0;
      const int kvh = hh & 1;
#pragma unroll
      for (int mi = 0; mi < 4; ++mi) {
        const int row = row0 + wm * 64 + mi * 16 + fr;
        float v[4][4];
        float ss = 0.f;
#pragma unroll
        for (int ni = 0; ni < 4; ++ni)
#pragma unroll
          for (int r = 0; r < 4; ++r) { v[ni][r] = acc[mi][ni][r] * scv[mi]; ss += v[ni][r] * v[ni][r]; }
        if (!isv) {
          ss += __shfl_xor(ss, 16); ss += __shfl_xor(ss, 32);
          const float sc = rsqrtf(ss * (1.f / 64.f) + EPS);
#pragma unroll
          for (int ni = 0; ni < 4; ++ni)
#pragma unroll
            for (int r = 0; r < 4; ++r) v[ni][r] *= sc * gv[ni][r];
          const int pos = row < SEQ ? row : SEQ + ((row - SEQ) & 3);
#pragma unroll
          for (int r = 0; r < 4; ++r) {
            const float partner = __shfl_xor(v[0][r], 32);
            const int i = (fq & 1) * 4 + r;
            const float cs = ROPE[pos * 16 + i], sn = ROPE[pos * 16 + 8 + i];
            v[0][r] = (fq < 2) ? (v[0][r] * cs - partner * sn) : (v[0][r] * cs + partner * sn);
          }
        }
#pragma unroll
        for (int ni = 0; ni < 4; ++ni)
          *(uint2*)(QKV + (size_t)row * 1024 + cb + ni * 16 + fq * 4) = pack4(v[ni][0], v[ni][1], v[ni][2], v[ni][3]);
        if (kind) {
          size_t base = 0;
          bool ok = false;
          if (kind <= 2) {
            if (row >= SEQ) {
              const int sb = (row - SEQ) >> 2, t = (row - SEQ) & 3;
              base = (kind == 1 ? OFF_SAK : OFF_SAV) + ((((size_t)(l * 128 + sb) * 128 + 124 + t) * 2 + kvh) * 64);
              ok = true;
            } else if (row >= SEQ - 128) {
              base = (kind == 1 ? OFF_PAK : OFF_PAV) + (((size_t)(l * 128 + (row - (SEQ - 128))) * 2 + kvh) * 64);
              ok = true;
            }
          } else {
            if (row >= SEQ) {
              const int sb = (row - SEQ) >> 2, t = (row - SEQ) & 3;
              base = (kind == 3 ? OFF_SCK : OFF_SCV) + ((((size_t)(l * 128 + sb) * 2048 + 2044 + t) * 2 + kvh) * 64);
              ok = true;
            } else if (row >= SEQ - 2048) {
              base = (kind == 3 ? OFF_PCK : OFF_PCV) + (((size_t)(l * 2048 + (row - (SEQ - 2048))) * 2 + kvh) * 64);
              ok = true;
            }
          }
          if (ok) {
#pragma unroll
            for (int ni = 0; ni < 4; ++ni)
              *(float4*)(P.out + base + ni * 16 + fq * 4) = make_float4(v[ni][0], v[ni][1], v[ni][2], v[ni][3]);
          }
        }
      }
    } else if (cb < 1536) {
      u16* Z = (u16*)(ws + WS_Z);
#pragma unroll
      for (int mi = 0; mi < 4; ++mi) {
        const int row = row0 + wm * 64 + mi * 16 + fr;
        const float sc = scv[mi];
#pragma unroll
        for (int ni = 0; ni < 4; ++ni)
          *(uint2*)(Z + (size_t)row * 512 + (cb - 1024) + ni * 16 + fq * 4) =
              pack4(acc[mi][ni][0] * sc, acc[mi][ni][1] * sc, acc[mi][ni][2] * sc, acc[mi][ni][3] * sc);
      }
    } else if (cb < 2560) {
      u16* XBC = (u16*)(ws + WS_XBC);
#pragma unroll
      for (int mi = 0; mi < 4; ++mi) {
        const int row = row0 + wm * 64 + mi * 16 + fr;
        const float sc = scv[mi];
        size_t cbase = 0;
        bool ok = false;
        if (row >= SEQ) {
          const int sb = (row - SEQ) >> 2, t = (row - SEQ) & 3;
          if (t >= 1) { ok = true; cbase = OFF_SCONV + ((size_t)(l * 128 + sb) * 3 + (t - 1)) * 1024; }
        } else if (row >= SEQ - 3) {
          ok = true; cbase = OFF_PCONV + (size_t)(l * 3 + (row - (SEQ - 3))) * 1024;
        }
#pragma unroll
        for (int ni = 0; ni < 4; ++ni) {
          const int ch = (cb - 1536) + ni * 16 + fq * 4;
          const float x0 = acc[mi][ni][0] * sc, x1 = acc[mi][ni][1] * sc, x2 = acc[mi][ni][2] * sc, x3 = acc[mi][ni][3] * sc;
          *(uint2*)(XBC + (size_t)row * 1024 + ch) = pack4(x0, x1, x2, x3);
          if (ok) *(float4*)(P.out + cbase + ch) = make_float4(x0, x1, x2, x3);
        }
      }
    } else if (cb == 2560) {
      float* DT = (float*)(ws + WS_DT);
      if (fq < 2) {
#pragma unroll
        for (int mi = 0; mi < 4; ++mi) {
          const int row = row0 + wm * 64 + mi * 16 + fr;
          const float sc = scv[mi];
          *(float4*)(DT + (size_t)row * 8 + fq * 4) = make_float4(acc[mi][0][0] * sc, acc[mi][0][1] * sc, acc[mi][0][2] * sc, acc[mi][0][3] * sc);
        }
      }
    }
  } else if (EPI == EPI_OUT) {
    float* H1 = (float*)(ws + WS_H1);
    u16* AH1 = (u16*)(ws + WS_AH1);
    const float* HF = (const float*)(ws + WS_HF);
#pragma unroll
    for (int mi = 0; mi < 4; ++mi) {
      const int row = row0 + wm * 64 + mi * 16 + fr;
      const float* res = (l == 0) ? (row < SEQ ? P.in[I_XP] + (size_t)row * 1024 : P.in[I_XS] + (size_t)(row - SEQ) * 1024)
                                  : HF + (size_t)row * 1024;
#pragma unroll
      for (int ni = 0; ni < 4; ++ni) {
        const int col = col0 + wn * 64 + ni * 16 + fq * 4;
        const float4 rv = *(const float4*)(res + col);
        const float h0 = rv.x + acc[mi][ni][0], h1 = rv.y + acc[mi][ni][1], h2 = rv.z + acc[mi][ni][2], h3 = rv.w + acc[mi][ni][3];
        *(float4*)(H1 + (size_t)row * 1024 + col) = make_float4(h0, h1, h2, h3);
        *(uint2*)(AH1 + (size_t)row * 1024 + col) = pack4(h0, h1, h2, h3);
      }
    }
  } else if (EPI == EPI_GU) {
    u16* G = (u16*)(ws + WS_G);
#pragma unroll
    for (int mi = 0; mi < 4; ++mi) {
      const int row = row0 + wm * 64 + mi * 16 + fr;
      const float sc = scv[mi];
#pragma unroll
      for (int q = 0; q < 2; ++q) {
        const int j = ((col0 + wn * 64) >> 1) + q * 16 + fq * 4;
        float o[4];
#pragma unroll
        for (int r = 0; r < 4; ++r) o[r] = siluf(acc[mi][2 * q][r] * sc) * (acc[mi][2 * q + 1][r] * sc);
        *(uint2*)(G + (size_t)row * DFF + j) = pack4(o[0], o[1], o[2], o[3]);
      }
    }
  } else {
    const float* H1 = (const float*)(ws + WS_H1);
    float* HF = (float*)(ws + WS_HF);
    u16* AH = (u16*)(ws + WS_AH);
#pragma unroll
    for (int mi = 0; mi < 4; ++mi) {
      const int row = row0 + wm * 64 + mi * 16 + fr;
#pragma unroll
      for (int ni = 0; ni < 4; ++ni) {
        const int col = col0 + wn * 64 + ni * 16 + fq * 4;
        const float4 rv = *(const float4*)(H1 + (size_t)row * 1024 + col);
        const float h0 = rv.x + acc[mi][ni][0], h1 = rv.y + acc[mi][ni][1], h2 = rv.z + acc[mi][ni][2], h3 = rv.w + acc[mi][ni][3];
        if (l == 0) {
          *(float4*)(HF + (size_t)row * 1024 + col) = make_float4(h0, h1, h2, h3);
          *(uint2*)(AH + (size_t)row * 1024 + col) = pack4(h0, h1, h2, h3);
        } else {
          *(float4*)(P.out + OFF_Y + (size_t)row * 1024 + col) = make_float4(h0, h1, h2, h3);
        }
      }
    }
  }
}

template <int EPI>
DEVI void gemm_tile(const Params& P, int l, const u16* __restrict__ A, int lda, const u16* __restrict__ Bt, int ldb,
                          int K, int KS, int row0, int col0, unsigned char* smem) {
  const int tid = opaque_tid(), lane = tid & 63, w = tid >> 6, wm = w >> 1, wn = w & 1;
  const int fr = lane & 15, fq = lane >> 4;
  f32x4 acc[4][4];
#pragma unroll
  for (int mi = 0; mi < 4; ++mi)
#pragma unroll
    for (int ni = 0; ni < 4; ++ni) acc[mi][ni] = (f32x4){0.f, 0.f, 0.f, 0.f};
  const int lrow = tid >> 3, lch = tid & 7;
  const int gch = lch ^ (lrow & 7);
  const u16* Ag = A + (size_t)(row0 + lrow) * lda + gch * 8;
  const u16* Bg = Bt + (size_t)(col0 + lrow) * ldb + gch * 8;
  unsigned char* ldsT = smem + tid * 16;
  f32x4 gr0 = (f32x4){0.f, 0.f, 0.f, 0.f}, gr1 = gr0;
  float scv[4] = {1.f, 1.f, 1.f, 1.f};
  const int nk = K >> 6;
  const int ksS = (KS >> 6) - 1;
#pragma unroll
  for (int i = 0; i < 4; ++i) {
    __builtin_amdgcn_global_load_lds((const unsigned*)(Ag + (size_t)(32 * i) * lda), (unsigned*)(ldsT + i * 4096), 16, 0, 0);
    __builtin_amdgcn_global_load_lds((const unsigned*)(Bg + (size_t)(32 * i) * ldb), (unsigned*)(ldsT + 16384 + i * 4096), 16, 0, 0);
  }
  asm volatile("s_waitcnt vmcnt(0)" ::: "memory");
  __syncthreads();
  for (int ks = 0; ks < nk; ++ks) {
    const bool more = (ks + 1 < nk);
    if (more) {
      unsigned char* dst = ldsT + ((ks + 1) & 1) * 32768;
#pragma unroll
      for (int i = 0; i < 4; ++i) {
        __builtin_amdgcn_global_load_lds((const unsigned*)(Ag + (size_t)(32 * i) * lda + (ks + 1) * 64), (unsigned*)(dst + i * 4096), 16, 0, 0);
        __builtin_amdgcn_global_load_lds((const unsigned*)(Bg + (size_t)(32 * i) * ldb + (ks + 1) * 64), (unsigned*)(dst + 16384 + i * 4096), 16, 0, 0);
      }
    }
    const unsigned char* As = smem + (ks & 1) * 32768;
    const unsigned char* Bs = As + 16384;
#pragma unroll
    for (int kk = 0; kk < 2; ++kk) {
      bf16x8 af[4], bq[4];
#pragma unroll
      for (int mi = 0; mi < 4; ++mi) {
        const int row = wm * 64 + mi * 16 + fr;
        af[mi] = *(const bf16x8*)(As + row * 128 + (((kk * 4 + fq) ^ (row & 7)) << 4));
      }
#pragma unroll
      for (int ni = 0; ni < 4; ++ni) {
        const int row = wn * 64 + ni * 16 + fr;
        bq[ni] = *(const bf16x8*)(Bs + row * 128 + (((kk * 4 + fq) ^ (row & 7)) << 4));
      }
      if (ks <= ksS) {
        if (wn == 0) { gr0 = mfma16(af[0], af[0], gr0); gr1 = mfma16(af[1], af[1], gr1); }
        else { gr0 = mfma16(af[2], af[2], gr0); gr1 = mfma16(af[3], af[3], gr1); }
      }
      __builtin_amdgcn_s_setprio(1);
#pragma unroll
      for (int mi = 0; mi < 4; ++mi)
#pragma unroll
        for (int ni = 0; ni < 4; ++ni) acc[mi][ni] = mfma16(bq[ni], af[mi], acc[mi][ni]);
      __builtin_amdgcn_s_setprio(0);
    }
    float* rsL = (float*)(smem + ((ks + 1) & 1) * 32768);
    if (ks == ksS) {
      if ((fr >> 2) == fq) {
        const int r = fr & 3;
        const float d0 = r == 0 ? gr0[0] : r == 1 ? gr0[1] : r == 2 ? gr0[2] : gr0[3];
        const float d1 = r == 0 ? gr1[0] : r == 1 ? gr1[1] : r == 2 ? gr1[2] : gr1[3];
        rsL[wm * 64 + (wn * 2) * 16 + fr] = rsqrtf(d0 / (float)KS + EPS);
        rsL[wm * 64 + (wn * 2 + 1) * 16 + fr] = rsqrtf(d1 / (float)KS + EPS);
      }
    }
    asm volatile("s_waitcnt vmcnt(0)" ::: "memory");
    __syncthreads();
    if (ks == ksS) {
#pragma unroll
      for (int mi = 0; mi < 4; ++mi) scv[mi] = rsL[wm * 64 + mi * 16 + fr];
      __syncthreads();
    }
  }
  gemm_epilogue<EPI>(P, l, acc, scv, row0, col0, wm, wn, fr, fq);
}

DEVI void wconv_item(const Params& P, int mode, int l, int kt, int nt, unsigned char* smem) {
  float* tile = (float*)smem;
  const int tid = opaque_tid();
  const float* src; int ldsrc, Nsrc; u16* dst; int lddst;
  const float* gain = nullptr;
  unsigned char* ws = P.ws;
  if (mode == 0) { src = P.in[I_WIN] + (size_t)l * 1024 * NIN; ldsrc = NIN; Nsrc = NIN; dst = (u16*)(ws + WS_WIN) + (size_t)l * NINP * 1024; lddst = 1024; gain = P.in[I_NORM1] + l * 1024; }
  else if (mode == 1) { src = P.in[I_WOUT] + (size_t)l * 1024 * 1024; ldsrc = 1024; Nsrc = 1024; dst = (u16*)(ws + WS_WOUT) + (size_t)l * 1024 * 1024; lddst = 1024; }
  else if (mode == 2) { src = P.in[I_WGATE] + (size_t)l * 1024 * DFF; ldsrc = DFF; Nsrc = DFF; dst = (u16*)(ws + WS_WGU) + (size_t)l * 5632 * 1024; lddst = 1024; gain = P.in[I_NORM2] + l * 1024; }
  else if (mode == 3) { src = P.in[I_WUP] + (size_t)l * 1024 * DFF; ldsrc = DFF; Nsrc = DFF; dst = (u16*)(ws + WS_WGU) + (size_t)l * 5632 * 1024; lddst = 1024; gain = P.in[I_NORM2] + l * 1024; }
  else { src = P.in[I_WDOWN] + (size_t)l * DFF * 1024; ldsrc = 1024; Nsrc = 1024; dst = (u16*)(ws + WS_WDN) + (size_t)l * 1024 * DFF; lddst = DFF; }
  const int k0 = kt * 64, n0 = nt * 64;
  {
    const int j = tid & 63, ig = tid >> 6;
    const int n = n0 + j;
#pragma unroll
    for (int ii = 0; ii < 16; ++ii) {
      const int i = ig * 16 + ii, k = k0 + i;
      float v = 0.f;
      if (n < Nsrc) {
        v = src[(size_t)k * ldsrc + n];
        if (mode == 1) { if (k >= 256 && k < 768) v *= P.in[I_SSMN][l * 512 + (k - 256)]; }
        else if (gain) v *= gain[k];
      }
      tile[i * 65 + j] = v;
    }
  }
  __syncthreads();
  {
    const int i8 = tid & 7;
    int kd = k0 + i8 * 8;
    if (mode == 1) kd = (kd < 256) ? kd + 512 : (kd < 768 ? kd - 256 : kd);
#pragma unroll
    for (int jj = 0; jj < 2; ++jj) {
      const int j = (tid >> 3) + 32 * jj;
      const int n = n0 + j;
      int nd = n;
      if (mode == 2) nd = ((n >> 4) << 5) + (n & 15);
      else if (mode == 3) nd = ((n >> 4) << 5) + (n & 15) + 16;
      uint4 o;
      o.x = pack2(tile[(i8 * 8 + 0) * 65 + j], tile[(i8 * 8 + 1) * 65 + j]);
      o.y = pack2(tile[(i8 * 8 + 2) * 65 + j], tile[(i8 * 8 + 3) * 65 + j]);
      o.z = pack2(tile[(i8 * 8 + 4) * 65 + j], tile[(i8 * 8 + 5) * 65 + j]);
      o.w = pack2(tile[(i8 * 8 + 6) * 65 + j], tile[(i8 * 8 + 7) * 65 + j]);
      *(uint4*)(dst + (size_t)nd * lddst + kd) = o;
    }
  }
  __syncthreads();
}

DEVI void xconv_item(const Params& P, int item) {
  u16* AH = (u16*)(P.ws + WS_AH);
#pragma unroll
  for (int i = 0; i < 4; ++i) {
    const size_t e = ((size_t)item * 1024 + i * 256 + threadIdx.x) * 8;
    const float* src = (e < (size_t)SEQ * 1024) ? P.in[I_XP] + e : P.in[I_XS] + (e - (size_t)SEQ * 1024);
    const float4 a = *(const float4*)src, b = *(const float4*)(src + 4);
    uint4 o;
    o.x = pack2(a.x, a.y); o.y = pack2(a.z, a.w); o.z = pack2(b.x, b.y); o.w = pack2(b.z, b.w);
    *(uint4*)(AH + e) = o;
  }
}

DEVI void rope_item(const Params& P, int item) {
  const int e = item * 256 + threadIdx.x;
  if (e >= 16388 * 8) return;
  const int pos = e >> 3, i = e & 7;
  const double inv[8] = {1.0, 0.19392274474868576, 0.03760603093086393, 0.007292664737217109,
                         0.001414213562373095, 0.0002742481756762073, 5.318295896944988e-05, 1.031338537721246e-05};
  double invv = inv[0];
#pragma unroll
  for (int q = 1; q < 8; ++q) invv = (i == q) ? inv[q] : invv;
  const double ang = (double)pos * invv;
  const double n = rint(ang * 0.15915494309189535);
  double r = fma(-n, 6.283185307179586, ang);
  r = fma(-n, 2.4492935982947064e-16, r);
  const double r2 = r * r;
  double S = 1.0, C = 1.0;
#pragma unroll
  for (int k = 14; k >= 1; --k) {
    S = 1.0 - r2 * (1.0 / ((2.0 * k) * (2.0 * k + 1.0))) * S;
    C = 1.0 - r2 * (1.0 / ((2.0 * k - 1.0) * (2.0 * k))) * C;
  }
  float* ROPE = (float*)(P.ws + WS_ROPE);
  ROPE[pos * 16 + i] = (float)C;
  ROPE[pos * 16 + 8 + i] = (float)(r * S);
}

DEVI void attn_item(const Params& P, int l, int variant, int idx, unsigned char* smem) {
  const int tid = opaque_tid(), lane = tid & 63, w = tid >> 6, fr = lane & 15, fq = lane >> 4;
  const int h = idx & 3, qb = idx >> 2;
  const int dil = (variant <= 1) ? 1 : (variant == 2 ? 4 : 16);
  const int maxd = (variant == 0) ? 127 : 128;
  const int nbr = SEQ / dil / 64;
  const int res = qb / nbr, ib = qb % nbr;
  const int i0 = ib * 64;
  const int qofs = (variant == 0 ? 0 : 512) + h * 64;
  const int kofs = (variant == 0 ? 256 : 768) + (h >> 1) * 64;
  const int vofs = kofs + 128;
  const u16* QKV = (const u16*)(P.ws + WS_QKV);
  u16* Qs = (u16*)smem;
  u16* Ks = (u16*)(smem + 9216);
  u16* Vt = (u16*)(smem + 9216 + 27648);
  u16* Ps = Ks;
  {
    const int r = tid >> 2, c = (tid & 3) * 16;
    {
      const size_t pos = (size_t)res + (size_t)dil * (i0 + r);
      const uint4* g = (const uint4*)(QKV + pos * 1024 + qofs + c);
      const uint4 a = g[0], b = g[1];
      *(uint4*)(Qs + r * 72 + c) = a;
      *(uint4*)(Qs + r * 72 + c + 8) = b;
    }
#pragma unroll
    for (int pss = 0; pss < 3; ++pss) {
      const int kk = pss * 64 + r;
      const int ik = i0 - 128 + kk;
      uint4 a = make_uint4(0, 0, 0, 0), b = a, va = a, vb = a;
      if (ik >= 0) {
        const size_t pos = (size_t)res + (size_t)dil * ik;
        const uint4* g = (const uint4*)(QKV + pos * 1024 + kofs + c);
        a = g[0]; b = g[1];
        const uint4* gv = (const uint4*)(QKV + pos * 1024 + vofs + c);
        va = gv[0]; vb = gv[1];
      }
      *(uint4*)(Ks + kk * 72 + c) = a;
      *(uint4*)(Ks + kk * 72 + c + 8) = b;
      const unsigned vv[8] = {va.x, va.y, va.z, va.w, vb.x, vb.y, vb.z, vb.w};
#pragma unroll
      for (int e = 0; e < 8; ++e) {
        Vt[(c + 2 * e) * 200 + kk] = (u16)(vv[e] & 0xffffu);
        Vt[(c + 2 * e + 1) * 200 + kk] = (u16)(vv[e] >> 16);
      }
    }
  }
  __syncthreads();
  f32x4 s[12];
  {
    bf16x8 qa[2];
#pragma unroll
    for (int kk = 0; kk < 2; ++kk) qa[kk] = *(const bf16x8*)(Qs + (w * 16 + fr) * 72 + kk * 32 + fq * 8);
#pragma unroll
    for (int kb = 0; kb < 12; ++kb) {
      f32x4 a = (f32x4){0.f, 0.f, 0.f, 0.f};
#pragma unroll
      for (int kk = 0; kk < 2; ++kk) {
        const bf16x8 kf = *(const bf16x8*)(Ks + (kb * 16 + fr) * 72 + kk * 32 + fq * 8);
        a = mfma16(kf, qa[kk], a);
      }
      s[kb] = a;
    }
  }
  float sink = 0.f;
  if (variant == 0) sink = P.in[I_SINK][l * 4 + h];
  const int iq = i0 + w * 16 + fr;
  float mx = -INFINITY;
#pragma unroll
  for (int kb = 0; kb < 12; ++kb)
#pragma unroll
    for (int r = 0; r < 4; ++r) {
      const int ik = i0 - 128 + kb * 16 + fq * 4 + r;
      const int dist = iq - ik;
      const bool valid = (dist >= 0) && (dist <= maxd) && (ik >= 0);
      const float v = valid ? s[kb][r] * 0.125f : -INFINITY;
      s[kb][r] = v;
      mx = fmaxf(mx, v);
    }
  mx = fmaxf(mx, __shfl_xor(mx, 16)); mx = fmaxf(mx, __shfl_xor(mx, 32));
  if (variant == 0) mx = fmaxf(mx, sink);
  float den = 0.f;
#pragma unroll
  for (int kb = 0; kb < 12; ++kb)
#pragma unroll
    for (int r = 0; r < 4; ++r) {
      const float e = __expf(s[kb][r] - mx);
      s[kb][r] = e;
      den += e;
    }
  den += __shfl_xor(den, 16); den += __shfl_xor(den, 32);
  if (variant == 0) den += __expf(sink - mx);
  __syncthreads();
#pragma unroll
  for (int kb = 0; kb < 12; ++kb)
    *(uint2*)(Ps + (w * 16 + fr) * 200 + kb * 16 + fq * 4) = pack4(s[kb][0], s[kb][1], s[kb][2], s[kb][3]);
  __syncthreads();
  f32x4 o[4];
#pragma unroll
  for (int nb = 0; nb < 4; ++nb) o[nb] = (f32x4){0.f, 0.f, 0.f, 0.f};
#pragma unroll
  for (int ks = 0; ks < 6; ++ks) {
    const bf16x8 pa = *(const bf16x8*)(Ps + (w * 16 + fr) * 200 + ks * 32 + fq * 8);
#pragma unroll
    for (int nb = 0; nb < 4; ++nb) {
      const bf16x8 vf = *(const bf16x8*)(Vt + (nb * 16 + fr) * 200 + ks * 32 + fq * 8);
      o[nb] = mfma16(vf, pa, o[nb]);
    }
  }
  {
    const size_t pos = (size_t)res + (size_t)dil * iq;
    const float inv = 1.f / den;
    if (variant == 0) {
      u16* MIX = (u16*)(P.ws + WS_MIX);
#pragma unroll
      for (int nb = 0; nb < 4; ++nb)
        *(uint2*)(MIX + pos * 1024 + 512 + h * 64 + nb * 16 + fq * 4) = pack4(o[nb][0] * inv, o[nb][1] * inv, o[nb][2] * inv, o[nb][3] * inv);
    } else {
      u16* CO = (u16*)(P.ws + WS_CO) + (size_t)(variant - 1) * SEQ * 256;
#pragma unroll
      for (int nb = 0; nb < 4; ++nb)
        *(uint2*)(CO + pos * 256 + h * 64 + nb * 16 + fq * 4) = pack4(o[nb][0] * inv, o[nb][1] * inv, o[nb][2] * inv, o[nb][3] * inv);
      if (fq == 0) {
        float* LSE = (float*)(P.ws + WS_LSE) + (size_t)(variant - 1) * SEQ * 4;
        LSE[pos * 4 + h] = mx + __logf(den);
      }
    }
  }
  __syncthreads();
}

DEVI void cmerge_item(const Params& P, int item) {
  const int tid = opaque_tid();
  const int tok = item * 8 + (tid >> 5), ch = tid & 31;
  const int h = ch >> 3;
  const float* LSE = (const float*)(P.ws + WS_LSE);
  const u16* CO = (const u16*)(P.ws + WS_CO);
  const float l0 = LSE[(size_t)tok * 4 + h], l1 = LSE[(size_t)(SEQ + tok) * 4 + h], l2 = LSE[(size_t)(2 * SEQ + tok) * 4 + h];
  const float mx = fmaxf(l0, fmaxf(l1, l2));
  float w0 = __expf(l0 - mx), w1 = __expf(l1 - mx), w2 = __expf(l2 - mx);
  const float inv = 1.f / (w0 + w1 + w2);
  w0 *= inv; w1 *= inv; w2 *= inv;
  const uint4 a = *(const uint4*)(CO + (size_t)tok * 256 + ch * 8);
  const uint4 b = *(const uint4*)(CO + ((size_t)SEQ + tok) * 256 + ch * 8);
  const uint4 c = *(const uint4*)(CO + ((size_t)2 * SEQ + tok) * 256 + ch * 8);
  uint4 o;
  o.x = pack2(w0 * bflo(a.x) + w1 * bflo(b.x) + w2 * bflo(c.x), w0 * bfhi(a.x) + w1 * bfhi(b.x) + w2 * bfhi(c.x));
  o.y = pack2(w0 * bflo(a.y) + w1 * bflo(b.y) + w2 * bflo(c.y), w0 * bfhi(a.y) + w1 * bfhi(b.y) + w2 * bfhi(c.y));
  o.z = pack2(w0 * bflo(a.z) + w1 * bflo(b.z) + w2 * bflo(c.z), w0 * bfhi(a.z) + w1 * bfhi(b.z) + w2 * bfhi(c.z));
  o.w = pack2(w0 * bflo(a.w) + w1 * bflo(b.w) + w2 * bflo(c.w), w0 * bfhi(a.w) + w1 * bfhi(b.w) + w2 * bfhi(c.w));
  u16* MIX = (u16*)(P.ws + WS_MIX);
  *(uint4*)(MIX + (size_t)tok * 1024 + 768 + ch * 8) = o;
}

DEVI void sattn_item(const Params& P, int l, int isC, int item, unsigned char* smem) {
  const int tid = opaque_tid(), lane = tid & 63, t = tid >> 6;
  const int b = item >> 1, kvh = item & 1;
  float* qf = (float*)smem + t * 128;
  float* sb = (float*)smem + 512 + t * 784;
  const int row = SEQ + b * 4 + t;
  const u16* QKV = (const u16*)(P.ws + WS_QKV);
  const int nkeys = isC ? 387 : 128;
  const int buf = isC ? 2048 : 128;
  const float* cK = (isC ? P.in[I_CCK] : P.in[I_CAK]) + ((size_t)(l * 128 + b) * buf) * 128 + kvh * 64;
  const float* cV = (isC ? P.in[I_CCV] : P.in[I_CAV]) + ((size_t)(l * 128 + b) * buf) * 128 + kvh * 64;
  const float* nK = P.out + (isC ? OFF_SCK : OFF_SAK) + ((size_t)(l * 128 + b) * buf + (buf - 4)) * 128 + kvh * 64;
  const float* nV = P.out + (isC ? OFF_SCV : OFF_SAV) + ((size_t)(l * 128 + b) * buf + (buf - 4)) * 128 + kvh * 64;
#pragma unroll
  for (int hh = 0; hh < 2; ++hh)
    qf[hh * 64 + lane] = bf2f(QKV[(size_t)row * 1024 + (isC ? 512 : 0) + (kvh * 2 + hh) * 64 + lane]);
  __syncthreads();
  float m0 = -INFINITY, m1 = -INFINITY;
  for (int j = lane; j < nkeys; j += 64) {
    int idx;
    if (isC) { const int pi = j / 129, jj = j - pi * 129; const int d = (pi == 0) ? 1 : (pi == 1 ? 4 : 16); idx = 2048 + t - d * jj; }
    else idx = t + 1 + j;
    const float* kp = (idx < buf) ? cK + (size_t)idx * 128 : nK + (size_t)(idx - buf) * 128;
    float s0 = 0.f, s1 = 0.f;
#pragma unroll
    for (int c4 = 0; c4 < 16; ++c4) {
      const float4 kv = ((const float4*)kp)[c4];
      const float4 q0 = ((const float4*)qf)[c4], q1 = ((const float4*)(qf + 64))[c4];
      s0 += kv.x * q0.x + kv.y * q0.y + kv.z * q0.z + kv.w * q0.w;
      s1 += kv.x * q1.x + kv.y * q1.y + kv.z * q1.z + kv.w * q1.w;
    }
    s0 *= 0.125f; s1 *= 0.125f;
    sb[j] = s0; sb[392 + j] = s1;
    m0 = fmaxf(m0, s0); m1 = fmaxf(m1, s1);
  }
  m0 = wave_max(m0); m1 = wave_max(m1);
  float sk0 = 0.f, sk1 = 0.f;
  if (!isC) {
    sk0 = P.in[I_SINK][l * 4 + kvh * 2]; sk1 = P.in[I_SINK][l * 4 + kvh * 2 + 1];
    m0 = fmaxf(m0, sk0); m1 = fmaxf(m1, sk1);
  }
  float d0 = 0.f, d1 = 0.f;
  for (int j = lane; j < nkeys; j += 64) {
    const float e0 = __expf(sb[j] - m0), e1 = __expf(sb[392 + j] - m1);
    sb[j] = e0; sb[392 + j] = e1;
    d0 += e0; d1 += e1;
  }
  d0 = wave_sum(d0); d1 = wave_sum(d1);
  if (!isC) { d0 += __expf(sk0 - m0); d1 += __expf(sk1 - m1); }
  __syncthreads();
  const int g4 = lane >> 4, c4 = lane & 15;
  float a0[4] = {0.f, 0.f, 0.f, 0.f}, a1[4] = {0.f, 0.f, 0.f, 0.f};
  const int nsteps = (nkeys + 3) >> 2;
#pragma unroll 8
  for (int js = 0; js < nsteps; ++js) {
    const int jraw = js * 4 + g4;
    const int j = jraw < nkeys ? jraw : nkeys - 1;
    int idx;
    if (isC) { const int pi = j / 129, jj = j - pi * 129; const int d = (pi == 0) ? 1 : (pi == 1 ? 4 : 16); idx = 2048 + t - d * jj; }
    else idx = t + 1 + j;
    const float* vp = (idx < buf) ? cV + (size_t)idx * 128 : nV + (size_t)(idx - buf) * 128;
    const float4 v = ((const float4*)vp)[c4];
    const float p0 = jraw < nkeys ? sb[j] : 0.f, p1 = jraw < nkeys ? sb[392 + j] : 0.f;
    a0[0] += p0 * v.x; a0[1] += p0 * v.y; a0[2] += p0 * v.z; a0[3] += p0 * v.w;
    a1[0] += p1 * v.x; a1[1] += p1 * v.y; a1[2] += p1 * v.z; a1[3] += p1 * v.w;
  }
#pragma unroll
  for (int i = 0; i < 4; ++i) {
    a0[i] += __shfl_xor(a0[i], 16); a0[i] += __shfl_xor(a0[i], 32);
    a1[i] += __shfl_xor(a1[i], 16); a1[i] += __shfl_xor(a1[i], 32);
  }
  u16* MIX = (u16*)(P.ws + WS_MIX);
  const int mo = isC ? 768 : 512;
  if (g4 == 0) {
    const float i0 = 1.f / d0, i1 = 1.f / d1;
    uint2 w0, w1;
    w0.x = pack2(a0[0] * i0, a0[1] * i0); w0.y = pack2(a0[2] * i0, a0[3] * i0);
    w1.x = pack2(a1[0] * i1, a1[1] * i1); w1.y = pack2(a1[2] * i1, a1[3] * i1);
    *(uint2*)(MIX + (size_t)row * 1024 + mo + (kvh * 2) * 64 + c4 * 4) = w0;
    *(uint2*)(MIX + (size_t)row * 1024 + mo + (kvh * 2 + 1) * 64 + c4 * 4) = w1;
  }
  __syncthreads();
}

DEVI void smamba_item(const Params& P, int l, int item, unsigned char* smem) {
  const int tid = opaque_tid();
  const int b = item >> 3, h = item & 7, g = h >> 2;
  float* xa = (float*)smem;
  float* Ba = xa + 256;
  float* Ca = Ba + 512;
  const u16* XBC = (const u16*)(P.ws + WS_XBC);
  const float* DT = (const float*)(P.ws + WS_DT);
  const u16* Z = (const u16*)(P.ws + WS_Z);
  const int row0 = SEQ + b * 4;
  for (int ci = tid; ci < 320; ci += 256) {
    int ch; float* dst; int dl;
    if (ci < 64) { ch = h * 64 + ci; dst = xa + ci; dl = 64; }
    else if (ci < 192) { ch = 512 + g * 128 + (ci - 64); dst = Ba + (ci - 64); dl = 128; }
    else { ch = 768 + g * 128 + (ci - 192); dst = Ca + (ci - 192); dl = 128; }
    float sq[7];
#pragma unroll
    for (int j = 0; j < 3; ++j) sq[j] = P.in[I_SCONV][((size_t)(l * 128 + b) * 3 + j) * 1024 + ch];
#pragma unroll
    for (int j = 0; j < 4; ++j) sq[3 + j] = bf2f(XBC[(size_t)(row0 + j) * 1024 + ch]);
    const float w0 = P.in[I_CONVW][(l * 4 + 0) * 1024 + ch], w1 = P.in[I_CONVW][(l * 4 + 1) * 1024 + ch];
    const float w2 = P.in[I_CONVW][(l * 4 + 2) * 1024 + ch], w3 = P.in[I_CONVW][(l * 4 + 3) * 1024 + ch];
    const float bs = P.in[I_CONVB][l * 1024 + ch];
#pragma unroll
    for (int t = 0; t < 4; ++t) dst[t * dl] = siluf(bs + w0 * sq[t] + w1 * sq[t + 1] + w2 * sq[t + 2] + w3 * sq[t + 3]);
  }
  __syncthreads();
  const int p = tid >> 2, nq = tid & 3;
  float hs[32];
  const float* sp = P.in[I_SSM] + (((size_t)(l * 128 + b) * 8 + h) * 64 + p) * 128 + nq * 32;
#pragma unroll
  for (int i = 0; i < 8; ++i) {
    const float4 v = ((const float4*)sp)[i];
    hs[4 * i] = v.x; hs[4 * i + 1] = v.y; hs[4 * i + 2] = v.z; hs[4 * i + 3] = v.w;
  }
  const float dtb = P.in[I_DTB][l * 8 + h], aneg = -__expf(P.in[I_ALOG][l * 8 + h]), dsk = P.in[I_DSKIP][l * 8 + h];
  u16* MIX = (u16*)(P.ws + WS_MIX);
#pragma unroll
  for (int t = 0; t < 4; ++t) {
    const float dt = softplusf(DT[(size_t)(row0 + t) * 8 + h] + dtb);
    const float dA = __expf(aneg * dt);
    const float xv = xa[t * 64 + p];
    const float xdt = xv * dt;
    float yp = 0.f;
#pragma unroll
    for (int i = 0; i < 32; ++i) {
      hs[i] = hs[i] * dA + xdt * Ba[t * 128 + nq * 32 + i];
      yp += Ca[t * 128 + nq * 32 + i] * hs[i];
    }
    yp += __shfl_xor(yp, 1); yp += __shfl_xor(yp, 2);
    float y = yp + xv * dsk;
    y *= siluf(bf2f(Z[(size_t)(row0 + t) * 512 + h * 64 + p]));
    if (nq == 0) MIX[(size_t)(row0 + t) * 1024 + h * 64 + p] = f2bf(y);
  }
  float* op = P.out + OFF_SSSM + (((size_t)(l * 128 + b) * 8 + h) * 64 + p) * 128 + nq * 32;
#pragma unroll
  for (int i = 0; i < 8; ++i) ((float4*)op)[i] = make_float4(hs[4 * i], hs[4 * i + 1], hs[4 * i + 2], hs[4 * i + 3]);
  __syncthreads();
}

DEVI void ssd_dt_acum(const Params& P, int l, int c, int h, float* dtv, float* acum) {
  const int tid = opaque_tid(), lane = tid & 63;
  const float* DT = (const float*)(P.ws + WS_DT);
  const float aneg = -__expf(P.in[I_ALOG][l * 8 + h]);
  float a = 0.f;
  if (tid < 128) {
    const float dt = softplusf(DT[(size_t)(c * 128 + tid) * 8 + h] + P.in[I_DTB][l * 8 + h]);
    dtv[tid] = dt;
    a = aneg * dt;
  }
#pragma unroll
  for (int o = 1; o < 64; o <<= 1) {
    const float n = __shfl_up(a, o);
    if (lane >= o) a += n;
  }
  if (tid == 63) dtv[128] = a;
  __syncthreads();
  if (tid >= 64 && tid < 128) a += dtv[128];
  if (tid < 128) acum[tid] = a;
  __syncthreads();
}

template <class F>
DEVI void conv_rows(const Params& P, int l, int tok0, int n, int ch, F f) {
  const u16* XBC = (const u16*)(P.ws + WS_XBC);
  const float w0 = P.in[I_CONVW][(l * 4 + 0) * 1024 + ch], w1 = P.in[I_CONVW][(l * 4 + 1) * 1024 + ch];
  const float w2 = P.in[I_CONVW][(l * 4 + 2) * 1024 + ch], w3 = P.in[I_CONVW][(l * 4 + 3) * 1024 + ch];
  const float bs = P.in[I_CONVB][l * 1024 + ch];
  float x0 = (tok0 - 3 >= 0) ? bf2f(XBC[(size_t)(tok0 - 3) * 1024 + ch]) : 0.f;
  float x1 = (tok0 - 2 >= 0) ? bf2f(XBC[(size_t)(tok0 - 2) * 1024 + ch]) : 0.f;
  float x2 = (tok0 - 1 >= 0) ? bf2f(XBC[(size_t)(tok0 - 1) * 1024 + ch]) : 0.f;
  for (int b = 0; b < n; b += 32) {
    u16 raw[32];
#pragma unroll
    for (int t = 0; t < 32; ++t) raw[t] = XBC[(size_t)(tok0 + b + t) * 1024 + ch];
#pragma unroll
    for (int t = 0; t < 32; ++t) {
      const float x3 = bf2f(raw[t]);
      f(b + t, siluf(bs + w0 * x0 + w1 * x1 + w2 * x2 + w3 * x3));
      x0 = x1; x1 = x2; x2 = x3;
    }
  }
}

template <int N>
struct ConvBuf2 { unsigned raw[N + 3]; float wa[5], wb[5]; };
template <int N>
DEVI void conv2_load(const Params& P, int l, int tok0, int ch, ConvBuf2<N>& cb) {
  const u16* XBC = (const u16*)(P.ws + WS_XBC);
#pragma unroll
  for (int j = 0; j < 3; ++j) cb.raw[j] = (tok0 - 3 + j >= 0) ? *(const unsigned*)(XBC + (size_t)(tok0 - 3 + j) * 1024 + ch) : 0u;
#pragma unroll
  for (int t = 0; t < N; ++t) cb.raw[3 + t] = *(const unsigned*)(XBC + (size_t)(tok0 + t) * 1024 + ch);
#pragma unroll
  for (int j = 0; j < 4; ++j) {
    cb.wa[j] = P.in[I_CONVW][(l * 4 + j) * 1024 + ch];
    cb.wb[j] = P.in[I_CONVW][(l * 4 + j) * 1024 + ch + 1];
  }
  cb.wa[4] = P.in[I_CONVB][l * 1024 + ch];
  cb.wb[4] = P.in[I_CONVB][l * 1024 + ch + 1];
}
template <int N, class F>
DEVI void conv2_apply(const ConvBuf2<N>& cb, F f) {
#pragma unroll
  for (int t = 0; t < N; ++t) {
    const float va = siluf(cb.wa[4] + cb.wa[0] * bflo(cb.raw[t]) + cb.wa[1] * bflo(cb.raw[t + 1]) + cb.wa[2] * bflo(cb.raw[t + 2]) + cb.wa[3] * bflo(cb.raw[t + 3]));
    const float vb = siluf(cb.wb[4] + cb.wb[0] * bfhi(cb.raw[t]) + cb.wb[1] * bfhi(cb.raw[t + 1]) + cb.wb[2] * bfhi(cb.raw[t + 2]) + cb.wb[3] * bfhi(cb.raw[t + 3]));
    f(t, va, vb);
  }
}

DEVI void ssd_cs_item(const Params& P, int l, int item, unsigned char* smem) {
  const int tid = opaque_tid(), lane = tid & 63, w = tid >> 6, fr = lane & 15, fq = lane >> 4;
  const int c = item >> 3, h = item & 7, g = h >> 2;
  u16* xT = (u16*)smem;
  u16* BT = (u16*)(smem + 17408);
  float* acum = (float*)(smem + 17408 + 34816);
  float* dtv = acum + 128;
  ConvBuf2<16> cX;
  ConvBuf2<32> cB;
  conv2_load<16>(P, l, c * 128 + (tid >> 5) * 16, h * 64 + 2 * (tid & 31), cX);
  conv2_load<32>(P, l, c * 128 + (tid >> 6) * 32, 512 + g * 128 + 2 * (tid & 63), cB);
  ssd_dt_acum(P, l, c, h, dtv, acum);
  const float aend = acum[127];
  {
    const int cp = tid & 31, rg = tid >> 5;
    conv2_apply<16>(cX, [&](int t, float va, float vb) {
      const int s = rg * 16 + t;
      const float e = dtv[s] * __expf(aend - acum[s]);
      xT[(2 * cp) * 136 + s] = f2bf(va * e);
      xT[(2 * cp + 1) * 136 + s] = f2bf(vb * e);
    });
  }
  {
    const int cp = tid & 63, rg = tid >> 6;
    conv2_apply<32>(cB, [&](int t, float va, float vb) {
      BT[(2 * cp) * 136 + rg * 32 + t] = f2bf(va);
      BT[(2 * cp + 1) * 136 + rg * 32 + t] = f2bf(vb);
    });
  }
  __syncthreads();
  float* CS = (float*)(P.ws + WS_CS) + (size_t)(c * 8 + h) * 8192;
  bf16x8 xa[4];
#pragma unroll
  for (int ks = 0; ks < 4; ++ks) xa[ks] = *(const bf16x8*)(xT + (w * 16 + fr) * 136 + ks * 32 + fq * 8);
#pragma unroll
  for (int nb = 0; nb < 8; ++nb) {
    f32x4 a = (f32x4){0.f, 0.f, 0.f, 0.f};
#pragma unroll
    for (int ks = 0; ks < 4; ++ks) {
      const bf16x8 bfg = *(const bf16x8*)(BT + (nb * 16 + fr) * 136 + ks * 32 + fq * 8);
      a = mfma16(xa[ks], bfg, a);
    }
#pragma unroll
    for (int r = 0; r < 4; ++r) CS[(w * 16 + fq * 4 + r) * 128 + nb * 16 + fr] = a[r];
  }
  if (tid == 0) ((float*)(P.ws + WS_CD))[c * 8 + h] = __expf(aend);
  __syncthreads();
}

DEVI void ssd_scan_item(const Params& P, int l, int item) {
  const int e = item * 256 + threadIdx.x;
  const int h = e >> 13;
  const float* CS = (const float*)(P.ws + WS_CS);
  const float* CD = (const float*)(P.ws + WS_CD);
  u16* HIN = (u16*)(P.ws + WS_HIN);
  float hc = 0.f;
#pragma unroll 32
  for (int c = 0; c < 128; ++c) {
    HIN[(size_t)c * 65536 + e] = f2bf(hc);
    hc = hc * CD[c * 8 + h] + CS[(size_t)c * 65536 + e];
  }
  P.out[OFF_PSSM + (size_t)l * 65536 + e] = hc;
}

DEVI void ssd_y_item(const Params& P, int l, int item, unsigned char* smem) {
  const int tid = opaque_tid(), lane = tid & 63, w = tid >> 6, fr = lane & 15, fq = lane >> 4;
  const int half = item & 1, h = (item >> 1) & 7, c = item >> 4, g = h >> 2;
  const int l0 = half * 64;
  u16* Cs = (u16*)smem;
  u16* Hs = (u16*)(smem + 17408);
  u16* Bs = (u16*)(smem + 34816);
  float* acum = (float*)(smem + 69632);
  float* dtv = acum + 128;
  u16* Gs = Hs;
  u16* xT = Bs;
  ConvBuf2<16> cC, cX;
  ConvBuf2<32> cB;
  u32x4 hin[4];
  conv2_load<16>(P, l, c * 128 + l0 + (tid >> 6) * 16, 768 + g * 128 + 2 * (tid & 63), cC);
  conv2_load<32>(P, l, c * 128 + (tid >> 6) * 32, 512 + g * 128 + 2 * (tid & 63), cB);
  conv2_load<16>(P, l, c * 128 + (tid >> 5) * 16, h * 64 + 2 * (tid & 31), cX);
  {
    const u16* HIN = (const u16*)(P.ws + WS_HIN) + (size_t)(c * 8 + h) * 8192;
    const int r = tid >> 2, cq = (tid & 3) * 32;
#pragma unroll
    for (int i = 0; i < 4; ++i) hin[i] = *(const u32x4*)(HIN + r * 128 + cq + i * 8);
  }
  ssd_dt_acum(P, l, c, h, dtv, acum);
  {
    const int cp = tid & 63, rg = tid >> 6;
    conv2_apply<16>(cC, [&](int t, float va, float vb) {
      *(unsigned*)(Cs + (rg * 16 + t) * 136 + 2 * cp) = pack2(va, vb);
    });
    conv2_apply<32>(cB, [&](int t, float va, float vb) {
      *(unsigned*)(Bs + (rg * 32 + t) * 136 + 2 * cp) = pack2(va, vb);
    });
    const int r = tid >> 2, cq = (tid & 3) * 32;
#pragma unroll
    for (int i = 0; i < 4; ++i) *(u32x4*)(Hs + r * 136 + cq + i * 8) = hin[i];
  }
  __syncthreads();
  f32x4 y[4];
  f32x4 cb[8];
  {
    bf16x8 ca[4];
#pragma unroll
    for (int ks = 0; ks < 4; ++ks) ca[ks] = *(const bf16x8*)(Cs + (w * 16 + fr) * 136 + ks * 32 + fq * 8);
#pragma unroll
    for (int nb = 0; nb < 4; ++nb) {
      f32x4 a = (f32x4){0.f, 0.f, 0.f, 0.f};
#pragma unroll
      for (int ks = 0; ks < 4; ++ks) a = mfma16(ca[ks], *(const bf16x8*)(Hs + (nb * 16 + fr) * 136 + ks * 32 + fq * 8), a);
      y[nb] = a;
    }
#pragma unroll
    for (int sbk = 0; sbk < 8; ++sbk) {
      f32x4 a = (f32x4){0.f, 0.f, 0.f, 0.f};
#pragma unroll
      for (int ks = 0; ks < 4; ++ks) a = mfma16(ca[ks], *(const bf16x8*)(Bs + (sbk * 16 + fr) * 136 + ks * 32 + fq * 8), a);
      cb[sbk] = a;
    }
  }
  float al[4];
#pragma unroll
  for (int r = 0; r < 4; ++r) al[r] = acum[l0 + w * 16 + fq * 4 + r];
  __syncthreads();
#pragma unroll
  for (int sbk = 0; sbk < 8; ++sbk) {
    const int s = sbk * 16 + fr;
    const float as = acum[s];
#pragma unroll
    for (int r = 0; r < 4; ++r) {
      const int ll = l0 + w * 16 + fq * 4 + r;
      const float gval = (s <= ll) ? cb[sbk][r] * __expf(al[r] - as) : 0.f;
      Gs[(w * 16 + fq * 4 + r) * 136 + s] = f2bf(gval);
    }
  }
  {
    const int cp = tid & 31, rg = tid >> 5;
    conv2_apply<16>(cX, [&](int t, float va, float vb) {
      const int s = rg * 16 + t;
      xT[(2 * cp) * 136 + s] = f2bf(va * dtv[s]);
      xT[(2 * cp + 1) * 136 + s] = f2bf(vb * dtv[s]);
    });
  }
  __syncthreads();
  f32x4 yd[4];
#pragma unroll
  for (int nb = 0; nb < 4; ++nb) yd[nb] = (f32x4){0.f, 0.f, 0.f, 0.f};
#pragma unroll
  for (int ks = 0; ks < 4; ++ks) {
    const bf16x8 ga = *(const bf16x8*)(Gs + (w * 16 + fr) * 136 + ks * 32 + fq * 8);
#pragma unroll
    for (int nb = 0; nb < 4; ++nb) yd[nb] = mfma16(ga, *(const bf16x8*)(xT + (nb * 16 + fr) * 136 + ks * 32 + fq * 8), yd[nb]);
  }
  const float dsk = P.in[I_DSKIP][l * 8 + h];
  const u16* Z = (const u16*)(P.ws + WS_Z);
  u16* MIX = (u16*)(P.ws + WS_MIX);
#pragma unroll
  for (int r = 0; r < 4; ++r) {
    const int ll = l0 + w * 16 + fq * 4 + r;
    const size_t tok = (size_t)c * 128 + ll;
    const float idt = 1.f / dtv[ll];
    const float eal = __expf(al[r]);
#pragma unroll
    for (int nb = 0; nb < 4; ++nb) {
      const int p = nb * 16 + fr;
      float yv = yd[nb][r] + y[nb][r] * eal + bf2f(xT[p * 136 + ll]) * idt * dsk;
      yv *= siluf(bf2f(Z[tok * 512 + h * 64 + p]));
      MIX[tok * 1024 + h * 64 + p] = f2bf(yv);
    }
  }
  __syncthreads();
}

DEVI void mixnorm_item(const Params& P, int item) {
  const int tid = opaque_tid(), lane = tid & 63, w = tid >> 6;
  const int row = item * 4 + w;
  u16* MIX = (u16*)(P.ws + WS_MIX) + (size_t)row * 1024 + lane * 8;
  const uint4 v = *(const uint4*)MIX;
  float f[8] = {bflo(v.x), bfhi(v.x), bflo(v.y), bfhi(v.y), bflo(v.z), bfhi(v.z), bflo(v.w), bfhi(v.w)};
  float s = 0.f;
#pragma unroll
  for (int i = 0; i < 8; ++i) s += f[i] * f[i];
  s = wave_sum(s);
  const float sc = rsqrtf(s * (1.f / 512.f) + EPS);
  uint4 o;
  o.x = pack2(f[0] * sc, f[1] * sc); o.y = pack2(f[2] * sc, f[3] * sc);
  o.z = pack2(f[4] * sc, f[5] * sc); o.w = pack2(f[6] * sc, f[7] * sc);
  *(uint4*)MIX = o;
}

DEVI void copy_item(const Params& P, int l, int item) {
  const float* src; float* dst; int n4;
  int s4;
  if (item < 4096) {
    const int part = item & 15, kv = (item >> 4) & 1, b = item >> 5;
    const size_t base = (size_t)(l * 128 + b) * 262144;
    src = (kv ? P.in[I_CCV] : P.in[I_CCK]) + base + 512;
    dst = P.out + (kv ? OFF_SCV : OFF_SCK) + base;
    s4 = part * 4096;
    n4 = min(4096, 65408 - s4);
  } else {
    const int it = item - 4096;
    const int kv = it & 1, b = it >> 1;
    const size_t base = (size_t)(l * 128 + b) * 16384;
    src = (kv ? P.in[I_CAV] : P.in[I_CAK]) + base + 512;
    dst = P.out + (kv ? OFF_SAV : OFF_SAK) + base;
    s4 = 0; n4 = 3968;
  }
  const f32x4* s = (const f32x4*)src + s4;
  f32x4* d = (f32x4*)dst + s4;
  const int t = threadIdx.x;
  f32x4 v[16];
#pragma unroll
  for (int i = 0; i < 16; ++i)
    if (i * 256 + t < n4) v[i] = __builtin_nontemporal_load(s + i * 256 + t);
#pragma unroll
  for (int i = 0; i < 16; ++i)
    if (i * 256 + t < n4) __builtin_nontemporal_store(v[i], d + i * 256 + t);
}

DEVI void copy_ptrs(const Params& P, int l, int item, const f32x4*& s, f32x4*& d, int& n4) {
  if (item < 4096) {
    const int part = item & 15, kv = (item >> 4) & 1, b = item >> 5;
    const size_t base = (size_t)(l * 128 + b) * 262144;
    s = (const f32x4*)((kv ? P.in[I_CCV] : P.in[I_CCK]) + base + 512) + part * 4096;
    d = (f32x4*)(P.out + (kv ? OFF_SCV : OFF_SCK) + base) + part * 4096;
    n4 = min(4096, 65408 - part * 4096);
  } else {
    const int it = item - 4096;
    const int kv = it & 1, b = it >> 1;
    const size_t base = (size_t)(l * 128 + b) * 16384;
    s = (const f32x4*)((kv ? P.in[I_CAV] : P.in[I_CAK]) + base + 512);
    d = (f32x4*)(P.out + (kv ? OFF_SAV : OFF_SAK) + base);
    n4 = 3968;
  }
}

struct GBar { unsigned* bar; unsigned epoch; unsigned x; unsigned nloc; unsigned nx; };
DEVI unsigned bar_ld(unsigned* p) { return __hip_atomic_load(p, __ATOMIC_RELAXED, __HIP_MEMORY_SCOPE_AGENT); }
DEVI unsigned bar_add(unsigned* p, unsigned v) { return __hip_atomic_fetch_add(p, v, __ATOMIC_RELAXED, __HIP_MEMORY_SCOPE_AGENT); }
DEVI void gsync_flat(GBar& g) {
  asm volatile("s_waitcnt vmcnt(0) lgkmcnt(0)" ::: "memory");
  __syncthreads();
  if (threadIdx.x == 0) {
    __builtin_amdgcn_fence(__ATOMIC_RELEASE, "agent");
    asm volatile("s_waitcnt vmcnt(0)" ::: "memory");
    bar_add(g.bar, 1u);
    while (bar_ld(g.bar) < gridDim.x) __builtin_amdgcn_s_sleep(2);
    __builtin_amdgcn_fence(__ATOMIC_ACQUIRE, "agent");
    asm volatile("s_waitcnt vmcnt(0)" ::: "memory");
  }
  __syncthreads();
}
DEVI void gsync(GBar& g) {
  asm volatile("s_waitcnt vmcnt(0) lgkmcnt(0)" ::: "memory");
  __syncthreads();
  g.epoch++;
  if (threadIdx.x == 0) {
    const unsigned old = bar_add(g.bar + 32 * (1 + g.x), 1u);
    if (old == g.epoch * g.nloc - 1u) {
      __builtin_amdgcn_fence(__ATOMIC_RELEASE, "agent");
      asm volatile("s_waitcnt vmcnt(0)" ::: "memory");
      bar_add(g.bar + 32 * 9, 1u);
    }
    const unsigned target = g.epoch * g.nx;
    while (bar_ld(g.bar + 32 * 9) < target) __builtin_amdgcn_s_sleep(1);
    __builtin_amdgcn_fence(__ATOMIC_ACQUIRE, "agent");
    asm volatile("s_waitcnt vmcnt(0)" ::: "memory");
  }
  __syncthreads();
}

__global__ void __launch_bounds__(256, 2) hymba_megakernel(Params P) {
  extern __shared__ __attribute__((aligned(16))) unsigned char smem[];
  cg::grid_group cgrid = cg::this_grid();
  GBar grid; grid.bar = (unsigned*)(P.ws + WS_BAR); grid.epoch = 0;
  grid.x = (unsigned)__builtin_amdgcn_s_getreg((3 << 11) | 20) & 7u;
  if (threadIdx.x == 0) bar_add(grid.bar + 32 * 10 + grid.x, 1u);
  const int nb = gridDim.x, bid = blockIdx.x;
  const int vbid = ((nb & 7) == 0) ? (bid & 7) * (nb >> 3) + (bid >> 3) : bid;
  unsigned char* ws = P.ws;

#ifdef NANFILL
  {
    uint4* w4 = (uint4*)ws;
    const size_t n4 = WS_END / 16;
    const uint4 pat = make_uint4(0xffffffffu, 0xffffffffu, 0xffffffffu, 0xffffffffu);
    for (size_t i = (size_t)bid * 256 + threadIdx.x; i < n4; i += (size_t)nb * 256) w4[i] = pat;
    for (int i = threadIdx.x; i < LDS_BYTES / 16; i += 256) ((uint4*)smem)[i] = pat;
  }
  gsync(grid);
#endif
  {
    const int NW = 2 * 3040, NX = 2112, NR = 513;
    for (int it = bid; it < NW + NX + NR; it += nb) {
      if ((PHM & 1) && it < NW) {
        const int l = it / 3040;
        int r = it % 3040;
        if (r < 672) wconv_item(P, 0, l, r / 42, r % 42, smem);
        else if ((r -= 672) < 256) wconv_item(P, 1, l, r / 16, r % 16, smem);
        else if ((r -= 256) < 704) wconv_item(P, 2, l, r / 44, r % 44, smem);
        else if ((r -= 704) < 704) wconv_item(P, 3, l, r / 44, r % 44, smem);
        else { r -= 704; wconv_item(P, 4, l, r / 16, r % 16, smem); }
      } else if (it < NW + NX) { if (PHM & 2) xconv_item(P, it - NW); }
      else if (PHM & 2) rope_item(P, it - NW - NX);
    }
  }
  asm volatile("s_waitcnt vmcnt(0) lgkmcnt(0)" ::: "memory");
  __syncthreads();
  cgrid.sync();
  if (threadIdx.x == 0) __builtin_amdgcn_fence(__ATOMIC_ACQUIRE, "agent");
  asm volatile("s_waitcnt vmcnt(0)" ::: "memory");
  __syncthreads();
  {
    unsigned nx = 0;
#pragma unroll
    for (int i = 0; i < 8; ++i) nx += (bar_ld(grid.bar + 32 * 10 + i) != 0u) ? 1u : 0u;
    grid.nx = nx;
    grid.nloc = bar_ld(grid.bar + 32 * 10 + grid.x);
  }

#ifdef DELAYTEST
  {
    const unsigned long long t0 = wall_clock64();
    while (wall_clock64() - t0 < 200000ull) __builtin_amdgcn_s_sleep(8);
    __syncthreads();
    if (threadIdx.x == 0) __builtin_amdgcn_fence(__ATOMIC_ACQUIRE, "agent");
    asm volatile("s_waitcnt vmcnt(0)" ::: "memory");
    __syncthreads();
  }
#endif
#ifdef E2TEST
  {
    const u16* AHp = (const u16*)(ws + WS_AH);
    const u16* WTp = (const u16*)(ws + WS_WIN);
    for (size_t i = (size_t)bid * 256 + threadIdx.x; i < (size_t)NT * 1024; i += (size_t)nb * 256) P.out[OFF_Y + i] = bf2f(AHp[i]) * 1.2345678f + 0.1f;
    for (size_t i = (size_t)bid * 256 + threadIdx.x; i < (size_t)2 * NINP * 1024; i += (size_t)nb * 256) P.out[OFF_SCK + i] = bf2f(WTp[i]) * 1.2345678f + 0.001f;
    return;
  }
#endif
#pragma unroll 1
  for (int l = 0; l < 2; ++l) {
    {
      const u16* A = (const u16*)(ws + WS_AH);
      const u16* Bt = (const u16*)(ws + WS_WIN) + (size_t)l * NINP * 1024;
      for (int t = vbid; t < 132 * 21; t += nb) {
        const int rt = t / 21, ct = t % 21;
        if (PHM & 4) gemm_tile<EPI_IN>(P, l, A, 1024, Bt, 1024, 1024, XKS, rt * 128, ct * 128, smem);
      }
    }
    gsync(grid);
    if (STOPAT == 1) return;
    {
      const int N_SC = 256, N_SA = 256, N_AT = 4096, N_CS = 1024, N_SM = 1024, N_CP = 1952;
      const int tot = N_SC + N_SA + N_AT + N_CS + N_SM;
      for (int it = bid; it < tot; it += nb) {
        int r = it;
        int lq = l;
        asm volatile("" : "+s"(lq));
        if (r < N_SC) { if (PHM & 8) sattn_item(P, lq, 1, r, smem); }
        else if ((r -= N_SC) < N_SA) { if (PHM & 8) sattn_item(P, lq, 0, r, smem); }
        else if ((r -= N_SA) < N_AT) { if (PHM & 16) attn_item(P, lq, r >> 10, r & 1023, smem); }
        else if ((r -= N_AT) < N_CS) { if (PHM & 32) ssd_cs_item(P, lq, r, smem); }
        else { r -= N_CS; if (PHM & 64) smamba_item(P, lq, r, smem); }
      }
      const int hb = nb >> 1;
      if (bid >= hb)
        for (int ci = bid - hb; ci < N_CP; ci += nb - hb) copy_item(P, l, ci);
    }
    gsync(grid);
    if (STOPAT == 2) return;
    {
      for (int it = bid; it < 256 + 2048 + 800; it += nb) {
        if (it < 256) { if (PHM & 256) ssd_scan_item(P, l, it); }
        else if (it < 2304) { if (PHM & 256) cmerge_item(P, it - 256); }
        else copy_item(P, l, 1952 + (it - 2304));
      }
    }
    gsync(grid);
    if (STOPAT == 3) return;
    for (int k = 0;; ++k) {
      const int yi = bid + k * nb, ci = 2752 + bid + k * nb;
      if (yi >= 2048 && ci >= 4352) break;
      if (yi < 2048) ssd_y_item(P, l, yi, smem);
      if (ci < 4352) copy_item(P, l, ci);
    }
    gsync(grid);
    for (int it = bid; it < NT / 4; it += nb) mixnorm_item(P, it);
    gsync(grid);
    if (STOPAT == 4) return;
    {
      const u16* A = (const u16*)(ws + WS_MIX);
      const u16* Bt = (const u16*)(ws + WS_WOUT) + (size_t)l * 1024 * 1024;
      for (int t = vbid; t < 132 * 8; t += nb) {
        const int rt = t / 8, ct = t % 8;
        if (PHM & 1024) gemm_tile<EPI_OUT>(P, l, A, 1024, Bt, 1024, 1024, 0, rt * 128, ct * 128, smem);
      }
    }
    gsync(grid);
    if (STOPAT == 5) return;
    {
      const u16* A = (const u16*)(ws + WS_AH1);
      const u16* Bt = (const u16*)(ws + WS_WGU) + (size_t)l * 5632 * 1024;
      const int NCP = 0, NTL = 132 * 44;
      for (int it = vbid; it < NTL + NCP; it += nb) {
        int t;
        if (it < 2 * NCP) {
          if (!(it & 1)) { copy_item(P, l, it >> 1); continue; }
          t = it >> 1;
        } else t = it - NCP;
        const int rt = t / 44, ct = t % 44;
        if (PHM & 2048) gemm_tile<EPI_GU>(P, l, A, 1024, Bt, 1024, 1024, 1024, rt * 128, ct * 128, smem);
      }
    }
    gsync(grid);
    if (STOPAT == 6) return;
    {
      const u16* A = (const u16*)(ws + WS_G);
      const u16* Bt = (const u16*)(ws + WS_WDN) + (size_t)l * 1024 * DFF;
      for (int t = vbid; t < 132 * 8; t += nb) {
        const int rt = t / 8, ct = t % 8;
        if (PHM & 4096) gemm_tile<EPI_DN>(P, l, A, DFF, Bt, DFF, DFF, 0, rt * 128, ct * 128, smem);
      }
    }
    if (l == 0) gsync(grid);
  }
}

extern "C" void kernel_launch(void* const* d_in, const int* in_sizes, int n_in, void* d_out, int out_size, void* d_ws,
                              size_t ws_size, hipStream_t stream) {
  static int grid_blocks = 0;
  if (!grid_blocks) {
    int dev = 0, cus = 0, per_cu = 0;
    (void)hipGetDevice(&dev);
    (void)hipDeviceGetAttribute(&cus, hipDeviceAttributeMultiprocessorCount, dev);
    (void)hipFuncSetAttribute((const void*)hymba_megakernel, hipFuncAttributeMaxDynamicSharedMemorySize, LDS_BYTES);
    (void)hipOccupancyMaxActiveBlocksPerMultiprocessor(&per_cu, hymba_megakernel, 256, LDS_BYTES);
    if (per_cu < 1) per_cu = 1;
    if (per_cu > 2) per_cu = 2;
    grid_blocks = cus * per_cu;
  }
  Params p{};
  for (int i = 0; i < 26; ++i) p.in[i] = (const float*)d_in[i];
  p.out = (float*)d_out;
  p.ws = (unsigned char*)d_ws;
  (void)hipMemsetAsync((unsigned char*)d_ws + WS_BAR, 0, 2048, stream);
  void* args[] = {&p};
  hipError_t e = hipLaunchCooperativeKernel((void*)hymba_megakernel, dim3(grid_blocks), dim3(256), args, LDS_BYTES, stream);
  if (e != hipSuccess) fprintf(stderr, "cooperative launch failed: %s (grid %d)\n", hipGetErrorString(e), grid_blocks);
}
```

```cpp
#include <hip/hip_runtime.h>
#include <hip/hip_bf16.h>
#include <hip/hip_cooperative_groups.h>
#include <cstdio>
namespace cg = cooperative_groups;

typedef unsigned short u16;
using bf16x8 = __attribute__((ext_vector_type(8))) short;
using f32x4 = __attribute__((ext_vector_type(4))) float;
using u32x4 = __attribute__((ext_vector_type(4))) unsigned int;
#define DEVI __device__ __forceinline__

constexpr int DM = 1024, SEQ = 16384, NSAMP = 512, NT = SEQ + NSAMP, NB = 128;
constexpr int NINP = 2688, NIN = 2568, DFF = 2816;
constexpr float EPS = 1e-6f;
constexpr int LDS_BYTES = 73728;
#ifndef XKS
#define XKS 1024
#endif
#ifndef RSOFF
#define RSOFF 0
#endif
#ifndef OUTMASK
#define OUTMASK 0xff
#endif
#ifndef STOPAT
#define STOPAT 0
#endif
#ifndef PHM
#define PHM 0xffff
#endif

constexpr size_t OFF_Y = 0;
constexpr size_t OFF_PAK = (size_t)NT * DM;
constexpr size_t OFF_PAV = OFF_PAK + 32768;
constexpr size_t OFF_PCK = OFF_PAV + 32768;
constexpr size_t OFF_PCV = OFF_PCK + 524288;
constexpr size_t OFF_PSSM = OFF_PCV + 524288;
constexpr size_t OFF_PCONV = OFF_PSSM + 131072;
constexpr size_t OFF_SAK = OFF_PCONV + 6144;
constexpr size_t OFF_SAV = OFF_SAK + 4194304;
constexpr size_t OFF_SCK = OFF_SAV + 4194304;
constexpr size_t OFF_SCV = OFF_SCK + 67108864;
constexpr size_t OFF_SSSM = OFF_SCV + 67108864;
constexpr size_t OFF_SCONV = OFF_SSSM + 16777216;

constexpr size_t al256(size_t x) { return (x + 255) & ~(size_t)255; }
constexpr size_t WS_WIN = 0;
constexpr size_t WS_WOUT = WS_WIN + al256((size_t)2 * NINP * 1024 * 2);
constexpr size_t WS_WGU = WS_WOUT + al256((size_t)2 * 1024 * 1024 * 2);
constexpr size_t WS_WDN = WS_WGU + al256((size_t)2 * 5632 * 1024 * 2);
constexpr size_t WS_AH = WS_WDN + al256((size_t)2 * 1024 * 2816 * 2);
constexpr size_t WS_AH1 = WS_AH + al256((size_t)NT * 1024 * 2);
constexpr size_t WS_HF = WS_AH1 + al256((size_t)NT * 1024 * 2);
constexpr size_t WS_H1 = WS_HF + al256((size_t)NT * 1024 * 4);
constexpr size_t WS_QKV = WS_H1 + al256((size_t)NT * 1024 * 4);
constexpr size_t WS_Z = WS_QKV + al256((size_t)NT * 1024 * 2);
constexpr size_t WS_XBC = WS_Z + al256((size_t)NT * 512 * 2);
constexpr size_t WS_DT = WS_XBC + al256((size_t)NT * 1024 * 2);
constexpr size_t WS_G = WS_DT + al256((size_t)NT * 8 * 4);
constexpr size_t WS_MIX = WS_G + al256((size_t)NT * DFF * 2);
constexpr size_t WS_CO = WS_MIX + al256((size_t)NT * 1024 * 2);
constexpr size_t WS_LSE = WS_CO + al256((size_t)3 * SEQ * 256 * 2);
constexpr size_t WS_CS = WS_LSE + al256((size_t)3 * SEQ * 4 * 4);
constexpr size_t WS_CD = WS_CS + al256((size_t)128 * 65536 * 4);
constexpr size_t WS_HIN = WS_CD + al256((size_t)128 * 8 * 4);
constexpr size_t WS_ROPE = WS_HIN + al256((size_t)128 * 65536 * 2);
constexpr size_t WS_BAR = WS_ROPE + al256((size_t)16388 * 16 * 4);
constexpr size_t WS_END = WS_BAR + 2048;

struct Params {
  const float* in[26];
  float* out;
  unsigned char* ws;
};
enum { I_XP = 0, I_XS, I_CAK, I_CAV, I_CCK, I_CCV, I_SSM, I_SCONV, I_NORM1, I_WIN, I_AQN, I_AKN, I_SINK, I_CQN, I_CKN,
       I_CONVW, I_CONVB, I_DTB, I_ALOG, I_DSKIP, I_SSMN, I_WOUT, I_NORM2, I_WGATE, I_WUP, I_WDOWN };

DEVI int opaque_tid() { int t = threadIdx.x; asm volatile("" : "+v"(t)); return t; }
DEVI u16 f2bf(float f) { unsigned u = __float_as_uint(f); u += 0x7fffu + ((u >> 16) & 1u); return (u16)(u >> 16); }
DEVI float bf2f(u16 h) { return __uint_as_float(((unsigned)h) << 16); }
DEVI unsigned pack2(float a, float b) { return (unsigned)f2bf(a) | ((unsigned)f2bf(b) << 16); }
DEVI float siluf(float x) { return x / (1.f + __expf(-x)); }
DEVI float softplusf(float x) { return x > 20.f ? x : log1pf(__expf(x)); }
DEVI float bflo(unsigned u) { return __uint_as_float(u << 16); }
DEVI float bfhi(unsigned u) { return __uint_as_float(u & 0xffff0000u); }
DEVI u32x4 gload16_async(const void* p) {
  u32x4 v;
  asm volatile("global_load_dwordx4 %0, %1, off" : "=v"(v) : "v"(p) : "memory");
  return v;
}
DEVI void gwait8(u32x4& a0, u32x4& a1, u32x4& a2, u32x4& a3, u32x4& b0, u32x4& b1, u32x4& b2, u32x4& b3) {
  asm volatile("s_waitcnt vmcnt(0)" : "+v"(a0), "+v"(a1), "+v"(a2), "+v"(a3), "+v"(b0), "+v"(b1), "+v"(b2), "+v"(b3) : : "memory");
}
DEVI float sumsq8(u32x4 v) {
  float s = 0.f, t;
  t = bflo(v.x); s += t * t; t = bfhi(v.x); s += t * t;
  t = bflo(v.y); s += t * t; t = bfhi(v.y); s += t * t;
  t = bflo(v.z); s += t * t; t = bfhi(v.z); s += t * t;
  t = bflo(v.w); s += t * t; t = bfhi(v.w); s += t * t;
  return s;
}
DEVI float wave_max(float v) {
#pragma unroll
  for (int o = 32; o >= 1; o >>= 1) v = fmaxf(v, __shfl_xor(v, o));
  return v;
}
DEVI float wave_sum(float v) {
#pragma unroll
  for (int o = 32; o >= 1; o >>= 1) v += __shfl_xor(v, o);
  return v;
}
DEVI f32x4 mfma16(bf16x8 a, bf16x8 b, f32x4 c) { return __builtin_amdgcn_mfma_f32_16x16x32_bf16(a, b, c, 0, 0, 0); }

enum { EPI_IN = 0, EPI_OUT = 1, EPI_GU = 2, EPI_DN = 3 };

DEVI uint2 pack4(float a, float b, float c, float d) { uint2 o; o.x = pack2(a, b); o.y = pack2(c, d); return o; }

template <int EPI>
DEVI void gemm_epilogue(const Params& P, int l, f32x4 (&acc)[4][4], float (&scv)[4], int row0, int col0, int wm, int wn, int fr, int fq) {
  unsigned char* ws = P.ws;
  if (EPI == EPI_IN) {
    const int cb = col0 + wn * 64;
    if (cb < 1024) {
      u16* QKV = (u16*)(ws + WS_QKV);
      const float* ROPE = (const float*)(ws + WS_ROPE);
      const int hh = cb >> 6;
      const bool isv = (hh == 6 || hh == 7 || hh == 14 || hh == 15);
      const float* gain = P.in[I_AQN];
      if (hh >= 4 && hh < 6) gain = P.in[I_AKN];
      else if (hh >= 8 && hh < 12) gain = P.in[I_CQN];
      else if (hh >= 12) gain = P.in[I_CKN];
      gain += l * 64;
      float gv[4][4];
#pragma unroll
      for (int ni = 0; ni < 4; ++ni)
#pragma unroll
        for (int r = 0; r < 4; ++r) gv[ni][r] = isv ? 1.f : gain[ni * 16 + fq * 4 + r];
      const int kind = (hh == 4 || hh == 5) ? 1 : (hh == 6 || hh == 7) ? 2 : (hh == 12 || hh == 13) ? 3 : (hh >= 14) ? 4 : 0;
      const int kvh = hh & 1;
#pragma unroll
      for (int mi = 0; mi < 4; ++mi) {
        const int row = row0 + wm * 64 + mi * 16 + fr;
        float v[4][4];
        float ss = 0.f;
#pragma unroll
        for (int ni = 0; ni < 4; ++ni)
#pragma unroll
          for (int r = 0; r < 4; ++r) { v[ni][r] = acc[mi][ni][r] * scv[mi]; ss += v[ni][r] * v[ni][r]; }
        if (!isv) {
          ss += __shfl_xor(ss, 16); ss += __shfl_xor(ss, 32);
          const float sc = rsqrtf(ss * (1.f / 64.f) + EPS);
#pragma unroll
          for (int ni = 0; ni < 4; ++ni)
#pragma unroll
            for (int r = 0; r < 4; ++r) v[ni][r] *= sc * gv[ni][r];
          const int pos = row < SEQ ? row : SEQ + ((row - SEQ) & 3);
#pragma unroll
          for (int r = 0; r < 4; ++r) {
            const float partner = __shfl_xor(v[0][r], 32);
            const int i = (fq & 1) * 4 + r;
            const float cs = ROPE[pos * 16 + i], sn = ROPE[pos * 16 + 8 + i];
            v[0][r] = (fq < 2) ? (v[0][r] * cs - partner * sn) : (v[0][r] * cs + partner * sn);
          }
        }
#pragma unroll
        for (int ni = 0; ni < 4; ++ni)
          *(uint2*)(QKV + (size_t)row * 1024 + cb + ni * 16 + fq * 4) = pack4(v[ni][0], v[ni][1], v[ni][2], v[ni][3]);
        if (kind) {
          size_t base = 0;
          bool ok = false;
          if (kind <= 2) {
            if (row >= SEQ) {
              const int sb = (row - SEQ) >> 2, t = (row - SEQ) & 3;
              base = (kind == 1 ? OFF_SAK : OFF_SAV) + ((((size_t)(l * 128 + sb) * 128 + 124 + t) * 2 + kvh) * 64);
              ok = true;
            } else if (row >= SEQ - 128) {
              base = (kind == 1 ? OFF_PAK : OFF_PAV) + (((size_t)(l * 128 + (row - (SEQ - 128))) * 2 + kvh) * 64);
              ok = true;
            }
          } else {
            if (row >= SEQ) {
              const int sb = (row - SEQ) >> 2, t = (row - SEQ) & 3;
              base = (kind == 3 ? OFF_SCK : OFF_SCV) + ((((size_t)(l * 128 + sb) * 2048 + 2044 + t) * 2 + kvh) * 64);
              ok = true;
            } else if (row >= SEQ - 2048) {
              base = (kind == 3 ? OFF_PCK : OFF_PCV) + (((size_t)(l * 2048 + (row - (SEQ - 2048))) * 2 + kvh) * 64);
              ok = true;
            }
          }
          if (ok) {
#pragma unroll
            for (int ni = 0; ni < 4; ++ni)
              *(float4*)(P.out + base + ni * 16 + fq * 4) = make_float4(v[ni][0], v[ni][1], v[ni][2], v[ni][3]);
          }
        }
      }
    } else if (cb < 1536) {
      u16* Z = (u16*)(ws + WS_Z);
#pragma unroll
      for (int mi = 0; mi < 4; ++mi) {
        const int row = row0 + wm * 64 + mi * 16 + fr;
        const float sc = scv[mi];
#pragma unroll
        for (int ni = 0; ni < 4; ++ni)
          *(uint2*)(Z + (size_t)row * 512 + (cb - 1024) + ni * 16 + fq * 4) =
              pack4(acc[mi][ni][0] * sc, acc[mi][ni][1] * sc, acc[mi][ni][2] * sc, acc[mi][ni][3] * sc);
      }
    } else if (cb < 2560) {
      u16* XBC = (u16*)(ws + WS_XBC);
#pragma unroll
      for (int mi = 0; mi < 4; ++mi) {
        const int row = row0 + wm * 64 + mi * 16 + fr;
        const float sc = scv[mi];
        size_t cbase = 0;
        bool ok = false;
        if (row >= SEQ) {
          const int sb = (row - SEQ) >> 2, t = (row - SEQ) & 3;
          if (t >= 1) { ok = true; cbase = OFF_SCONV + ((size_t)(l * 128 + sb) * 3 + (t - 1)) * 1024; }
        } else if (row >= SEQ - 3) {
          ok = true; cbase = OFF_PCONV + (size_t)(l * 3 + (row - (SEQ - 3))) * 1024;
        }
#pragma unroll
        for (int ni = 0; ni < 4; ++ni) {
          const int ch = (cb - 1536) + ni * 16 + fq * 4;
          const float x0 = acc[mi][ni][0] * sc, x1 = acc[mi][ni][1] * sc, x2 = acc[mi][ni][2] * sc, x3 = acc[mi][ni][3] * sc;
          *(uint2*)(XBC + (size_t)row * 1024 + ch) = pack4(x0, x1, x2, x3);
          if (ok) *(float4*)(P.out + cbase + ch) = make_float4(x0, x1, x2, x3);
        }
      }
    } else if (cb == 2560) {
      float* DT = (float*)(ws + WS_DT);
      if (fq < 2) {
#pragma unroll
        for (int mi = 0; mi < 4; ++mi) {
          const int row = row0 + wm * 64 + mi * 16 + fr;
          const float sc = scv[mi];
          *(float4*)(DT + (size_t)row * 8 + fq * 4) = make_float4(acc[mi][0][0] * sc, acc[mi][0][1] * sc, acc[mi][0][2] * sc, acc[mi][0][3] * sc);
        }
      }
    }
  } else if (EPI == EPI_OUT) {
    float* H1 = (float*)(ws + WS_H1);
    u16* AH1 = (u16*)(ws + WS_AH1);
    const float* HF = (const float*)(ws + WS_HF);
#pragma unroll
    for (int mi = 0; mi < 4; ++mi) {
      const int row = row0 + wm * 64 + mi * 16 + fr;
      const float* res = (l == 0) ? (row < SEQ ? P.in[I_XP] + (size_t)row * 1024 : P.in[I_XS] + (size_t)(row - SEQ) * 1024)
                                  : HF + (size_t)row * 1024;
#pragma unroll
      for (int ni = 0; ni < 4; ++ni) {
        const int col = col0 + wn * 64 + ni * 16 + fq * 4;
        const float4 rv = *(const float4*)(res + col);
        const float h0 = rv.x + acc[mi][ni][0], h1 = rv.y + acc[mi][ni][1], h2 = rv.z + acc[mi][ni][2], h3 = rv.w + acc[mi][ni][3];
        *(float4*)(H1 + (size_t)row * 1024 + col) = make_float4(h0, h1, h2, h3);
        *(uint2*)(AH1 + (size_t)row * 1024 + col) = pack4(h0, h1, h2, h3);
      }
    }
  } else if (EPI == EPI_GU) {
    u16* G = (u16*)(ws + WS_G);
#pragma unroll
    for (int mi = 0; mi < 4; ++mi) {
      const int row = row0 + wm * 64 + mi * 16 + fr;
      const float sc = scv[mi];
#pragma unroll
      for (int q = 0; q < 2; ++q) {
        const int j = ((col0 + wn * 64) >> 1) + q * 16 + fq * 4;
        float o[4];
#pragma unroll
        for (int r = 0; r < 4; ++r) o[r] = siluf(acc[mi][2 * q][r] * sc) * (acc[mi][2 * q + 1][r] * sc);
        *(uint2*)(G + (size_t)row * DFF + j) = pack4(o[0], o[1], o[2], o[3]);
      }
    }
  } else {
    const float* H1 = (const float*)(ws + WS_H1);
    float* HF = (float*)(ws + WS_HF);
    u16* AH = (u16*)(ws + WS_AH);
#pragma unroll
    for (int mi = 0; mi < 4; ++mi) {
      const int row = row0 + wm * 64 + mi * 16 + fr;
#pragma unroll
      for (int ni = 0; ni < 4; ++ni) {
        const int col = col0 + wn * 64 + ni * 16 + fq * 4;
        const float4 rv = *(const float4*)(H1 + (size_t)row * 1024 + col);
        const float h0 = rv.x + acc[mi][ni][0], h1 = rv.y + acc[mi][ni][1], h2 = rv.z + acc[mi][ni][2], h3 = rv.w + acc[mi][ni][3];
        if (l == 0) {
          *(float4*)(HF + (size_t)row * 1024 + col) = make_float4(h0, h1, h2, h3);
          *(uint2*)(AH + (size_t)row * 1024 + col) = pack4(h0, h1, h2, h3);
        } else {
          *(float4*)(P.out + OFF_Y + (size_t)row * 1024 + col) = make_float4(h0, h1, h2, h3);
        }
      }
    }
  }
}

template <int EPI>
DEVI void gemm_tile(const Params& P, int l, const u16* __restrict__ A, int lda, const u16* __restrict__ Bt, int ldb,
                          int K, int KS, int row0, int col0, unsigned char* smem) {
  const int tid = opaque_tid(), lane = tid & 63, w = tid >> 6, wm = w >> 1, wn = w & 1;
  const int fr = lane & 15, fq = lane >> 4;
  f32x4 acc[4][4];
#pragma unroll
  for (int mi = 0; mi < 4; ++mi)
#pragma unroll
    for (int ni = 0; ni < 4; ++ni) acc[mi][ni] = (f32x4){0.f, 0.f, 0.f, 0.f};
  const int lrow = tid >> 3, lch = tid & 7;
  const int gch = lch ^ (lrow & 7);
  const u16* Ag = A + (size_t)(row0 + lrow) * lda + gch * 8;
  const u16* Bg = Bt + (size_t)(col0 + lrow) * ldb + gch * 8;
  unsigned char* ldsT = smem + tid * 16;
  f32x4 gr0 = (f32x4){0.f, 0.f, 0.f, 0.f}, gr1 = gr0;
  float scv[4] = {1.f, 1.f, 1.f, 1.f};
  const int nk = K >> 6;
  const int ksS = (KS >> 6) - 1;
#pragma unroll
  for (int i = 0; i < 4; ++i) {
    __builtin_amdgcn_global_load_lds((const unsigned*)(Ag + (size_t)(32 * i) * lda), (unsigned*)(ldsT + i * 4096), 16, 0, 0);
    __builtin_amdgcn_global_load_lds((const unsigned*)(Bg + (size_t)(32 * i) * ldb), (unsigned*)(ldsT + 16384 + i * 4096), 16, 0, 0);
  }
  asm volatile("s_waitcnt vmcnt(0)" ::: "memory");
  __syncthreads();
#pragma unroll 2
  for (int ks = 0; ks < nk; ++ks) {
    const bool more = (ks + 1 < nk);
    if (more) {
      unsigned char* dst = ldsT + ((ks + 1) & 1) * 32768;
#pragma unroll
      for (int i = 0; i < 4; ++i) {
        __builtin_amdgcn_global_load_lds((const unsigned*)(Ag + (size_t)(32 * i) * lda + (ks + 1) * 64), (unsigned*)(dst + i * 4096), 16, 0, 0);
        __builtin_amdgcn_global_load_lds((const unsigned*)(Bg + (size_t)(32 * i) * ldb + (ks + 1) * 64), (unsigned*)(dst + 16384 + i * 4096), 16, 0, 0);
      }
    }
    const unsigned char* As = smem + (ks & 1) * 32768;
    const unsigned char* Bs = As + 16384;
#pragma unroll
    for (int kk = 0; kk < 2; ++kk) {
      bf16x8 af[4], bq[4];
#pragma unroll
      for (int mi = 0; mi < 4; ++mi) {
        const int row = wm * 64 + mi * 16 + fr;
        af[mi] = *(const bf16x8*)(As + row * 128 + (((kk * 4 + fq) ^ (row & 7)) << 4));
      }
#pragma unroll
      for (int ni = 0; ni < 4; ++ni) {
        const int row = wn * 64 + ni * 16 + fr;
        bq[ni] = *(const bf16x8*)(Bs + row * 128 + (((kk * 4 + fq) ^ (row & 7)) << 4));
      }
      if (ks <= ksS) {
        if (wn == 0) { gr0 = mfma16(af[0], af[0], gr0); gr1 = mfma16(af[1], af[1], gr1); }
        else { gr0 = mfma16(af[2], af[2], gr0); gr1 = mfma16(af[3], af[3], gr1); }
      }
      __builtin_amdgcn_s_setprio(1);
#pragma unroll
      for (int mi = 0; mi < 4; ++mi)
#pragma unroll
        for (int ni = 0; ni < 4; ++ni) acc[mi][ni] = mfma16(bq[ni], af[mi], acc[mi][ni]);
      __builtin_amdgcn_s_setprio(0);
    }
    float* rsL = (float*)(smem + ((ks + 1) & 1) * 32768);
    if (ks == ksS) {
      if ((fr >> 2) == fq) {
        const int r = fr & 3;
        const float d0 = r == 0 ? gr0[0] : r == 1 ? gr0[1] : r == 2 ? gr0[2] : gr0[3];
        const float d1 = r == 0 ? gr1[0] : r == 1 ? gr1[1] : r == 2 ? gr1[2] : gr1[3];
        rsL[wm * 64 + (wn * 2) * 16 + fr] = rsqrtf(d0 / (float)KS + EPS);
        rsL[wm * 64 + (wn * 2 + 1) * 16 + fr] = rsqrtf(d1 / (float)KS + EPS);
      }
    }
    asm volatile("s_waitcnt vmcnt(0)" ::: "memory");
    __syncthreads();
    if (ks == ksS) {
#pragma unroll
      for (int mi = 0; mi < 4; ++mi) scv[mi] = rsL[wm * 64 + mi * 16 + fr];
      __syncthreads();
    }
  }
  gemm_epilogue<EPI>(P, l, acc, scv, row0, col0, wm, wn, fr, fq);
}

DEVI void wconv_item(const Params& P, int mode, int l, int kt, int nt, unsigned char* smem) {
  float* tile = (float*)smem;
  const int tid = opaque_tid();
  const float* src; int ldsrc, Nsrc; u16* dst; int lddst;
  const float* gain = nullptr;
  unsigned char* ws = P.ws;
  if (mode == 0) { src = P.in[I_WIN] + (size_t)l * 1024 * NIN; ldsrc = NIN; Nsrc = NIN; dst = (u16*)(ws + WS_WIN) + (size_t)l * NINP * 1024; lddst = 1024; gain = P.in[I_NORM1] + l * 1024; }
  else if (mode == 1) { src = P.in[I_WOUT] + (size_t)l * 1024 * 1024; ldsrc = 1024; Nsrc = 1024; dst = (u16*)(ws + WS_WOUT) + (size_t)l * 1024 * 1024; lddst = 1024; }
  else if (mode == 2) { src = P.in[I_WGATE] + (size_t)l * 1024 * DFF; ldsrc = DFF; Nsrc = DFF; dst = (u16*)(ws + WS_WGU) + (size_t)l * 5632 * 1024; lddst = 1024; gain = P.in[I_NORM2] + l * 1024; }
  else if (mode == 3) { src = P.in[I_WUP] + (size_t)l * 1024 * DFF; ldsrc = DFF; Nsrc = DFF; dst = (u16*)(ws + WS_WGU) + (size_t)l * 5632 * 1024; lddst = 1024; gain = P.in[I_NORM2] + l * 1024; }
  else { src = P.in[I_WDOWN] + (size_t)l * DFF * 1024; ldsrc = 1024; Nsrc = 1024; dst = (u16*)(ws + WS_WDN) + (size_t)l * 1024 * DFF; lddst = DFF; }
  const int k0 = kt * 64, n0 = nt * 64;
  {
    const int j = tid & 63, ig = tid >> 6;
    const int n = n0 + j;
#pragma unroll
    for (int ii = 0; ii < 16; ++ii) {
      const int i = ig * 16 + ii, k = k0 + i;
      float v = 0.f;
      if (n < Nsrc) {
        v = src[(size_t)k * ldsrc + n];
        if (mode == 1) { if (k >= 256 && k < 768) v *= P.in[I_SSMN][l * 512 + (k - 256)]; }
        else if (gain) v *= gain[k];
      }
      tile[i * 65 + j] = v;
    }
  }
  __syncthreads();
  {
    const int i8 = tid & 7;
    int kd = k0 + i8 * 8;
    if (mode == 1) kd = (kd < 256) ? kd + 512 : (kd < 768 ? kd - 256 : kd);
#pragma unroll
    for (int jj = 0; jj < 2; ++jj) {
      const int j = (tid >> 3) + 32 * jj;
      const int n = n0 + j;
      int nd = n;
      if (mode == 2) nd = ((n >> 4) << 5) + (n & 15);
      else if (mode == 3) nd = ((n >> 4) << 5) + (n & 15) + 16;
      uint4 o;
      o.x = pack2(tile[(i8 * 8 + 0) * 65 + j], tile[(i8 * 8 + 1) * 65 + j]);
      o.y = pack2(tile[(i8 * 8 + 2) * 65 + j], tile[(i8 * 8 + 3) * 65 + j]);
      o.z = pack2(tile[(i8 * 8 + 4) * 65 + j], tile[(i8 * 8 + 5) * 65 + j]);
      o.w = pack2(tile[(i8 * 8 + 6) * 65 + j], tile[(i8 * 8 + 7) * 65 + j]);
      *(uint4*)(dst + (size_t)nd * lddst + kd) = o;
    }
  }
  __syncthreads();
}

DEVI void xconv_item(const Params& P, int item) {
  u16* AH = (u16*)(P.ws + WS_AH);
#pragma unroll
  for (int i = 0; i < 4; ++i) {
    const size_t e = ((size_t)item * 1024 + i * 256 + threadIdx.x) * 8;
    const float* src = (e < (size_t)SEQ * 1024) ? P.in[I_XP] + e : P.in[I_XS] + (e - (size_t)SEQ * 1024);
    const float4 a = *(const float4*)src, b = *(const float4*)(src + 4);
    uint4 o;
    o.x = pack2(a.x, a.y); o.y = pack2(a.z, a.w); o.z = pack2(b.x, b.y); o.w = pack2(b.z, b.w);
    *(uint4*)(AH + e) = o;
  }
}

DEVI void rope_item(const Params& P, int item) {
  const int e = item * 256 + threadIdx.x;
  if (e >= 16388 * 8) return;
  const int pos = e >> 3, i = e & 7;
  const double inv[8] = {1.0, 0.19392274474868576, 0.03760603093086393, 0.007292664737217109,
                         0.001414213562373095, 0.0002742481756762073, 5.318295896944988e-05, 1.031338537721246e-05};
  double invv = inv[0];
#pragma unroll
  for (int q = 1; q < 8; ++q) invv = (i == q) ? inv[q] : invv;
  const double ang = (double)pos * invv;
  const double n = rint(ang * 0.15915494309189535);
  double r = fma(-n, 6.283185307179586, ang);
  r = fma(-n, 2.4492935982947064e-16, r);
  const double r2 = r * r;
  double S = 1.0, C = 1.0;
#pragma unroll
  for (int k = 14; k >= 1; --k) {
    S = 1.0 - r2 * (1.0 / ((2.0 * k) * (2.0 * k + 1.0))) * S;
    C = 1.0 - r2 * (1.0 / ((2.0 * k - 1.0) * (2.0 * k))) * C;
  }
  float* ROPE = (float*)(P.ws + WS_ROPE);
  ROPE[pos * 16 + i] = (float)C;
  ROPE[pos * 16 + 8 + i] = (float)(r * S);
}

DEVI void attn_item(const Params& P, int l, int variant, int idx, unsigned char* smem) {
  const int tid = opaque_tid(), lane = tid & 63, w = tid >> 6, fr = lane & 15, fq = lane >> 4;
  const int h = idx & 3, qb = idx >> 2;
  const int dil = (variant <= 1) ? 1 : (variant == 2 ? 4 : 16);
  const int maxd = (variant == 0) ? 127 : 128;
  const int nbr = SEQ / dil / 64;
  const int res = qb / nbr, ib = qb % nbr;
  const int i0 = ib * 64;
  const int qofs = (variant == 0 ? 0 : 512) + h * 64;
  const int kofs = (variant == 0 ? 256 : 768) + (h >> 1) * 64;
  const int vofs = kofs + 128;
  const u16* QKV = (const u16*)(P.ws + WS_QKV);
  u16* Qs = (u16*)smem;
  u16* Ks = (u16*)(smem + 9216);
  u16* Vt = (u16*)(smem + 9216 + 27648);
  u16* Ps = Ks;
  {
    const int r = tid >> 2, c = (tid & 3) * 16;
    {
      const size_t pos = (size_t)res + (size_t)dil * (i0 + r);
      const uint4* g = (const uint4*)(QKV + pos * 1024 + qofs + c);
      const uint4 a = g[0], b = g[1];
      *(uint4*)(Qs + r * 72 + c) = a;
      *(uint4*)(Qs + r * 72 + c + 8) = b;
    }
#pragma unroll
    for (int pss = 0; pss < 3; ++pss) {
      const int kk = pss * 64 + r;
      const int ik = i0 - 128 + kk;
      uint4 a = make_uint4(0, 0, 0, 0), b = a, va = a, vb = a;
      if (ik >= 0) {
        const size_t pos = (size_t)res + (size_t)dil * ik;
        const uint4* g = (const uint4*)(QKV + pos * 1024 + kofs + c);
        a = g[0]; b = g[1];
        const uint4* gv = (const uint4*)(QKV + pos * 1024 + vofs + c);
        va = gv[0]; vb = gv[1];
      }
      *(uint4*)(Ks + kk * 72 + c) = a;
      *(uint4*)(Ks + kk * 72 + c + 8) = b;
      const unsigned vv[8] = {va.x, va.y, va.z, va.w, vb.x, vb.y, vb.z, vb.w};
#pragma unroll
      for (int e = 0; e < 8; ++e) {
        Vt[(c + 2 * e) * 200 + kk] = (u16)(vv[e] & 0xffffu);
        Vt[(c + 2 * e + 1) * 200 + kk] = (u16)(vv[e] >> 16);
      }
    }
  }
  __syncthreads();
  f32x4 s[12];
  {
    bf16x8 qa[2];
#pragma unroll
    for (int kk = 0; kk < 2; ++kk) qa[kk] = *(const bf16x8*)(Qs + (w * 16 + fr) * 72 + kk * 32 + fq * 8);
#pragma unroll
    for (int kb = 0; kb < 12; ++kb) {
      f32x4 a = (f32x4){0.f, 0.f, 0.f, 0.f};
#pragma unroll
      for (int kk = 0; kk < 2; ++kk) {
        const bf16x8 kf = *(const bf16x8*)(Ks + (kb * 16 + fr) * 72 + kk * 32 + fq * 8);
        a = mfma16(kf, qa[kk], a);
      }
      s[kb] = a;
    }
  }
  float sink = 0.f;
  if (variant == 0) sink = P.in[I_SINK][l * 4 + h];
  const int iq = i0 + w * 16 + fr;
  float mx = -INFINITY;
#pragma unroll
  for (int kb = 0; kb < 12; ++kb)
#pragma unroll
    for (int r = 0; r < 4; ++r) {
      const int ik = i0 - 128 + kb * 16 + fq * 4 + r;
      const int dist = iq - ik;
      const bool valid = (dist >= 0) && (dist <= maxd) && (ik >= 0);
      const float v = valid ? s[kb][r] * 0.125f : -INFINITY;
      s[kb][r] = v;
      mx = fmaxf(mx, v);
    }
  mx = fmaxf(mx, __shfl_xor(mx, 16)); mx = fmaxf(mx, __shfl_xor(mx, 32));
  if (variant == 0) mx = fmaxf(mx, sink);
  float den = 0.f;
#pragma unroll
  for (int kb = 0; kb < 12; ++kb)
#pragma unroll
    for (int r = 0; r < 4; ++r) {
      const float e = __expf(s[kb][r] - mx);
      s[kb][r] = e;
      den += e;
    }
  den += __shfl_xor(den, 16); den += __shfl_xor(den, 32);
  if (variant == 0) den += __expf(sink - mx);
  __syncthreads();
#pragma unroll
  for (int kb = 0; kb < 12; ++kb)
    *(uint2*)(Ps + (w * 16 + fr) * 200 + kb * 16 + fq * 4) = pack4(s[kb][0], s[kb][1], s[kb][2], s[kb][3]);
  __syncthreads();
  f32x4 o[4];
#pragma unroll
  for (int nb = 0; nb < 4; ++nb) o[nb] = (f32x4){0.f, 0.f, 0.f, 0.f};
#pragma unroll
  for (int ks = 0; ks < 6; ++ks) {
    const bf16x8 pa = *(const bf16x8*)(Ps + (w * 16 + fr) * 200 + ks * 32 + fq * 8);
#pragma unroll
    for (int nb = 0; nb < 4; ++nb) {
      const bf16x8 vf = *(const bf16x8*)(Vt + (nb * 16 + fr) * 200 + ks * 32 + fq * 8);
      o[nb] = mfma16(vf, pa, o[nb]);
    }
  }
  {
    const size_t pos = (size_t)res + (size_t)dil * iq;
    const float inv = 1.f / den;
    if (variant == 0) {
      u16* MIX = (u16*)(P.ws + WS_MIX);
#pragma unroll
      for (int nb = 0; nb < 4; ++nb)
        *(uint2*)(MIX + pos * 1024 + 512 + h * 64 + nb * 16 + fq * 4) = pack4(o[nb][0] * inv, o[nb][1] * inv, o[nb][2] * inv, o[nb][3] * inv);
    } else {
      u16* CO = (u16*)(P.ws + WS_CO) + (size_t)(variant - 1) * SEQ * 256;
#pragma unroll
      for (int nb = 0; nb < 4; ++nb)
        *(uint2*)(CO + pos * 256 + h * 64 + nb * 16 + fq * 4) = pack4(o[nb][0] * inv, o[nb][1] * inv, o[nb][2] * inv, o[nb][3] * inv);
      if (fq == 0) {
        float* LSE = (float*)(P.ws + WS_LSE) + (size_t)(variant - 1) * SEQ * 4;
        LSE[pos * 4 + h] = mx + __logf(den);
      }
    }
  }
  __syncthreads();
}

DEVI void cmerge_item(const Params& P, int item) {
  const int tid = opaque_tid();
  const int tok = item * 8 + (tid >> 5), ch = tid & 31;
  const int h = ch >> 3;
  const float* LSE = (const float*)(P.ws + WS_LSE);
  const u16* CO = (const u16*)(P.ws + WS_CO);
  const float l0 = LSE[(size_t)tok * 4 + h], l1 = LSE[(size_t)(SEQ + tok) * 4 + h], l2 = LSE[(size_t)(2 * SEQ + tok) * 4 + h];
  const float mx = fmaxf(l0, fmaxf(l1, l2));
  float w0 = __expf(l0 - mx), w1 = __expf(l1 - mx), w2 = __expf(l2 - mx);
  const float inv = 1.f / (w0 + w1 + w2);
  w0 *= inv; w1 *= inv; w2 *= inv;
  const uint4 a = *(const uint4*)(CO + (size_t)tok * 256 + ch * 8);
  const uint4 b = *(const uint4*)(CO + ((size_t)SEQ + tok) * 256 + ch * 8);
  const uint4 c = *(const uint4*)(CO + ((size_t)2 * SEQ + tok) * 256 + ch * 8);
  uint4 o;
  o.x = pack2(w0 * bflo(a.x) + w1 * bflo(b.x) + w2 * bflo(c.x), w0 * bfhi(a.x) + w1 * bfhi(b.x) + w2 * bfhi(c.x));
  o.y = pack2(w0 * bflo(a.y) + w1 * bflo(b.y) + w2 * bflo(c.y), w0 * bfhi(a.y) + w1 * bfhi(b.y) + w2 * bfhi(c.y));
  o.z = pack2(w0 * bflo(a.z) + w1 * bflo(b.z) + w2 * bflo(c.z), w0 * bfhi(a.z) + w1 * bfhi(b.z) + w2 * bfhi(c.z));
  o.w = pack2(w0 * bflo(a.w) + w1 * bflo(b.w) + w2 * bflo(c.w), w0 * bfhi(a.w) + w1 * bfhi(b.w) + w2 * bfhi(c.w));
  u16* MIX = (u16*)(P.ws + WS_MIX);
  *(uint4*)(MIX + (size_t)tok * 1024 + 768 + ch * 8) = o;
}

DEVI void sattn_item(const Params& P, int l, int isC, int item, unsigned char* smem) {
  const int tid = opaque_tid(), lane = tid & 63, t = tid >> 6;
  const int b = item >> 1, kvh = item & 1;
  float* qf = (float*)smem + t * 128;
  float* sb = (float*)smem + 512 + t * 784;
  const int row = SEQ + b * 4 + t;
  const u16* QKV = (const u16*)(P.ws + WS_QKV);
  const int nkeys = isC ? 387 : 128;
  const int buf = isC ? 2048 : 128;
  const float* cK = (isC ? P.in[I_CCK] : P.in[I_CAK]) + ((size_t)(l * 128 + b) * buf) * 128 + kvh * 64;
  const float* cV = (isC ? P.in[I_CCV] : P.in[I_CAV]) + ((size_t)(l * 128 + b) * buf) * 128 + kvh * 64;
  const float* nK = P.out + (isC ? OFF_SCK : OFF_SAK) + ((size_t)(l * 128 + b) * buf + (buf - 4)) * 128 + kvh * 64;
  const float* nV = P.out + (isC ? OFF_SCV : OFF_SAV) + ((size_t)(l * 128 + b) * buf + (buf - 4)) * 128 + kvh * 64;
#pragma unroll
  for (int hh = 0; hh < 2; ++hh)
    qf[hh * 64 + lane] = bf2f(QKV[(size_t)row * 1024 + (isC ? 512 : 0) + (kvh * 2 + hh) * 64 + lane]);
  __syncthreads();
  float m0 = -INFINITY, m1 = -INFINITY;
  for (int j = lane; j < nkeys; j += 64) {
    int idx;
    if (isC) { const int pi = j / 129, jj = j - pi * 129; const int d = (pi == 0) ? 1 : (pi == 1 ? 4 : 16); idx = 2048 + t - d * jj; }
    else idx = t + 1 + j;
    const float* kp = (idx < buf) ? cK + (size_t)idx * 128 : nK + (size_t)(idx - buf) * 128;
    float s0 = 0.f, s1 = 0.f;
#pragma unroll
    for (int c4 = 0; c4 < 16; ++c4) {
      const float4 kv = ((const float4*)kp)[c4];
      const float4 q0 = ((const float4*)qf)[c4], q1 = ((const float4*)(qf + 64))[c4];
      s0 += kv.x * q0.x + kv.y * q0.y + kv.z * q0.z + kv.w * q0.w;
      s1 += kv.x * q1.x + kv.y * q1.y + kv.z * q1.z + kv.w * q1.w;
    }
    s0 *= 0.125f; s1 *= 0.125f;
    sb[j] = s0; sb[392 + j] = s1;
    m0 = fmaxf(m0, s0); m1 = fmaxf(m1, s1);
  }
  m0 = wave_max(m0); m1 = wave_max(m1);
  float sk0 = 0.f, sk1 = 0.f;
  if (!isC) {
    sk0 = P.in[I_SINK][l * 4 + kvh * 2]; sk1 = P.in[I_SINK][l * 4 + kvh * 2 + 1];
    m0 = fmaxf(m0, sk0); m1 = fmaxf(m1, sk1);
  }
  float d0 = 0.f, d1 = 0.f;
  for (int j = lane; j < nkeys; j += 64) {
    const float e0 = __expf(sb[j] - m0), e1 = __expf(sb[392 + j] - m1);
    sb[j] = e0; sb[392 + j] = e1;
    d0 += e0; d1 += e1;
  }
  d0 = wave_sum(d0); d1 = wave_sum(d1);
  if (!isC) { d0 += __expf(sk0 - m0); d1 += __expf(sk1 - m1); }
  __syncthreads();
  const int g4 = lane >> 4, c4 = lane & 15;
  float a0[4] = {0.f, 0.f, 0.f, 0.f}, a1[4] = {0.f, 0.f, 0.f, 0.f};
  const int nsteps = (nkeys + 3) >> 2;
#pragma unroll 8
  for (int js = 0; js < nsteps; ++js) {
    const int jraw = js * 4 + g4;
    const int j = jraw < nkeys ? jraw : nkeys - 1;
    int idx;
    if (isC) { const int pi = j / 129, jj = j - pi * 129; const int d = (pi == 0) ? 1 : (pi == 1 ? 4 : 16); idx = 2048 + t - d * jj; }
    else idx = t + 1 + j;
    const float* vp = (idx < buf) ? cV + (size_t)idx * 128 : nV + (size_t)(idx - buf) * 128;
    const float4 v = ((const float4*)vp)[c4];
    const float p0 = jraw < nkeys ? sb[j] : 0.f, p1 = jraw < nkeys ? sb[392 + j] : 0.f;
    a0[0] += p0 * v.x; a0[1] += p0 * v.y; a0[2] += p0 * v.z; a0[3] += p0 * v.w;
    a1[0] += p1 * v.x; a1[1] += p1 * v.y; a1[2] += p1 * v.z; a1[3] += p1 * v.w;
  }
#pragma unroll
  for (int i = 0; i < 4; ++i) {
    a0[i] += __shfl_xor(a0[i], 16); a0[i] += __shfl_xor(a0[i], 32);
    a1[i] += __shfl_xor(a1[i], 16); a1[i] += __shfl_xor(a1[i], 32);
  }
  u16* MIX = (u16*)(P.ws + WS_MIX);
  const int mo = isC ? 768 : 512;
  if (g4 == 0) {
    const float i0 = 1.f / d0, i1 = 1.f / d1;
    uint2 w0, w1;
    w0.x = pack2(a0[0] * i0, a0[1] * i0); w0.y = pack2(a0[2] * i0, a0[3] * i0);
    w1.x = pack2(a1[0] * i1, a1[1] * i1); w1.y = pack2(a1[2] * i1, a1[3] * i1);
    *(uint2*)(MIX + (size_t)row * 1024 + mo + (kvh * 2) * 64 + c4 * 4) = w0;
    *(uint2*)(MIX + (size_t)row * 1024 + mo + (kvh * 2 + 1) * 64 + c4 * 4) = w1;
  }
  __syncthreads();
}

DEVI void smamba_item(const Params& P, int l, int item, unsigned char* smem) {
  const int tid = opaque_tid();
  const int b = item >> 3, h = item & 7, g = h >> 2;
  float* xa = (float*)smem;
  float* Ba = xa + 256;
  float* Ca = Ba + 512;
  const u16* XBC = (const u16*)(P.ws + WS_XBC);
  const float* DT = (const float*)(P.ws + WS_DT);
  const u16* Z = (const u16*)(P.ws + WS_Z);
  const int row0 = SEQ + b * 4;
  for (int ci = tid; ci < 320; ci += 256) {
    int ch; float* dst; int dl;
    if (ci < 64) { ch = h * 64 + ci; dst = xa + ci; dl = 64; }
    else if (ci < 192) { ch = 512 + g * 128 + (ci - 64); dst = Ba + (ci - 64); dl = 128; }
    else { ch = 768 + g * 128 + (ci - 192); dst = Ca + (ci - 192); dl = 128; }
    float sq[7];
#pragma unroll
    for (int j = 0; j < 3; ++j) sq[j] = P.in[I_SCONV][((size_t)(l * 128 + b) * 3 + j) * 1024 + ch];
#pragma unroll
    for (int j = 0; j < 4; ++j) sq[3 + j] = bf2f(XBC[(size_t)(row0 + j) * 1024 + ch]);
    const float w0 = P.in[I_CONVW][(l * 4 + 0) * 1024 + ch], w1 = P.in[I_CONVW][(l * 4 + 1) * 1024 + ch];
    const float w2 = P.in[I_CONVW][(l * 4 + 2) * 1024 + ch], w3 = P.in[I_CONVW][(l * 4 + 3) * 1024 + ch];
    const float bs = P.in[I_CONVB][l * 1024 + ch];
#pragma unroll
    for (int t = 0; t < 4; ++t) dst[t * dl] = siluf(bs + w0 * sq[t] + w1 * sq[t + 1] + w2 * sq[t + 2] + w3 * sq[t + 3]);
  }
  __syncthreads();
  const int p = tid >> 2, nq = tid & 3;
  float hs[32];
  const float* sp = P.in[I_SSM] + (((size_t)(l * 128 + b) * 8 + h) * 64 + p) * 128 + nq * 32;
#pragma unroll
  for (int i = 0; i < 8; ++i) {
    const float4 v = ((const float4*)sp)[i];
    hs[4 * i] = v.x; hs[4 * i + 1] = v.y; hs[4 * i + 2] = v.z; hs[4 * i + 3] = v.w;
  }
  const float dtb = P.in[I_DTB][l * 8 + h], aneg = -__expf(P.in[I_ALOG][l * 8 + h]), dsk = P.in[I_DSKIP][l * 8 + h];
  u16* MIX = (u16*)(P.ws + WS_MIX);
#pragma unroll
  for (int t = 0; t < 4; ++t) {
    const float dt = softplusf(DT[(size_t)(row0 + t) * 8 + h] + dtb);
    const float dA = __expf(aneg * dt);
    const float xv = xa[t * 64 + p];
    const float xdt = xv * dt;
    float yp = 0.f;
#pragma unroll
    for (int i = 0; i < 32; ++i) {
      hs[i] = hs[i] * dA + xdt * Ba[t * 128 + nq * 32 + i];
      yp += Ca[t * 128 + nq * 32 + i] * hs[i];
    }
    yp += __shfl_xor(yp, 1); yp += __shfl_xor(yp, 2);
    float y = yp + xv * dsk;
    y *= siluf(bf2f(Z[(size_t)(row0 + t) * 512 + h * 64 + p]));
    if (nq == 0) MIX[(size_t)(row0 + t) * 1024 + h * 64 + p] = f2bf(y);
  }
  float* op = P.out + OFF_SSSM + (((size_t)(l * 128 + b) * 8 + h) * 64 + p) * 128 + nq * 32;
#pragma unroll
  for (int i = 0; i < 8; ++i) ((float4*)op)[i] = make_float4(hs[4 * i], hs[4 * i + 1], hs[4 * i + 2], hs[4 * i + 3]);
  __syncthreads();
}

DEVI void ssd_dt_acum(const Params& P, int l, int c, int h, float* dtv, float* acum) {
  const int tid = opaque_tid(), lane = tid & 63;
  const float* DT = (const float*)(P.ws + WS_DT);
  const float aneg = -__expf(P.in[I_ALOG][l * 8 + h]);
  float a = 0.f;
  if (tid < 128) {
    const float dt = softplusf(DT[(size_t)(c * 128 + tid) * 8 + h] + P.in[I_DTB][l * 8 + h]);
    dtv[tid] = dt;
    a = aneg * dt;
  }
#pragma unroll
  for (int o = 1; o < 64; o <<= 1) {
    const float n = __shfl_up(a, o);
    if (lane >= o) a += n;
  }
  if (tid == 63) dtv[128] = a;
  __syncthreads();
  if (tid >= 64 && tid < 128) a += dtv[128];
  if (tid < 128) acum[tid] = a;
  __syncthreads();
}

template <class F>
DEVI void conv_rows(const Params& P, int l, int tok0, int n, int ch, F f) {
  const u16* XBC = (const u16*)(P.ws + WS_XBC);
  const float w0 = P.in[I_CONVW][(l * 4 + 0) * 1024 + ch], w1 = P.in[I_CONVW][(l * 4 + 1) * 1024 + ch];
  const float w2 = P.in[I_CONVW][(l * 4 + 2) * 1024 + ch], w3 = P.in[I_CONVW][(l * 4 + 3) * 1024 + ch];
  const float bs = P.in[I_CONVB][l * 1024 + ch];
  float x0 = (tok0 - 3 >= 0) ? bf2f(XBC[(size_t)(tok0 - 3) * 1024 + ch]) : 0.f;
  float x1 = (tok0 - 2 >= 0) ? bf2f(XBC[(size_t)(tok0 - 2) * 1024 + ch]) : 0.f;
  float x2 = (tok0 - 1 >= 0) ? bf2f(XBC[(size_t)(tok0 - 1) * 1024 + ch]) : 0.f;
  for (int b = 0; b < n; b += 32) {
    u16 raw[32];
#pragma unroll
    for (int t = 0; t < 32; ++t) raw[t] = XBC[(size_t)(tok0 + b + t) * 1024 + ch];
#pragma unroll
    for (int t = 0; t < 32; ++t) {
      const float x3 = bf2f(raw[t]);
      f(b + t, siluf(bs + w0 * x0 + w1 * x1 + w2 * x2 + w3 * x3));
      x0 = x1; x1 = x2; x2 = x3;
    }
  }
}

template <int N>
struct ConvBuf2 { unsigned raw[N + 3]; float wa[5], wb[5]; };
template <int N>
DEVI void conv2_load(const Params& P, int l, int tok0, int ch, ConvBuf2<N>& cb) {
  const u16* XBC = (const u16*)(P.ws + WS_XBC);
#pragma unroll
  for (int j = 0; j < 3; ++j) cb.raw[j] = (tok0 - 3 + j >= 0) ? *(const unsigned*)(XBC + (size_t)(tok0 - 3 + j) * 1024 + ch) : 0u;
#pragma unroll
  for (int t = 0; t < N; ++t) cb.raw[3 + t] = *(const unsigned*)(XBC + (size_t)(tok0 + t) * 1024 + ch);
#pragma unroll
  for (int j = 0; j < 4; ++j) {
    cb.wa[j] = P.in[I_CONVW][(l * 4 + j) * 1024 + ch];
    cb.wb[j] = P.in[I_CONVW][(l * 4 + j) * 1024 + ch + 1];
  }
  cb.wa[4] = P.in[I_CONVB][l * 1024 + ch];
  cb.wb[4] = P.in[I_CONVB][l * 1024 + ch + 1];
}
template <int N, class F>
DEVI void conv2_apply(const ConvBuf2<N>& cb, F f) {
#pragma unroll
  for (int t = 0; t < N; ++t) {
    const float va = siluf(cb.wa[4] + cb.wa[0] * bflo(cb.raw[t]) + cb.wa[1] * bflo(cb.raw[t + 1]) + cb.wa[2] * bflo(cb.raw[t + 2]) + cb.wa[3] * bflo(cb.raw[t + 3]));
    const float vb = siluf(cb.wb[4] + cb.wb[0] * bfhi(cb.raw[t]) + cb.wb[1] * bfhi(cb.raw[t + 1]) + cb.wb[2] * bfhi(cb.raw[t + 2]) + cb.wb[3] * bfhi(cb.raw[t + 3]));
    f(t, va, vb);
  }
}

DEVI void ssd_cs_item(const Params& P, int l, int item, unsigned char* smem) {
  const int tid = opaque_tid(), lane = tid & 63, w = tid >> 6, fr = lane & 15, fq = lane >> 4;
  const int c = item >> 3, h = item & 7, g = h >> 2;
  u16* xT = (u16*)smem;
  u16* BT = (u16*)(smem + 17408);
  float* acum = (float*)(smem + 17408 + 34816);
  float* dtv = acum + 128;
  ConvBuf2<16> cX;
  ConvBuf2<32> cB;
  conv2_load<16>(P, l, c * 128 + (tid >> 5) * 16, h * 64 + 2 * (tid & 31), cX);
  conv2_load<32>(P, l, c * 128 + (tid >> 6) * 32, 512 + g * 128 + 2 * (tid & 63), cB);
  ssd_dt_acum(P, l, c, h, dtv, acum);
  const float aend = acum[127];
  {
    const int cp = tid & 31, rg = tid >> 5;
    conv2_apply<16>(cX, [&](int t, float va, float vb) {
      const int s = rg * 16 + t;
      const float e = dtv[s] * __expf(aend - acum[s]);
      xT[(2 * cp) * 136 + s] = f2bf(va * e);
      xT[(2 * cp + 1) * 136 + s] = f2bf(vb * e);
    });
  }
  {
    const int cp = tid & 63, rg = tid >> 6;
    conv2_apply<32>(cB, [&](int t, float va, float vb) {
      BT[(2 * cp) * 136 + rg * 32 + t] = f2bf(va);
      BT[(2 * cp + 1) * 136 + rg * 32 + t] = f2bf(vb);
    });
  }
  __syncthreads();
  float* CS = (float*)(P.ws + WS_CS) + (size_t)(c * 8 + h) * 8192;
  bf16x8 xa[4];
#pragma unroll
  for (int ks = 0; ks < 4; ++ks) xa[ks] = *(const bf16x8*)(xT + (w * 16 + fr) * 136 + ks * 32 + fq * 8);
#pragma unroll
  for (int nb = 0; nb < 8; ++nb) {
    f32x4 a = (f32x4){0.f, 0.f, 0.f, 0.f};
#pragma unroll
    for (int ks = 0; ks < 4; ++ks) {
      const bf16x8 bfg = *(const bf16x8*)(BT + (nb * 16 + fr) * 136 + ks * 32 + fq * 8);
      a = mfma16(xa[ks], bfg, a);
    }
#pragma unroll
    for (int r = 0; r < 4; ++r) CS[(w * 16 + fq * 4 + r) * 128 + nb * 16 + fr] = a[r];
  }
  if (tid == 0) ((float*)(P.ws + WS_CD))[c * 8 + h] = __expf(aend);
  __syncthreads();
}

DEVI void ssd_scan_item(const Params& P, int l, int item) {
  const int e = item * 256 + threadIdx.x;
  const int h = e >> 13;
  const float* CS = (const float*)(P.ws + WS_CS);
  const float* CD = (const float*)(P.ws + WS_CD);
  u16* HIN = (u16*)(P.ws + WS_HIN);
  float hc = 0.f;
#pragma unroll 32
  for (int c = 0; c < 128; ++c) {
    HIN[(size_t)c * 65536 + e] = f2bf(hc);
    hc = hc * CD[c * 8 + h] + CS[(size_t)c * 65536 + e];
  }
  P.out[OFF_PSSM + (size_t)l * 65536 + e] = hc;
}

DEVI void ssd_y_item(const Params& P, int l, int item, unsigned char* smem) {
  const int tid = opaque_tid(), lane = tid & 63, w = tid >> 6, fr = lane & 15, fq = lane >> 4;
  const int half = item & 1, h = (item >> 1) & 7, c = item >> 4, g = h >> 2;
  const int l0 = half * 64;
  u16* Cs = (u16*)smem;
  u16* Hs = (u16*)(smem + 17408);
  u16* Bs = (u16*)(smem + 34816);
  float* acum = (float*)(smem + 69632);
  float* dtv = acum + 128;
  u16* Gs = Hs;
  u16* xT = Bs;
  ConvBuf2<16> cC, cX;
  ConvBuf2<32> cB;
  u32x4 hin[4];
  conv2_load<16>(P, l, c * 128 + l0 + (tid >> 6) * 16, 768 + g * 128 + 2 * (tid & 63), cC);
  conv2_load<32>(P, l, c * 128 + (tid >> 6) * 32, 512 + g * 128 + 2 * (tid & 63), cB);
  conv2_load<16>(P, l, c * 128 + (tid >> 5) * 16, h * 64 + 2 * (tid & 31), cX);
  {
    const u16* HIN = (const u16*)(P.ws + WS_HIN) + (size_t)(c * 8 + h) * 8192;
    const int r = tid >> 2, cq = (tid & 3) * 32;
#pragma unroll
    for (int i = 0; i < 4; ++i) hin[i] = *(const u32x4*)(HIN + r * 128 + cq + i * 8);
  }
  ssd_dt_acum(P, l, c, h, dtv, acum);
  {
    const int cp = tid & 63, rg = tid >> 6;
    conv2_apply<16>(cC, [&](int t, float va, float vb) {
      *(unsigned*)(Cs + (rg * 16 + t) * 136 + 2 * cp) = pack2(va, vb);
    });
    conv2_apply<32>(cB, [&](int t, float va, float vb) {
      *(unsigned*)(Bs + (rg * 32 + t) * 136 + 2 * cp) = pack2(va, vb);
    });
    const int r = tid >> 2, cq = (tid & 3) * 32;
#pragma unroll
    for (int i = 0; i < 4; ++i) *(u32x4*)(Hs + r * 136 + cq + i * 8) = hin[i];
  }
  __syncthreads();
  f32x4 y[4];
  f32x4 cb[8];
  {
    bf16x8 ca[4];
#pragma unroll
    for (int ks = 0; ks < 4; ++ks) ca[ks] = *(const bf16x8*)(Cs + (w * 16 + fr) * 136 + ks * 32 + fq * 8);
#pragma unroll
    for (int nb = 0; nb < 4; ++nb) {
      f32x4 a = (f32x4){0.f, 0.f, 0.f, 0.f};
#pragma unroll
      for (int ks = 0; ks < 4; ++ks) a = mfma16(ca[ks], *(const bf16x8*)(Hs + (nb * 16 + fr) * 136 + ks * 32 + fq * 8), a);
      y[nb] = a;
    }
#pragma unroll
    for (int sbk = 0; sbk < 8; ++sbk) {
      f32x4 a = (f32x4){0.f, 0.f, 0.f, 0.f};
#pragma unroll
      for (int ks = 0; ks < 4; ++ks) a = mfma16(ca[ks], *(const bf16x8*)(Bs + (sbk * 16 + fr) * 136 + ks * 32 + fq * 8), a);
      cb[sbk] = a;
    }
  }
  float al[4];
#pragma unroll
  for (int r = 0; r < 4; ++r) al[r] = acum[l0 + w * 16 + fq * 4 + r];
  __syncthreads();
#pragma unroll
  for (int sbk = 0; sbk < 8; ++sbk) {
    const int s = sbk * 16 + fr;
    const float as = acum[s];
#pragma unroll
    for (int r = 0; r < 4; ++r) {
      const int ll = l0 + w * 16 + fq * 4 + r;
      const float gval = (s <= ll) ? cb[sbk][r] * __expf(al[r] - as) : 0.f;
      Gs[(w * 16 + fq * 4 + r) * 136 + s] = f2bf(gval);
    }
  }
  {
    const int cp = tid & 31, rg = tid >> 5;
    conv2_apply<16>(cX, [&](int t, float va, float vb) {
      const int s = rg * 16 + t;
      xT[(2 * cp) * 136 + s] = f2bf(va * dtv[s]);
      xT[(2 * cp + 1) * 136 + s] = f2bf(vb * dtv[s]);
    });
  }
  __syncthreads();
  f32x4 yd[4];
#pragma unroll
  for (int nb = 0; nb < 4; ++nb) yd[nb] = (f32x4){0.f, 0.f, 0.f, 0.f};
#pragma unroll
  for (int ks = 0; ks < 4; ++ks) {
    const bf16x8 ga = *(const bf16x8*)(Gs + (w * 16 + fr) * 136 + ks * 32 + fq * 8);
#pragma unroll
    for (int nb = 0; nb < 4; ++nb) yd[nb] = mfma16(ga, *(const bf16x8*)(xT + (nb * 16 + fr) * 136 + ks * 32 + fq * 8), yd[nb]);
  }
  const float dsk = P.in[I_DSKIP][l * 8 + h];
  const u16* Z = (const u16*)(P.ws + WS_Z);
  u16* MIX = (u16*)(P.ws + WS_MIX);
#pragma unroll
  for (int r = 0; r < 4; ++r) {
    const int ll = l0 + w * 16 + fq * 4 + r;
    const size_t tok = (size_t)c * 128 + ll;
    const float idt = 1.f / dtv[ll];
    const float eal = __expf(al[r]);
#pragma unroll
    for (int nb = 0; nb < 4; ++nb) {
      const int p = nb * 16 + fr;
      float yv = yd[nb][r] + y[nb][r] * eal + bf2f(xT[p * 136 + ll]) * idt * dsk;
      yv *= siluf(bf2f(Z[tok * 512 + h * 64 + p]));
      MIX[tok * 1024 + h * 64 + p] = f2bf(yv);
    }
  }
  __syncthreads();
}

DEVI void mixnorm_item(const Params& P, int item) {
  const int tid = opaque_tid(), lane = tid & 63, w = tid >> 6;
  const int row = item * 4 + w;
  u16* MIX = (u16*)(P.ws + WS_MIX) + (size_t)row * 1024 + lane * 8;
  const uint4 v = *(const uint4*)MIX;
  float f[8] = {bflo(v.x), bfhi(v.x), bflo(v.y), bfhi(v.y), bflo(v.z), bfhi(v.z), bflo(v.w), bfhi(v.w)};
  float s = 0.f;
#pragma unroll
  for (int i = 0; i < 8; ++i) s += f[i] * f[i];
  s = wave_sum(s);
  const float sc = rsqrtf(s * (1.f / 512.f) + EPS);
  uint4 o;
  o.x = pack2(f[0] * sc, f[1] * sc); o.y = pack2(f[2] * sc, f[3] * sc);
  o.z = pack2(f[4] * sc, f[5] * sc); o.w = pack2(f[6] * sc, f[7] * sc);
  *(uint4*)MIX = o;
}

DEVI void copy_item(const Params& P, int l, int item) {
  const float* src; float* dst; int n4;
  int s4;
  if (item < 4096) {
    const int part = item & 15, kv = (item >> 4) & 1, b = item >> 5;
    const size_t base = (size_t)(l * 128 + b) * 262144;
    src = (kv ? P.in[I_CCV] : P.in[I_CCK]) + base + 512;
    dst = P.out + (kv ? OFF_SCV : OFF_SCK) + base;
    s4 = part * 4096;
    n4 = min(4096, 65408 - s4);
  } else {
    const int it = item - 4096;
    const int kv = it & 1, b = it >> 1;
    const size_t base = (size_t)(l * 128 + b) * 16384;
    src = (kv ? P.in[I_CAV] : P.in[I_CAK]) + base + 512;
    dst = P.out + (kv ? OFF_SAV : OFF_SAK) + base;
    s4 = 0; n4 = 3968;
  }
  const f32x4* s = (const f32x4*)src + s4;
  f32x4* d = (f32x4*)dst + s4;
  const int t = threadIdx.x;
  f32x4 v[16];
#pragma unroll
  for (int i = 0; i < 16; ++i)
    if (i * 256 + t < n4) v[i] = __builtin_nontemporal_load(s + i * 256 + t);
#pragma unroll
  for (int i = 0; i < 16; ++i)
    if (i * 256 + t < n4) __builtin_nontemporal_store(v[i], d + i * 256 + t);
}

DEVI void copy_ptrs(const Params& P, int l, int item, const f32x4*& s, f32x4*& d, int& n4) {
  if (item < 4096) {
    const int part = item & 15, kv = (item >> 4) & 1, b = item >> 5;
    const size_t base = (size_t)(l * 128 + b) * 262144;
    s = (const f32x4*)((kv ? P.in[I_CCV] : P.in[I_CCK]) + base + 512) + part * 4096;
    d = (f32x4*)(P.out + (kv ? OFF_SCV : OFF_SCK) + base) + part * 4096;
    n4 = min(4096, 65408 - part * 4096);
  } else {
    const int it = item - 4096;
    const int kv = it & 1, b = it >> 1;
    const size_t base = (size_t)(l * 128 + b) * 16384;
    s = (const f32x4*)((kv ? P.in[I_CAV] : P.in[I_CAK]) + base + 512);
    d = (f32x4*)(P.out + (kv ? OFF_SAV : OFF_SAK) + base);
    n4 = 3968;
  }
}

struct GBar { unsigned* bar; unsigned epoch; unsigned x; unsigned nloc; unsigned nx; };
DEVI unsigned bar_ld(unsigned* p) { return __hip_atomic_load(p, __ATOMIC_RELAXED, __HIP_MEMORY_SCOPE_AGENT); }
DEVI unsigned bar_add(unsigned* p, unsigned v) { return __hip_atomic_fetch_add(p, v, __ATOMIC_RELAXED, __HIP_MEMORY_SCOPE_AGENT); }
DEVI void gsync_flat(GBar& g) {
  asm volatile("s_waitcnt vmcnt(0) lgkmcnt(0)" ::: "memory");
  __syncthreads();
  if (threadIdx.x == 0) {
    __builtin_amdgcn_fence(__ATOMIC_RELEASE, "agent");
    asm volatile("s_waitcnt vmcnt(0)" ::: "memory");
    bar_add(g.bar, 1u);
    while (bar_ld(g.bar) < gridDim.x) __builtin_amdgcn_s_sleep(2);
    __builtin_amdgcn_fence(__ATOMIC_ACQUIRE, "agent");
    asm volatile("s_waitcnt vmcnt(0)" ::: "memory");
  }
  __syncthreads();
}
DEVI void gsync(GBar& g) {
  asm volatile("s_waitcnt vmcnt(0) lgkmcnt(0)" ::: "memory");
  __syncthreads();
  g.epoch++;
  if (threadIdx.x == 0) {
    const unsigned old = bar_add(g.bar + 32 * (1 + g.x), 1u);
    if (old == g.epoch * g.nloc - 1u) {
      __builtin_amdgcn_fence(__ATOMIC_RELEASE, "agent");
      asm volatile("s_waitcnt vmcnt(0)" ::: "memory");
      bar_add(g.bar + 32 * 9, 1u);
    }
    const unsigned target = g.epoch * g.nx;
    while (bar_ld(g.bar + 32 * 9) < target) __builtin_amdgcn_s_sleep(1);
    __builtin_amdgcn_fence(__ATOMIC_ACQUIRE, "agent");
    asm volatile("s_waitcnt vmcnt(0)" ::: "memory");
  }
  __syncthreads();
}

__global__ void __launch_bounds__(256, 2) hymba_megakernel(Params P) {
  extern __shared__ __attribute__((aligned(16))) unsigned char smem[];
  cg::grid_group cgrid = cg::this_grid();
  GBar grid; grid.bar = (unsigned*)(P.ws + WS_BAR); grid.epoch = 0;
  grid.x = (unsigned)__builtin_amdgcn_s_getreg((3 << 11) | 20) & 7u;
  if (threadIdx.x == 0) bar_add(grid.bar + 32 * 10 + grid.x, 1u);
  const int nb = gridDim.x, bid = blockIdx.x;
  const int vbid = ((nb & 7) == 0) ? (bid & 7) * (nb >> 3) + (bid >> 3) : bid;
  unsigned char* ws = P.ws;

#ifdef NANFILL
  {
    uint4* w4 = (uint4*)ws;
    const size_t n4 = WS_END / 16;
    const uint4 pat = make_uint4(0xffffffffu, 0xffffffffu, 0xffffffffu, 0xffffffffu);
    for (size_t i = (size_t)bid * 256 + threadIdx.x; i < n4; i += (size_t)nb * 256) w4[i] = pat;
    for (int i = threadIdx.x; i < LDS_BYTES / 16; i += 256) ((uint4*)smem)[i] = pat;
  }
  gsync(grid);
#endif
  {
    const int NW = 2 * 3040, NX = 2112, NR = 513;
    for (int it = bid; it < NW + NX + NR; it += nb) {
      if ((PHM & 1) && it < NW) {
        const int l = it / 3040;
        int r = it % 3040;
        if (r < 672) wconv_item(P, 0, l, r / 42, r % 42, smem);
        else if ((r -= 672) < 256) wconv_item(P, 1, l, r / 16, r % 16, smem);
        else if ((r -= 256) < 704) wconv_item(P, 2, l, r / 44, r % 44, smem);
        else if ((r -= 704) < 704) wconv_item(P, 3, l, r / 44, r % 44, smem);
        else { r -= 704; wconv_item(P, 4, l, r / 16, r % 16, smem); }
      } else if (it < NW + NX) { if (PHM & 2) xconv_item(P, it - NW); }
      else if (PHM & 2) rope_item(P, it - NW - NX);
    }
  }
  asm volatile("s_waitcnt vmcnt(0) lgkmcnt(0)" ::: "memory");
  __syncthreads();
  cgrid.sync();
  if (threadIdx.x == 0) __builtin_amdgcn_fence(__ATOMIC_ACQUIRE, "agent");
  asm volatile("s_waitcnt vmcnt(0)" ::: "memory");
  __syncthreads();
  {
    unsigned nx = 0;
#pragma unroll
    for (int i = 0; i < 8; ++i) nx += (bar_ld(grid.bar + 32 * 10 + i) != 0u) ? 1u : 0u;
    grid.nx = nx;
    grid.nloc = bar_ld(grid.bar + 32 * 10 + grid.x);
  }

#ifdef DELAYTEST
  {
    const unsigned long long t0 = wall_clock64();
    while (wall_clock64() - t0 < 200000ull) __builtin_amdgcn_s_sleep(8);
    __syncthreads();
    if (threadIdx.x == 0) __builtin_amdgcn_fence(__ATOMIC_ACQUIRE, "agent");
    asm volatile("s_waitcnt vmcnt(0)" ::: "memory");
    __syncthreads();
  }
#endif
#ifdef E2TEST
  {
    const u16* AHp = (const u16*)(ws + WS_AH);
    const u16* WTp = (const u16*)(ws + WS_WIN);
    for (size_t i = (size_t)bid * 256 + threadIdx.x; i < (size_t)NT * 1024; i += (size_t)nb * 256) P.out[OFF_Y + i] = bf2f(AHp[i]) * 1.2345678f + 0.1f;
    for (size_t i = (size_t)bid * 256 + threadIdx.x; i < (size_t)2 * NINP * 1024; i += (size_t)nb * 256) P.out[OFF_SCK + i] = bf2f(WTp[i]) * 1.2345678f + 0.001f;
    return;
  }
#endif
#pragma unroll 1
  for (int l = 0; l < 2; ++l) {
    {
      const u16* A = (const u16*)(ws + WS_AH);
      const u16* Bt = (const u16*)(ws + WS_WIN) + (size_t)l * NINP * 1024;
      for (int t = vbid; t < 132 * 21; t += nb) {
        const int rt = t / 21, ct = t % 21;
        if (PHM & 4) gemm_tile<EPI_IN>(P, l, A, 1024, Bt, 1024, 1024, XKS, rt * 128, ct * 128, smem);
      }
    }
    gsync(grid);
    if (STOPAT == 1) return;
    {
      const int N_SC = 256, N_SA = 256, N_AT = 4096, N_CS = 1024, N_SM = 1024, N_CP = 1952;
      const int tot = N_SC + N_SA + N_AT + N_CS + N_SM + N_CP;
      for (int it = bid; it < tot; it += nb) {
        int r = it;
        int lq = l;
        asm volatile("" : "+s"(lq));
        if (r < N_SC) { if (PHM & 8) sattn_item(P, lq, 1, r, smem); }
        else if ((r -= N_SC) < N_SA) { if (PHM & 8) sattn_item(P, lq, 0, r, smem); }
        else if ((r -= N_SA) < N_AT) { if (PHM & 16) attn_item(P, lq, r >> 10, r & 1023, smem); }
        else if ((r -= N_AT) < N_CS) { if (PHM & 32) ssd_cs_item(P, lq, r, smem); }
        else if ((r -= N_CS) < N_SM) { if (PHM & 64) smamba_item(P, lq, r, smem); }
        else { r -= N_SM; if (PHM & 128) copy_item(P, lq, r); }
      }
    }
    gsync(grid);
    if (STOPAT == 2) return;
    {
      for (int it = bid; it < 256 + 2048 + 800; it += nb) {
        if (it < 256) { if (PHM & 256) ssd_scan_item(P, l, it); }
        else if (it < 2304) { if (PHM & 256) cmerge_item(P, it - 256); }
        else copy_item(P, l, 1952 + (it - 2304));
      }
    }
    gsync(grid);
    if (STOPAT == 3) return;
    for (int k = 0;; ++k) {
      const int yi = bid + k * nb, ci = 2752 + bid + k * nb;
      if (yi >= 2048 && ci >= 4352) break;
      if (yi < 2048) ssd_y_item(P, l, yi, smem);
      if (ci < 4352) copy_item(P, l, ci);
    }
    gsync(grid);
    for (int it = bid; it < NT / 4; it += nb) mixnorm_item(P, it);
    gsync(grid);
    if (STOPAT == 4) return;
    {
      const u16* A = (const u16*)(ws + WS_MIX);
      const u16* Bt = (const u16*)(ws + WS_WOUT) + (size_t)l * 1024 * 1024;
      for (int t = vbid; t < 132 * 8; t += nb) {
        const int rt = t / 8, ct = t % 8;
        if (PHM & 1024) gemm_tile<EPI_OUT>(P, l, A, 1024, Bt, 1024, 1024, 0, rt * 128, ct * 128, smem);
      }
    }
    gsync(grid);
    if (STOPAT == 5) return;
    {
      const u16* A = (const u16*)(ws + WS_AH1);
      const u16* Bt = (const u16*)(ws + WS_WGU) + (size_t)l * 5632 * 1024;
      const int NCP = 0, NTL = 132 * 44;
      for (int it = vbid; it < NTL + NCP; it += nb) {
        int t;
        if (it < 2 * NCP) {
          if (!(it & 1)) { copy_item(P, l, it >> 1); continue; }
          t = it >> 1;
        } else t = it - NCP;
        const int rt = t / 44, ct = t % 44;
        if (PHM & 2048) gemm_tile<EPI_GU>(P, l, A, 1024, Bt, 1024, 1024, 1024, rt * 128, ct * 128, smem);
      }
    }
    gsync(grid);
    if (STOPAT == 6) return;
    {
      const u16* A = (const u16*)(ws + WS_G);
      const u16* Bt = (const u16*)(ws + WS_WDN) + (size_t)l * 1024 * DFF;
      for (int t = vbid; t < 132 * 8; t += nb) {
        const int rt = t / 8, ct = t % 8;
        if (PHM & 4096) gemm_tile<EPI_DN>(P, l, A, DFF, Bt, DFF, DFF, 0, rt * 128, ct * 128, smem);
      }
    }
    if (l == 0) gsync(grid);
  }
}

extern "C" void kernel_launch(void* const* d_in, const int* in_sizes, int n_in, void* d_out, int out_size, void* d_ws,
                              size_t ws_size, hipStream_t stream) {
  static int grid_blocks = 0;
  if (!grid_blocks) {
    int dev = 0, cus = 0, per_cu = 0;
    (void)hipGetDevice(&dev);
    (void)hipDeviceGetAttribute(&cus, hipDeviceAttributeMultiprocessorCount, dev);
    (void)hipFuncSetAttribute((const void*)hymba_megakernel, hipFuncAttributeMaxDynamicSharedMemorySize, LDS_BYTES);
    (void)hipOccupancyMaxActiveBlocksPerMultiprocessor(&per_cu, hymba_megakernel, 256, LDS_BYTES);
    if (per_cu < 1) per_cu = 1;
    if (per_cu > 2) per_cu = 2;
    grid_blocks = cus * per_cu;
  }
  Params p{};
  for (int i = 0; i < 26; ++i) p.in[i] = (const float*)d_in[i];
  p.out = (float*)d_out;
  p.ws = (unsigned char*)d_ws;
  (void)hipMemsetAsync((unsigned char*)d_ws + WS_BAR, 0, 2048, stream);
  void* args[] = {&p};
  hipError_t e = hipLaunchCooperativeKernel((void*)hymba_megakernel, dim3(grid_blocks), dim3(256), args, LDS_BYTES, stream);
  if (e != hipSuccess) fprintf(stderr, "cooperative launch failed: %s (grid %d)\n", hipGetErrorString(e), grid_blocks);
}
```

```cpp
#include <hip/hip_runtime.h>
#include <hip/hip_bf16.h>
#include <hip/hip_cooperative_groups.h>
#include <cstdio>
namespace cg = cooperative_groups;

typedef unsigned short u16;
using bf16x8 = __attribute__((ext_vector_type(8))) short;
using f32x4 = __attribute__((ext_vector_type(4))) float;
using u32x4 = __attribute__((ext_vector_type(4))) unsigned int;
#define DEVI __device__ __forceinline__

constexpr int DM = 1024, SEQ = 16384, NSAMP = 512, NT = SEQ + NSAMP, NB = 128;
constexpr int NINP = 2688, NIN = 2568, DFF = 2816;
constexpr float EPS = 1e-6f;
constexpr int LDS_BYTES = 73728;
#ifndef XKS
#define XKS 1024
#endif
#ifndef RSOFF
#define RSOFF 0
#endif
#ifndef OUTMASK
#define OUTMASK 0xff
#endif
#ifndef STOPAT
#define STOPAT 0
#endif
#ifndef PHM
#define PHM 0xffff
#endif

constexpr size_t OFF_Y = 0;
constexpr size_t OFF_PAK = (size_t)NT * DM;
constexpr size_t OFF_PAV = OFF_PAK + 32768;
constexpr size_t OFF_PCK = OFF_PAV + 32768;
constexpr size_t OFF_PCV = OFF_PCK + 524288;
constexpr size_t OFF_PSSM = OFF_PCV + 524288;
constexpr size_t OFF_PCONV = OFF_PSSM + 131072;
constexpr size_t OFF_SAK = OFF_PCONV + 6144;
constexpr size_t OFF_SAV = OFF_SAK + 4194304;
constexpr size_t OFF_SCK = OFF_SAV + 4194304;
constexpr size_t OFF_SCV = OFF_SCK + 67108864;
constexpr size_t OFF_SSSM = OFF_SCV + 67108864;
constexpr size_t OFF_SCONV = OFF_SSSM + 16777216;

constexpr size_t al256(size_t x) { return (x + 255) & ~(size_t)255; }
constexpr size_t WS_WIN = 0;
constexpr size_t WS_WOUT = WS_WIN + al256((size_t)2 * NINP * 1024 * 2);
constexpr size_t WS_WGU = WS_WOUT + al256((size_t)2 * 1024 * 1024 * 2);
constexpr size_t WS_WDN = WS_WGU + al256((size_t)2 * 5632 * 1024 * 2);
constexpr size_t WS_AH = WS_WDN + al256((size_t)2 * 1024 * 2816 * 2);
constexpr size_t WS_AH1 = WS_AH + al256((size_t)NT * 1024 * 2);
constexpr size_t WS_HF = WS_AH1 + al256((size_t)NT * 1024 * 2);
constexpr size_t WS_H1 = WS_HF + al256((size_t)NT * 1024 * 4);
constexpr size_t WS_QKV = WS_H1 + al256((size_t)NT * 1024 * 4);
constexpr size_t WS_Z = WS_QKV + al256((size_t)NT * 1024 * 2);
constexpr size_t WS_XBC = WS_Z + al256((size_t)NT * 512 * 2);
constexpr size_t WS_DT = WS_XBC + al256((size_t)NT * 1024 * 2);
constexpr size_t WS_G = WS_DT + al256((size_t)NT * 8 * 4);
constexpr size_t WS_MIX = WS_G + al256((size_t)NT * DFF * 2);
constexpr size_t WS_CO = WS_MIX + al256((size_t)NT * 1024 * 2);
constexpr size_t WS_LSE = WS_CO + al256((size_t)3 * SEQ * 256 * 2);
constexpr size_t WS_CS = WS_LSE + al256((size_t)3 * SEQ * 4 * 4);
constexpr size_t WS_CD = WS_CS + al256((size_t)128 * 65536 * 4);
constexpr size_t WS_HIN = WS_CD + al256((size_t)128 * 8 * 4);
constexpr size_t WS_ROPE = WS_HIN + al256((size_t)128 * 65536 * 2);
constexpr size_t WS_BAR = WS_ROPE + al256((size_t)16388 * 16 * 4);
constexpr size_t WS_END = WS_BAR + 2048;

struct Params {
  const float* in[26];
  float* out;
  unsigned char* ws;
};
enum { I_XP = 0, I_XS, I_CAK, I_CAV, I_CCK, I_CCV, I_SSM, I_SCONV, I_NORM1, I_WIN, I_AQN, I_AKN, I_SINK, I_CQN, I_CKN,
       I_CONVW, I_CONVB, I_DTB, I_ALOG, I_DSKIP, I_SSMN, I_WOUT, I_NORM2, I_WGATE, I_WUP, I_WDOWN };

DEVI int opaque_tid() { int t = threadIdx.x; asm volatile("" : "+v"(t)); return t; }
DEVI u16 f2bf(float f) { unsigned u = __float_as_uint(f); u += 0x7fffu + ((u >> 16) & 1u); return (u16)(u >> 16); }
DEVI float bf2f(u16 h) { return __uint_as_float(((unsigned)h) << 16); }
DEVI unsigned pack2(float a, float b) { return (unsigned)f2bf(a) | ((unsigned)f2bf(b) << 16); }
DEVI float siluf(float x) { return x / (1.f + __expf(-x)); }
DEVI float softplusf(float x) { return x > 20.f ? x : log1pf(__expf(x)); }
DEVI float bflo(unsigned u) { return __uint_as_float(u << 16); }
DEVI float bfhi(unsigned u) { return __uint_as_float(u & 0xffff0000u); }
DEVI u32x4 gload16_async(const void* p) {
  u32x4 v;
  asm volatile("global_load_dwordx4 %0, %1, off" : "=v"(v) : "v"(p) : "memory");
  return v;
}
DEVI void gwait8(u32x4& a0, u32x4& a1, u32x4& a2, u32x4& a3, u32x4& b0, u32x4& b1, u32x4& b2, u32x4& b3) {
  asm volatile("s_waitcnt vmcnt(0)" : "+v"(a0), "+v"(a1), "+v"(a2), "+v"(a3), "+v"(b0), "+v"(b1), "+v"(b2), "+v"(b3) : : "memory");
}
DEVI float sumsq8(u32x4 v) {
  float s = 0.f, t;
  t = bflo(v.x); s += t * t; t = bfhi(v.x); s += t * t;
  t = bflo(v.y); s += t * t; t = bfhi(v.y); s += t * t;
  t = bflo(v.z); s += t * t; t = bfhi(v.z); s += t * t;
  t = bflo(v.w); s += t * t; t = bfhi(v.w); s += t * t;
  return s;
}
DEVI float wave_max(float v) {
#pragma unroll
  for (int o = 32; o >= 1; o >>= 1) v = fmaxf(v, __shfl_xor(v, o));
  return v;
}
DEVI float wave_sum(float v) {
#pragma unroll
  for (int o = 32; o >= 1; o >>= 1) v += __shfl_xor(v, o);
  return v;
}
DEVI f32x4 mfma16(bf16x8 a, bf16x8 b, f32x4 c) { return __builtin_amdgcn_mfma_f32_16x16x32_bf16(a, b, c, 0, 0, 0); }

enum { EPI_IN = 0, EPI_OUT = 1, EPI_GU = 2, EPI_DN = 3 };

DEVI uint2 pack4(float a, float b, float c, float d) { uint2 o; o.x = pack2(a, b); o.y = pack2(c, d); return o; }

template <int EPI>
DEVI void gemm_epilogue(const Params& P, int l, f32x4 (&acc)[4][4], float (&scv)[4], int row0, int col0, int wm, int wn, int fr, int fq) {
  unsigned char* ws = P.ws;
  if (EPI == EPI_IN) {
    const int cb = col0 + wn * 64;
    if (cb < 1024) {
      u16* QKV = (u16*)(ws + WS_QKV);
      const float* ROPE = (const float*)(ws + WS_ROPE);
      const int hh = cb >> 6;
      const bool isv = (hh == 6 || hh == 7 || hh == 14 || hh == 15);
      const float* gain = P.in[I_AQN];
      if (hh >= 4 && hh < 6) gain = P.in[I_AKN];
      else if (hh >= 8 && hh < 12) gain = P.in[I_CQN];
      else if (hh >= 12) gain = P.in[I_CKN];
      gain += l * 64;
      float gv[4][4];
#pragma unroll
      for (int ni = 0; ni < 4; ++ni)
#pragma unroll
        for (int r = 0; r < 4; ++r) gv[ni][r] = isv ? 1.f : gain[ni * 16 + fq * 4 + r];
      const int kind = (hh == 4 || hh == 5) ? 1 : (hh == 6 || hh == 7) ? 2 : (hh == 12 || hh == 13) ? 3 : (hh >= 14) ? 4 : 0;
      const int kvh = hh & 1;
#pragma unroll
      for (int mi = 0; mi < 4; ++mi) {
        const int row = row0 + wm * 64 + mi * 16 + fr;
        float v[4][4];
        float ss = 0.f;
#pragma unroll
        for (int ni = 0; ni < 4; ++ni)
#pragma unroll
          for (int r = 0; r < 4; ++r) { v[ni][r] = acc[mi][ni][r] * scv[mi]; ss += v[ni][r] * v[ni][r]; }
        if (!isv) {
          ss += __shfl_xor(ss, 16); ss += __shfl_xor(ss, 32);
          const float sc = rsqrtf(ss * (1.f / 64.f) + EPS);
#pragma unroll
          for (int ni = 0; ni < 4; ++ni)
#pragma unroll
            for (int r = 0; r < 4; ++r) v[ni][r] *= sc * gv[ni][r];
          const int pos = row < SEQ ? row : SEQ + ((row - SEQ) & 3);
#pragma unroll
          for (int r = 0; r < 4; ++r) {
            const float partner = __shfl_xor(v[0][r], 32);
            const int i = (fq & 1) * 4 + r;
            const float cs = ROPE[pos * 16 + i], sn = ROPE[pos * 16 + 8 + i];
            v[0][r] = (fq < 2) ? (v[0][r] * cs - partner * sn) : (v[0][r] * cs + partner * sn);
          }
        }
#pragma unroll
        for (int ni = 0; ni < 4; ++ni)
          *(uint2*)(QKV + (size_t)row * 1024 + cb + ni * 16 + fq * 4) = pack4(v[ni][0], v[ni][1], v[ni][2], v[ni][3]);
        if (kind) {
          size_t base = 0;
          bool ok = false;
          if (kind <= 2) {
            if (row >= SEQ) {
              const int sb = (row - SEQ) >> 2, t = (row - SEQ) & 3;
              base = (kind == 1 ? OFF_SAK : OFF_SAV) + ((((size_t)(l * 128 + sb) * 128 + 124 + t) * 2 + kvh) * 64);
              ok = true;
            } else if (row >= SEQ - 128) {
              base = (kind == 1 ? OFF_PAK : OFF_PAV) + (((size_t)(l * 128 + (row - (SEQ - 128))) * 2 + kvh) * 64);
              ok = true;
            }
          } else {
            if (row >= SEQ) {
              const int sb = (row - SEQ) >> 2, t = (row - SEQ) & 3;
              base = (kind == 3 ? OFF_SCK : OFF_SCV) + ((((size_t)(l * 128 + sb) * 2048 + 2044 + t) * 2 + kvh) * 64);
              ok = true;
            } else if (row >= SEQ - 2048) {
              base = (kind == 3 ? OFF_PCK : OFF_PCV) + (((size_t)(l * 2048 + (row - (SEQ - 2048))) * 2 + kvh) * 64);
              ok = true;
            }
          }
          if (ok) {
#pragma unroll
            for (int ni = 0; ni < 4; ++ni)
              *(float4*)(P.out + base + ni * 16 + fq * 4) = make_float4(v[ni][0], v[ni][1], v[ni][2], v[ni][3]);
          }
        }
      }
    } else if (cb < 1536) {
      u16* Z = (u16*)(ws + WS_Z);
#pragma unroll
      for (int mi = 0; mi < 4; ++mi) {
        const int row = row0 + wm * 64 + mi * 16 + fr;
        const float sc = scv[mi];
#pragma unroll
        for (int ni = 0; ni < 4; ++ni)
          *(uint2*)(Z + (size_t)row * 512 + (cb - 1024) + ni * 16 + fq * 4) =
              pack4(acc[mi][ni][0] * sc, acc[mi][ni][1] * sc, acc[mi][ni][2] * sc, acc[mi][ni][3] * sc);
      }
    } else if (cb < 2560) {
      u16* XBC = (u16*)(ws + WS_XBC);
#pragma unroll
      for (int mi = 0; mi < 4; ++mi) {
        const int row = row0 + wm * 64 + mi * 16 + fr;
        const float sc = scv[mi];
        size_t cbase = 0;
        bool ok = false;
        if (row >= SEQ) {
          const int sb = (row - SEQ) >> 2, t = (row - SEQ) & 3;
          if (t >= 1) { ok = true; cbase = OFF_SCONV + ((size_t)(l * 128 + sb) * 3 + (t - 1)) * 1024; }
        } else if (row >= SEQ - 3) {
          ok = true; cbase = OFF_PCONV + (size_t)(l * 3 + (row - (SEQ - 3))) * 1024;
        }
#pragma unroll
        for (int ni = 0; ni < 4; ++ni) {
          const int ch = (cb - 1536) + ni * 16 + fq * 4;
          const float x0 = acc[mi][ni][0] * sc, x1 = acc[mi][ni][1] * sc, x2 = acc[mi][ni][2] * sc, x3 = acc[mi][ni][3] * sc;
          *(uint2*)(XBC + (size_t)row * 1024 + ch) = pack4(x0, x1, x2, x3);
          if (ok) *(float4*)(P.out + cbase + ch) = make_float4(x0, x1, x2, x3);
        }
      }
    } else if (cb == 2560) {
      float* DT = (float*)(ws + WS_DT);
      if (fq < 2) {
#pragma unroll
        for (int mi = 0; mi < 4; ++mi) {
          const int row = row0 + wm * 64 + mi * 16 + fr;
          const float sc = scv[mi];
          *(float4*)(DT + (size_t)row * 8 + fq * 4) = make_float4(acc[mi][0][0] * sc, acc[mi][0][1] * sc, acc[mi][0][2] * sc, acc[mi][0][3] * sc);
        }
      }
    }
  } else if (EPI == EPI_OUT) {
    float* H1 = (float*)(ws + WS_H1);
    u16* AH1 = (u16*)(ws + WS_AH1);
    const float* HF = (const float*)(ws + WS_HF);
#pragma unroll
    for (int mi = 0; mi < 4; ++mi) {
      const int row = row0 + wm * 64 + mi * 16 + fr;
      const float* res = (row < SEQ ? P.in[I_XP] + (size_t)row * 1024 : P.in[I_XS] + (size_t)(row - SEQ) * 1024);
      const u16* resb = (const u16*)(ws + WS_AH) + (size_t)row * 1024;
#pragma unroll
      for (int ni = 0; ni < 4; ++ni) {
        const int col = col0 + wn * 64 + ni * 16 + fq * 4;
        float4 rv;
        if (l == 0) rv = *(const float4*)(res + col);
        else { const uint2 rb = *(const uint2*)(resb + col); rv = make_float4(bflo(rb.x), bfhi(rb.x), bflo(rb.y), bfhi(rb.y)); }
        const float h0 = rv.x + acc[mi][ni][0], h1 = rv.y + acc[mi][ni][1], h2 = rv.z + acc[mi][ni][2], h3 = rv.w + acc[mi][ni][3];
        *(uint2*)(AH1 + (size_t)row * 1024 + col) = pack4(h0, h1, h2, h3);
      }
    }
  } else if (EPI == EPI_GU) {
    u16* G = (u16*)(ws + WS_G);
#pragma unroll
    for (int mi = 0; mi < 4; ++mi) {
      const int row = row0 + wm * 64 + mi * 16 + fr;
      const float sc = scv[mi];
#pragma unroll
      for (int q = 0; q < 2; ++q) {
        const int j = ((col0 + wn * 64) >> 1) + q * 16 + fq * 4;
        float o[4];
#pragma unroll
        for (int r = 0; r < 4; ++r) o[r] = siluf(acc[mi][2 * q][r] * sc) * (acc[mi][2 * q + 1][r] * sc);
        *(uint2*)(G + (size_t)row * DFF + j) = pack4(o[0], o[1], o[2], o[3]);
      }
    }
  } else {
    const float* H1 = (const float*)(ws + WS_H1);
    float* HF = (float*)(ws + WS_HF);
    u16* AH = (u16*)(ws + WS_AH);
#pragma unroll
    for (int mi = 0; mi < 4; ++mi) {
      const int row = row0 + wm * 64 + mi * 16 + fr;
#pragma unroll
      for (int ni = 0; ni < 4; ++ni) {
        const int col = col0 + wn * 64 + ni * 16 + fq * 4;
        const uint2 rb = *(const uint2*)((const u16*)(ws + WS_AH1) + (size_t)row * 1024 + col);
        const float4 rv = make_float4(bflo(rb.x), bfhi(rb.x), bflo(rb.y), bfhi(rb.y));
        const float h0 = rv.x + acc[mi][ni][0], h1 = rv.y + acc[mi][ni][1], h2 = rv.z + acc[mi][ni][2], h3 = rv.w + acc[mi][ni][3];
        if (l == 0) {
          *(uint2*)(AH + (size_t)row * 1024 + col) = pack4(h0, h1, h2, h3);
        } else {
          *(float4*)(P.out + OFF_Y + (size_t)row * 1024 + col) = make_float4(h0, h1, h2, h3);
        }
      }
    }
  }
}

template <int EPI>
DEVI void gemm_tile(const Params& P, int l, const u16* __restrict__ A, int lda, const u16* __restrict__ Bt, int ldb,
                          int K, int KS, int row0, int col0, unsigned char* smem) {
  const int tid = opaque_tid(), lane = tid & 63, w = tid >> 6, wm = w >> 1, wn = w & 1;
  const int fr = lane & 15, fq = lane >> 4;
  f32x4 acc[4][4];
#pragma unroll
  for (int mi = 0; mi < 4; ++mi)
#pragma unroll
    for (int ni = 0; ni < 4; ++ni) acc[mi][ni] = (f32x4){0.f, 0.f, 0.f, 0.f};
  const int lrow = tid >> 3, lch = tid & 7;
  const int gch = lch ^ (lrow & 7);
  const u16* Ag = A + (size_t)(row0 + lrow) * lda + gch * 8;
  const u16* Bg = Bt + (size_t)(col0 + lrow) * ldb + gch * 8;
  unsigned char* ldsT = smem + tid * 16;
  f32x4 gr0 = (f32x4){0.f, 0.f, 0.f, 0.f}, gr1 = gr0;
  float scv[4] = {1.f, 1.f, 1.f, 1.f};
  const int nk = K >> 6;
  const int ksS = (KS >> 6) - 1;
#pragma unroll
  for (int i = 0; i < 4; ++i) {
    __builtin_amdgcn_global_load_lds((const unsigned*)(Ag + (size_t)(32 * i) * lda), (unsigned*)(ldsT + i * 4096), 16, 0, 0);
    __builtin_amdgcn_global_load_lds((const unsigned*)(Bg + (size_t)(32 * i) * ldb), (unsigned*)(ldsT + 16384 + i * 4096), 16, 0, 0);
  }
  asm volatile("s_waitcnt vmcnt(0)" ::: "memory");
  __syncthreads();
#pragma unroll 2
  for (int ks = 0; ks < nk; ++ks) {
    const bool more = (ks + 1 < nk);
    if (more) {
      unsigned char* dst = ldsT + ((ks + 1) & 1) * 32768;
#pragma unroll
      for (int i = 0; i < 4; ++i) {
        __builtin_amdgcn_global_load_lds((const unsigned*)(Ag + (size_t)(32 * i) * lda + (ks + 1) * 64), (unsigned*)(dst + i * 4096), 16, 0, 0);
        __builtin_amdgcn_global_load_lds((const unsigned*)(Bg + (size_t)(32 * i) * ldb + (ks + 1) * 64), (unsigned*)(dst + 16384 + i * 4096), 16, 0, 0);
      }
    }
    const unsigned char* As = smem + (ks & 1) * 32768;
    const unsigned char* Bs = As + 16384;
#pragma unroll
    for (int kk = 0; kk < 2; ++kk) {
      bf16x8 af[4], bq[4];
#pragma unroll
      for (int mi = 0; mi < 4; ++mi) {
        const int row = wm * 64 + mi * 16 + fr;
        af[mi] = *(const bf16x8*)(As + row * 128 + (((kk * 4 + fq) ^ (row & 7)) << 4));
      }
#pragma unroll
      for (int ni = 0; ni < 4; ++ni) {
        const int row = wn * 64 + ni * 16 + fr;
        bq[ni] = *(const bf16x8*)(Bs + row * 128 + (((kk * 4 + fq) ^ (row & 7)) << 4));
      }
      if (ks <= ksS) {
        if (wn == 0) { gr0 = mfma16(af[0], af[0], gr0); gr1 = mfma16(af[1], af[1], gr1); }
        else { gr0 = mfma16(af[2], af[2], gr0); gr1 = mfma16(af[3], af[3], gr1); }
      }
      __builtin_amdgcn_s_setprio(1);
#pragma unroll
      for (int mi = 0; mi < 4; ++mi)
#pragma unroll
        for (int ni = 0; ni < 4; ++ni) acc[mi][ni] = mfma16(bq[ni], af[mi], acc[mi][ni]);
      __builtin_amdgcn_s_setprio(0);
    }
    float* rsL = (float*)(smem + ((ks + 1) & 1) * 32768);
    if (ks == ksS) {
      if ((fr >> 2) == fq) {
        const int r = fr & 3;
        const float d0 = r == 0 ? gr0[0] : r == 1 ? gr0[1] : r == 2 ? gr0[2] : gr0[3];
        const float d1 = r == 0 ? gr1[0] : r == 1 ? gr1[1] : r == 2 ? gr1[2] : gr1[3];
        rsL[wm * 64 + (wn * 2) * 16 + fr] = rsqrtf(d0 / (float)KS + EPS);
        rsL[wm * 64 + (wn * 2 + 1) * 16 + fr] = rsqrtf(d1 / (float)KS + EPS);
      }
    }
    asm volatile("s_waitcnt vmcnt(0)" ::: "memory");
    __syncthreads();
    if (ks == ksS) {
#pragma unroll
      for (int mi = 0; mi < 4; ++mi) scv[mi] = rsL[wm * 64 + mi * 16 + fr];
      __syncthreads();
    }
  }
  gemm_epilogue<EPI>(P, l, acc, scv, row0, col0, wm, wn, fr, fq);
}

DEVI void wconv_item(const Params& P, int mode, int l, int kt, int nt, unsigned char* smem) {
  float* tile = (float*)smem;
  const int tid = opaque_tid();
  const float* src; int ldsrc, Nsrc; u16* dst; int lddst;
  const float* gain = nullptr;
  unsigned char* ws = P.ws;
  if (mode == 0) { src = P.in[I_WIN] + (size_t)l * 1024 * NIN; ldsrc = NIN; Nsrc = NIN; dst = (u16*)(ws + WS_WIN) + (size_t)l * NINP * 1024; lddst = 1024; gain = P.in[I_NORM1] + l * 1024; }
  else if (mode == 1) { src = P.in[I_WOUT] + (size_t)l * 1024 * 1024; ldsrc = 1024; Nsrc = 1024; dst = (u16*)(ws + WS_WOUT) + (size_t)l * 1024 * 1024; lddst = 1024; }
  else if (mode == 2) { src = P.in[I_WGATE] + (size_t)l * 1024 * DFF; ldsrc = DFF; Nsrc = DFF; dst = (u16*)(ws + WS_WGU) + (size_t)l * 5632 * 1024; lddst = 1024; gain = P.in[I_NORM2] + l * 1024; }
  else if (mode == 3) { src = P.in[I_WUP] + (size_t)l * 1024 * DFF; ldsrc = DFF; Nsrc = DFF; dst = (u16*)(ws + WS_WGU) + (size_t)l * 5632 * 1024; lddst = 1024; gain = P.in[I_NORM2] + l * 1024; }
  else { src = P.in[I_WDOWN] + (size_t)l * DFF * 1024; ldsrc = 1024; Nsrc = 1024; dst = (u16*)(ws + WS_WDN) + (size_t)l * 1024 * DFF; lddst = DFF; }
  const int k0 = kt * 64, n0 = nt * 64;
  {
    const int j = tid & 63, ig = tid >> 6;
    const int n = n0 + j;
#pragma unroll
    for (int ii = 0; ii < 16; ++ii) {
      const int i = ig * 16 + ii, k = k0 + i;
      float v = 0.f;
      if (n < Nsrc) {
        v = src[(size_t)k * ldsrc + n];
        if (mode == 1) { if (k >= 256 && k < 768) v *= P.in[I_SSMN][l * 512 + (k - 256)]; }
        else if (gain) v *= gain[k];
      }
      tile[i * 65 + j] = v;
    }
  }
  __syncthreads();
  {
    const int i8 = tid & 7;
    int kd = k0 + i8 * 8;
    if (mode == 1) kd = (kd < 256) ? kd + 512 : (kd < 768 ? kd - 256 : kd);
#pragma unroll
    for (int jj = 0; jj < 2; ++jj) {
      const int j = (tid >> 3) + 32 * jj;
      const int n = n0 + j;
      int nd = n;
      if (mode == 2) nd = ((n >> 4) << 5) + (n & 15);
      else if (mode == 3) nd = ((n >> 4) << 5) + (n & 15) + 16;
      uint4 o;
      o.x = pack2(tile[(i8 * 8 + 0) * 65 + j], tile[(i8 * 8 + 1) * 65 + j]);
      o.y = pack2(tile[(i8 * 8 + 2) * 65 + j], tile[(i8 * 8 + 3) * 65 + j]);
      o.z = pack2(tile[(i8 * 8 + 4) * 65 + j], tile[(i8 * 8 + 5) * 65 + j]);
      o.w = pack2(tile[(i8 * 8 + 6) * 65 + j], tile[(i8 * 8 + 7) * 65 + j]);
      *(uint4*)(dst + (size_t)nd * lddst + kd) = o;
    }
  }
  __syncthreads();
}

DEVI void xconv_item(const Params& P, int item) {
  u16* AH = (u16*)(P.ws + WS_AH);
#pragma unroll
  for (int i = 0; i < 4; ++i) {
    const size_t e = ((size_t)item * 1024 + i * 256 + threadIdx.x) * 8;
    const float* src = (e < (size_t)SEQ * 1024) ? P.in[I_XP] + e : P.in[I_XS] + (e - (size_t)SEQ * 1024);
    const float4 a = *(const float4*)src, b = *(const float4*)(src + 4);
    uint4 o;
    o.x = pack2(a.x, a.y); o.y = pack2(a.z, a.w); o.z = pack2(b.x, b.y); o.w = pack2(b.z, b.w);
    *(uint4*)(AH + e) = o;
  }
}

DEVI void rope_item(const Params& P, int item) {
  const int e = item * 256 + threadIdx.x;
  if (e >= 16388 * 8) return;
  const int pos = e >> 3, i = e & 7;
  const double inv[8] = {1.0, 0.19392274474868576, 0.03760603093086393, 0.007292664737217109,
                         0.001414213562373095, 0.0002742481756762073, 5.318295896944988e-05, 1.031338537721246e-05};
  double invv = inv[0];
#pragma unroll
  for (int q = 1; q < 8; ++q) invv = (i == q) ? inv[q] : invv;
  const double ang = (double)pos * invv;
  const double n = rint(ang * 0.15915494309189535);
  double r = fma(-n, 6.283185307179586, ang);
  r = fma(-n, 2.4492935982947064e-16, r);
  const double r2 = r * r;
  double S = 1.0, C = 1.0;
#pragma unroll
  for (int k = 14; k >= 1; --k) {
    S = 1.0 - r2 * (1.0 / ((2.0 * k) * (2.0 * k + 1.0))) * S;
    C = 1.0 - r2 * (1.0 / ((2.0 * k - 1.0) * (2.0 * k))) * C;
  }
  float* ROPE = (float*)(P.ws + WS_ROPE);
  ROPE[pos * 16 + i] = (float)C;
  ROPE[pos * 16 + 8 + i] = (float)(r * S);
}

DEVI void attn_item(const Params& P, int l, int variant, int idx, unsigned char* smem) {
  const int tid = opaque_tid(), lane = tid & 63, w = tid >> 6, fr = lane & 15, fq = lane >> 4;
  const int h = idx & 3, qb = idx >> 2;
  const int dil = (variant <= 1) ? 1 : (variant == 2 ? 4 : 16);
  const int maxd = (variant == 0) ? 127 : 128;
  const int nbr = SEQ / dil / 64;
  const int res = qb / nbr, ib = qb % nbr;
  const int i0 = ib * 64;
  const int qofs = (variant == 0 ? 0 : 512) + h * 64;
  const int kofs = (variant == 0 ? 256 : 768) + (h >> 1) * 64;
  const int vofs = kofs + 128;
  const u16* QKV = (const u16*)(P.ws + WS_QKV);
  u16* Qs = (u16*)smem;
  u16* Ks = (u16*)(smem + 9216);
  u16* Vt = (u16*)(smem + 9216 + 27648);
  u16* Ps = Ks;
  {
    const int r = tid >> 2, c = (tid & 3) * 16;
    {
      const size_t pos = (size_t)res + (size_t)dil * (i0 + r);
      const uint4* g = (const uint4*)(QKV + pos * 1024 + qofs + c);
      const uint4 a = g[0], b = g[1];
      *(uint4*)(Qs + r * 72 + c) = a;
      *(uint4*)(Qs + r * 72 + c + 8) = b;
    }
#pragma unroll
    for (int pss = 0; pss < 3; ++pss) {
      const int kk = pss * 64 + r;
      const int ik = i0 - 128 + kk;
      uint4 a = make_uint4(0, 0, 0, 0), b = a, va = a, vb = a;
      if (ik >= 0) {
        const size_t pos = (size_t)res + (size_t)dil * ik;
        const uint4* g = (const uint4*)(QKV + pos * 1024 + kofs + c);
        a = g[0]; b = g[1];
        const uint4* gv = (const uint4*)(QKV + pos * 1024 + vofs + c);
        va = gv[0]; vb = gv[1];
      }
      *(uint4*)(Ks + kk * 72 + c) = a;
      *(uint4*)(Ks + kk * 72 + c + 8) = b;
      const unsigned vv[8] = {va.x, va.y, va.z, va.w, vb.x, vb.y, vb.z, vb.w};
#pragma unroll
      for (int e = 0; e < 8; ++e) {
        Vt[(c + 2 * e) * 200 + kk] = (u16)(vv[e] & 0xffffu);
        Vt[(c + 2 * e + 1) * 200 + kk] = (u16)(vv[e] >> 16);
      }
    }
  }
  __syncthreads();
  f32x4 s[12];
  {
    bf16x8 qa[2];
#pragma unroll
    for (int kk = 0; kk < 2; ++kk) qa[kk] = *(const bf16x8*)(Qs + (w * 16 + fr) * 72 + kk * 32 + fq * 8);
#pragma unroll
    for (int kb = 0; kb < 12; ++kb) {
      f32x4 a = (f32x4){0.f, 0.f, 0.f, 0.f};
#pragma unroll
      for (int kk = 0; kk < 2; ++kk) {
        const bf16x8 kf = *(const bf16x8*)(Ks + (kb * 16 + fr) * 72 + kk * 32 + fq * 8);
        a = mfma16(kf, qa[kk], a);
      }
      s[kb] = a;
    }
  }
  float sink = 0.f;
  if (variant == 0) sink = P.in[I_SINK][l * 4 + h];
  const int iq = i0 + w * 16 + fr;
  float mx = -INFINITY;
#pragma unroll
  for (int kb = 0; kb < 12; ++kb)
#pragma unroll
    for (int r = 0; r < 4; ++r) {
      const int ik = i0 - 128 + kb * 16 + fq * 4 + r;
      const int dist = iq - ik;
      const bool valid = (dist >= 0) && (dist <= maxd) && (ik >= 0);
      const float v = valid ? s[kb][r] * 0.125f : -INFINITY;
      s[kb][r] = v;
      mx = fmaxf(mx, v);
    }
  mx = fmaxf(mx, __shfl_xor(mx, 16)); mx = fmaxf(mx, __shfl_xor(mx, 32));
  if (variant == 0) mx = fmaxf(mx, sink);
  float den = 0.f;
#pragma unroll
  for (int kb = 0; kb < 12; ++kb)
#pragma unroll
    for (int r = 0; r < 4; ++r) {
      const float e = __expf(s[kb][r] - mx);
      s[kb][r] = e;
      den += e;
    }
  den += __shfl_xor(den, 16); den += __shfl_xor(den, 32);
  if (variant == 0) den += __expf(sink - mx);
  __syncthreads();
#pragma unroll
  for (int kb = 0; kb < 12; ++kb)
    *(uint2*)(Ps + (w * 16 + fr) * 200 + kb * 16 + fq * 4) = pack4(s[kb][0], s[kb][1], s[kb][2], s[kb][3]);
  __syncthreads();
  f32x4 o[4];
#pragma unroll
  for (int nb = 0; nb < 4; ++nb) o[nb] = (f32x4){0.f, 0.f, 0.f, 0.f};
#pragma unroll
  for (int ks = 0; ks < 6; ++ks) {
    const bf16x8 pa = *(const bf16x8*)(Ps + (w * 16 + fr) * 200 + ks * 32 + fq * 8);
#pragma unroll
    for (int nb = 0; nb < 4; ++nb) {
      const bf16x8 vf = *(const bf16x8*)(Vt + (nb * 16 + fr) * 200 + ks * 32 + fq * 8);
      o[nb] = mfma16(vf, pa, o[nb]);
    }
  }
  {
    const size_t pos = (size_t)res + (size_t)dil * iq;
    const float inv = 1.f / den;
    if (variant == 0) {
      u16* MIX = (u16*)(P.ws + WS_MIX);
#pragma unroll
      for (int nb = 0; nb < 4; ++nb)
        *(uint2*)(MIX + pos * 1024 + 512 + h * 64 + nb * 16 + fq * 4) = pack4(o[nb][0] * inv, o[nb][1] * inv, o[nb][2] * inv, o[nb][3] * inv);
    } else {
      u16* CO = (u16*)(P.ws + WS_CO) + (size_t)(variant - 1) * SEQ * 256;
#pragma unroll
      for (int nb = 0; nb < 4; ++nb)
        *(uint2*)(CO + pos * 256 + h * 64 + nb * 16 + fq * 4) = pack4(o[nb][0] * inv, o[nb][1] * inv, o[nb][2] * inv, o[nb][3] * inv);
      if (fq == 0) {
        float* LSE = (float*)(P.ws + WS_LSE) + (size_t)(variant - 1) * SEQ * 4;
        LSE[pos * 4 + h] = mx + __logf(den);
      }
    }
  }
  __syncthreads();
}

DEVI void cmerge_item(const Params& P, int item) {
  const int tid = opaque_tid();
  const int tok = item * 8 + (tid >> 5), ch = tid & 31;
  const int h = ch >> 3;
  const float* LSE = (const float*)(P.ws + WS_LSE);
  const u16* CO = (const u16*)(P.ws + WS_CO);
  const float l0 = LSE[(size_t)tok * 4 + h], l1 = LSE[(size_t)(SEQ + tok) * 4 + h], l2 = LSE[(size_t)(2 * SEQ + tok) * 4 + h];
  const float mx = fmaxf(l0, fmaxf(l1, l2));
  float w0 = __expf(l0 - mx), w1 = __expf(l1 - mx), w2 = __expf(l2 - mx);
  const float inv = 1.f / (w0 + w1 + w2);
  w0 *= inv; w1 *= inv; w2 *= inv;
  const uint4 a = *(const uint4*)(CO + (size_t)tok * 256 + ch * 8);
  const uint4 b = *(const uint4*)(CO + ((size_t)SEQ + tok) * 256 + ch * 8);
  const uint4 c = *(const uint4*)(CO + ((size_t)2 * SEQ + tok) * 256 + ch * 8);
  uint4 o;
  o.x = pack2(w0 * bflo(a.x) + w1 * bflo(b.x) + w2 * bflo(c.x), w0 * bfhi(a.x) + w1 * bfhi(b.x) + w2 * bfhi(c.x));
  o.y = pack2(w0 * bflo(a.y) + w1 * bflo(b.y) + w2 * bflo(c.y), w0 * bfhi(a.y) + w1 * bfhi(b.y) + w2 * bfhi(c.y));
  o.z = pack2(w0 * bflo(a.z) + w1 * bflo(b.z) + w2 * bflo(c.z), w0 * bfhi(a.z) + w1 * bfhi(b.z) + w2 * bfhi(c.z));
  o.w = pack2(w0 * bflo(a.w) + w1 * bflo(b.w) + w2 * bflo(c.w), w0 * bfhi(a.w) + w1 * bfhi(b.w) + w2 * bfhi(c.w));
  u16* MIX = (u16*)(P.ws + WS_MIX);
  *(uint4*)(MIX + (size_t)tok * 1024 + 768 + ch * 8) = o;
}

DEVI void sattn_item(const Params& P, int l, int isC, int item, unsigned char* smem) {
  const int tid = opaque_tid(), lane = tid & 63, t = tid >> 6;
  const int b = item >> 1, kvh = item & 1;
  float* qf = (float*)smem + t * 128;
  float* sb = (float*)smem + 512 + t * 784;
  const int row = SEQ + b * 4 + t;
  const u16* QKV = (const u16*)(P.ws + WS_QKV);
  const int nkeys = isC ? 387 : 128;
  const int buf = isC ? 2048 : 128;
  const float* cK = (isC ? P.in[I_CCK] : P.in[I_CAK]) + ((size_t)(l * 128 + b) * buf) * 128 + kvh * 64;
  const float* cV = (isC ? P.in[I_CCV] : P.in[I_CAV]) + ((size_t)(l * 128 + b) * buf) * 128 + kvh * 64;
  const float* nK = P.out + (isC ? OFF_SCK : OFF_SAK) + ((size_t)(l * 128 + b) * buf + (buf - 4)) * 128 + kvh * 64;
  const float* nV = P.out + (isC ? OFF_SCV : OFF_SAV) + ((size_t)(l * 128 + b) * buf + (buf - 4)) * 128 + kvh * 64;
#pragma unroll
  for (int hh = 0; hh < 2; ++hh)
    qf[hh * 64 + lane] = bf2f(QKV[(size_t)row * 1024 + (isC ? 512 : 0) + (kvh * 2 + hh) * 64 + lane]);
  __syncthreads();
  float m0 = -INFINITY, m1 = -INFINITY;
  for (int j = lane; j < nkeys; j += 64) {
    int idx;
    if (isC) { const int pi = j / 129, jj = j - pi * 129; const int d = (pi == 0) ? 1 : (pi == 1 ? 4 : 16); idx = 2048 + t - d * jj; }
    else idx = t + 1 + j;
    const float* kp = (idx < buf) ? cK + (size_t)idx * 128 : nK + (size_t)(idx - buf) * 128;
    float s0 = 0.f, s1 = 0.f;
#pragma unroll
    for (int c4 = 0; c4 < 16; ++c4) {
      const float4 kv = ((const float4*)kp)[c4];
      const float4 q0 = ((const float4*)qf)[c4], q1 = ((const float4*)(qf + 64))[c4];
      s0 += kv.x * q0.x + kv.y * q0.y + kv.z * q0.z + kv.w * q0.w;
      s1 += kv.x * q1.x + kv.y * q1.y + kv.z * q1.z + kv.w * q1.w;
    }
    s0 *= 0.125f; s1 *= 0.125f;
    sb[j] = s0; sb[392 + j] = s1;
    m0 = fmaxf(m0, s0); m1 = fmaxf(m1, s1);
  }
  m0 = wave_max(m0); m1 = wave_max(m1);
  float sk0 = 0.f, sk1 = 0.f;
  if (!isC) {
    sk0 = P.in[I_SINK][l * 4 + kvh * 2]; sk1 = P.in[I_SINK][l * 4 + kvh * 2 + 1];
    m0 = fmaxf(m0, sk0); m1 = fmaxf(m1, sk1);
  }
  float d0 = 0.f, d1 = 0.f;
  for (int j = lane; j < nkeys; j += 64) {
    const float e0 = __expf(sb[j] - m0), e1 = __expf(sb[392 + j] - m1);
    sb[j] = e0; sb[392 + j] = e1;
    d0 += e0; d1 += e1;
  }
  d0 = wave_sum(d0); d1 = wave_sum(d1);
  if (!isC) { d0 += __expf(sk0 - m0); d1 += __expf(sk1 - m1); }
  __syncthreads();
  const int g4 = lane >> 4, c4 = lane & 15;
  float a0[4] = {0.f, 0.f, 0.f, 0.f}, a1[4] = {0.f, 0.f, 0.f, 0.f};
  const int nsteps = (nkeys + 3) >> 2;
#pragma unroll 8
  for (int js = 0; js < nsteps; ++js) {
    const int jraw = js * 4 + g4;
    const int j = jraw < nkeys ? jraw : nkeys - 1;
    int idx;
    if (isC) { const int pi = j / 129, jj = j - pi * 129; const int d = (pi == 0) ? 1 : (pi == 1 ? 4 : 16); idx = 2048 + t - d * jj; }
    else idx = t + 1 + j;
    const float* vp = (idx < buf) ? cV + (size_t)idx * 128 : nV + (size_t)(idx - buf) * 128;
    const float4 v = ((const float4*)vp)[c4];
    const float p0 = jraw < nkeys ? sb[j] : 0.f, p1 = jraw < nkeys ? sb[392 + j] : 0.f;
    a0[0] += p0 * v.x; a0[1] += p0 * v.y; a0[2] += p0 * v.z; a0[3] += p0 * v.w;
    a1[0] += p1 * v.x; a1[1] += p1 * v.y; a1[2] += p1 * v.z; a1[3] += p1 * v.w;
  }
#pragma unroll
  for (int i = 0; i < 4; ++i) {
    a0[i] += __shfl_xor(a0[i], 16); a0[i] += __shfl_xor(a0[i], 32);
    a1[i] += __shfl_xor(a1[i], 16); a1[i] += __shfl_xor(a1[i], 32);
  }
  u16* MIX = (u16*)(P.ws + WS_MIX);
  const int mo = isC ? 768 : 512;
  if (g4 == 0) {
    const float i0 = 1.f / d0, i1 = 1.f / d1;
    uint2 w0, w1;
    w0.x = pack2(a0[0] * i0, a0[1] * i0); w0.y = pack2(a0[2] * i0, a0[3] * i0);
    w1.x = pack2(a1[0] * i1, a1[1] * i1); w1.y = pack2(a1[2] * i1, a1[3] * i1);
    *(uint2*)(MIX + (size_t)row * 1024 + mo + (kvh * 2) * 64 + c4 * 4) = w0;
    *(uint2*)(MIX + (size_t)row * 1024 + mo + (kvh * 2 + 1) * 64 + c4 * 4) = w1;
  }
  __syncthreads();
}

DEVI void smamba_item(const Params& P, int l, int item, unsigned char* smem) {
  const int tid = opaque_tid();
  const int b = item >> 3, h = item & 7, g = h >> 2;
  float* xa = (float*)smem;
  float* Ba = xa + 256;
  float* Ca = Ba + 512;
  const u16* XBC = (const u16*)(P.ws + WS_XBC);
  const float* DT = (const float*)(P.ws + WS_DT);
  const u16* Z = (const u16*)(P.ws + WS_Z);
  const int row0 = SEQ + b * 4;
  for (int ci = tid; ci < 320; ci += 256) {
    int ch; float* dst; int dl;
    if (ci < 64) { ch = h * 64 + ci; dst = xa + ci; dl = 64; }
    else if (ci < 192) { ch = 512 + g * 128 + (ci - 64); dst = Ba + (ci - 64); dl = 128; }
    else { ch = 768 + g * 128 + (ci - 192); dst = Ca + (ci - 192); dl = 128; }
    float sq[7];
#pragma unroll
    for (int j = 0; j < 3; ++j) sq[j] = P.in[I_SCONV][((size_t)(l * 128 + b) * 3 + j) * 1024 + ch];
#pragma unroll
    for (int j = 0; j < 4; ++j) sq[3 + j] = bf2f(XBC[(size_t)(row0 + j) * 1024 + ch]);
    const float w0 = P.in[I_CONVW][(l * 4 + 0) * 1024 + ch], w1 = P.in[I_CONVW][(l * 4 + 1) * 1024 + ch];
    const float w2 = P.in[I_CONVW][(l * 4 + 2) * 1024 + ch], w3 = P.in[I_CONVW][(l * 4 + 3) * 1024 + ch];
    const float bs = P.in[I_CONVB][l * 1024 + ch];
#pragma unroll
    for (int t = 0; t < 4; ++t) dst[t * dl] = siluf(bs + w0 * sq[t] + w1 * sq[t + 1] + w2 * sq[t + 2] + w3 * sq[t + 3]);
  }
  __syncthreads();
  const int p = tid >> 2, nq = tid & 3;
  float hs[32];
  const float* sp = P.in[I_SSM] + (((size_t)(l * 128 + b) * 8 + h) * 64 + p) * 128 + nq * 32;
#pragma unroll
  for (int i = 0; i < 8; ++i) {
    const float4 v = ((const float4*)sp)[i];
    hs[4 * i] = v.x; hs[4 * i + 1] = v.y; hs[4 * i + 2] = v.z; hs[4 * i + 3] = v.w;
  }
  const float dtb = P.in[I_DTB][l * 8 + h], aneg = -__expf(P.in[I_ALOG][l * 8 + h]), dsk = P.in[I_DSKIP][l * 8 + h];
  u16* MIX = (u16*)(P.ws + WS_MIX);
#pragma unroll
  for (int t = 0; t < 4; ++t) {
    const float dt = softplusf(DT[(size_t)(row0 + t) * 8 + h] + dtb);
    const float dA = __expf(aneg * dt);
    const float xv = xa[t * 64 + p];
    const float xdt = xv * dt;
    float yp = 0.f;
#pragma unroll
    for (int i = 0; i < 32; ++i) {
      hs[i] = hs[i] * dA + xdt * Ba[t * 128 + nq * 32 + i];
      yp += Ca[t * 128 + nq * 32 + i] * hs[i];
    }
    yp += __shfl_xor(yp, 1); yp += __shfl_xor(yp, 2);
    float y = yp + xv * dsk;
    y *= siluf(bf2f(Z[(size_t)(row0 + t) * 512 + h * 64 + p]));
    if (nq == 0) MIX[(size_t)(row0 + t) * 1024 + h * 64 + p] = f2bf(y);
  }
  float* op = P.out + OFF_SSSM + (((size_t)(l * 128 + b) * 8 + h) * 64 + p) * 128 + nq * 32;
#pragma unroll
  for (int i = 0; i < 8; ++i) ((float4*)op)[i] = make_float4(hs[4 * i], hs[4 * i + 1], hs[4 * i + 2], hs[4 * i + 3]);
  __syncthreads();
}

DEVI void ssd_dt_acum(const Params& P, int l, int c, int h, float* dtv, float* acum) {
  const int tid = opaque_tid(), lane = tid & 63;
  const float* DT = (const float*)(P.ws + WS_DT);
  const float aneg = -__expf(P.in[I_ALOG][l * 8 + h]);
  float a = 0.f;
  if (tid < 128) {
    const float dt = softplusf(DT[(size_t)(c * 128 + tid) * 8 + h] + P.in[I_DTB][l * 8 + h]);
    dtv[tid] = dt;
    a = aneg * dt;
  }
#pragma unroll
  for (int o = 1; o < 64; o <<= 1) {
    const float n = __shfl_up(a, o);
    if (lane >= o) a += n;
  }
  if (tid == 63) dtv[128] = a;
  __syncthreads();
  if (tid >= 64 && tid < 128) a += dtv[128];
  if (tid < 128) acum[tid] = a;
  __syncthreads();
}

template <class F>
DEVI void conv_rows(const Params& P, int l, int tok0, int n, int ch, F f) {
  const u16* XBC = (const u16*)(P.ws + WS_XBC);
  const float w0 = P.in[I_CONVW][(l * 4 + 0) * 1024 + ch], w1 = P.in[I_CONVW][(l * 4 + 1) * 1024 + ch];
  const float w2 = P.in[I_CONVW][(l * 4 + 2) * 1024 + ch], w3 = P.in[I_CONVW][(l * 4 + 3) * 1024 + ch];
  const float bs = P.in[I_CONVB][l * 1024 + ch];
  float x0 = (tok0 - 3 >= 0) ? bf2f(XBC[(size_t)(tok0 - 3) * 1024 + ch]) : 0.f;
  float x1 = (tok0 - 2 >= 0) ? bf2f(XBC[(size_t)(tok0 - 2) * 1024 + ch]) : 0.f;
  float x2 = (tok0 - 1 >= 0) ? bf2f(XBC[(size_t)(tok0 - 1) * 1024 + ch]) : 0.f;
  for (int b = 0; b < n; b += 32) {
    u16 raw[32];
#pragma unroll
    for (int t = 0; t < 32; ++t) raw[t] = XBC[(size_t)(tok0 + b + t) * 1024 + ch];
#pragma unroll
    for (int t = 0; t < 32; ++t) {
      const float x3 = bf2f(raw[t]);
      f(b + t, siluf(bs + w0 * x0 + w1 * x1 + w2 * x2 + w3 * x3));
      x0 = x1; x1 = x2; x2 = x3;
    }
  }
}

template <int N>
struct ConvBuf2 { unsigned raw[N + 3]; float wa[5], wb[5]; };
template <int N>
DEVI void conv2_load(const Params& P, int l, int tok0, int ch, ConvBuf2<N>& cb) {
  const u16* XBC = (const u16*)(P.ws + WS_XBC);
#pragma unroll
  for (int j = 0; j < 3; ++j) cb.raw[j] = (tok0 - 3 + j >= 0) ? *(const unsigned*)(XBC + (size_t)(tok0 - 3 + j) * 1024 + ch) : 0u;
#pragma unroll
  for (int t = 0; t < N; ++t) cb.raw[3 + t] = *(const unsigned*)(XBC + (size_t)(tok0 + t) * 1024 + ch);
#pragma unroll
  for (int j = 0; j < 4; ++j) {
    cb.wa[j] = P.in[I_CONVW][(l * 4 + j) * 1024 + ch];
    cb.wb[j] = P.in[I_CONVW][(l * 4 + j) * 1024 + ch + 1];
  }
  cb.wa[4] = P.in[I_CONVB][l * 1024 + ch];
  cb.wb[4] = P.in[I_CONVB][l * 1024 + ch + 1];
}
template <int N, class F>
DEVI void conv2_apply(const ConvBuf2<N>& cb, F f) {
#pragma unroll
  for (int t = 0; t < N; ++t) {
    const float va = siluf(cb.wa[4] + cb.wa[0] * bflo(cb.raw[t]) + cb.wa[1] * bflo(cb.raw[t + 1]) + cb.wa[2] * bflo(cb.raw[t + 2]) + cb.wa[3] * bflo(cb.raw[t + 3]));
    const float vb = siluf(cb.wb[4] + cb.wb[0] * bfhi(cb.raw[t]) + cb.wb[1] * bfhi(cb.raw[t + 1]) + cb.wb[2] * bfhi(cb.raw[t + 2]) + cb.wb[3] * bfhi(cb.raw[t + 3]));
    f(t, va, vb);
  }
}

DEVI void ssd_cs_item(const Params& P, int l, int item, unsigned char* smem) {
  const int tid = opaque_tid(), lane = tid & 63, w = tid >> 6, fr = lane & 15, fq = lane >> 4;
  const int c = item >> 3, h = item & 7, g = h >> 2;
  u16* xT = (u16*)smem;
  u16* BT = (u16*)(smem + 17408);
  float* acum = (float*)(smem + 17408 + 34816);
  float* dtv = acum + 128;
  ConvBuf2<16> cX;
  ConvBuf2<32> cB;
  conv2_load<16>(P, l, c * 128 + (tid >> 5) * 16, h * 64 + 2 * (tid & 31), cX);
  conv2_load<32>(P, l, c * 128 + (tid >> 6) * 32, 512 + g * 128 + 2 * (tid & 63), cB);
  ssd_dt_acum(P, l, c, h, dtv, acum);
  const float aend = acum[127];
  {
    const int cp = tid & 31, rg = tid >> 5;
    conv2_apply<16>(cX, [&](int t, float va, float vb) {
      const int s = rg * 16 + t;
      const float e = dtv[s] * __expf(aend - acum[s]);
      xT[(2 * cp) * 136 + s] = f2bf(va * e);
      xT[(2 * cp + 1) * 136 + s] = f2bf(vb * e);
    });
  }
  {
    const int cp = tid & 63, rg = tid >> 6;
    conv2_apply<32>(cB, [&](int t, float va, float vb) {
      BT[(2 * cp) * 136 + rg * 32 + t] = f2bf(va);
      BT[(2 * cp + 1) * 136 + rg * 32 + t] = f2bf(vb);
    });
  }
  __syncthreads();
  float* CS = (float*)(P.ws + WS_CS) + (size_t)(c * 8 + h) * 8192;
  bf16x8 xa[4];
#pragma unroll
  for (int ks = 0; ks < 4; ++ks) xa[ks] = *(const bf16x8*)(xT + (w * 16 + fr) * 136 + ks * 32 + fq * 8);
#pragma unroll
  for (int nb = 0; nb < 8; ++nb) {
    f32x4 a = (f32x4){0.f, 0.f, 0.f, 0.f};
#pragma unroll
    for (int ks = 0; ks < 4; ++ks) {
      const bf16x8 bfg = *(const bf16x8*)(BT + (nb * 16 + fr) * 136 + ks * 32 + fq * 8);
      a = mfma16(xa[ks], bfg, a);
    }
#pragma unroll
    for (int r = 0; r < 4; ++r) CS[(w * 16 + fq * 4 + r) * 128 + nb * 16 + fr] = a[r];
  }
  if (tid == 0) ((float*)(P.ws + WS_CD))[c * 8 + h] = __expf(aend);
  __syncthreads();
}

DEVI void ssd_scan_item(const Params& P, int l, int item) {
  const int e = item * 256 + threadIdx.x;
  const int h = e >> 13;
  const float* CS = (const float*)(P.ws + WS_CS);
  const float* CD = (const float*)(P.ws + WS_CD);
  u16* HIN = (u16*)(P.ws + WS_HIN);
  float hc = 0.f;
#pragma unroll 32
  for (int c = 0; c < 128; ++c) {
    HIN[(size_t)c * 65536 + e] = f2bf(hc);
    hc = hc * CD[c * 8 + h] + CS[(size_t)c * 65536 + e];
  }
  P.out[OFF_PSSM + (size_t)l * 65536 + e] = hc;
}

DEVI void ssd_y_item(const Params& P, int l, int item, unsigned char* smem) {
  const int tid = opaque_tid(), lane = tid & 63, w = tid >> 6, fr = lane & 15, fq = lane >> 4;
  const int half = item & 1, h = (item >> 1) & 7, c = item >> 4, g = h >> 2;
  const int l0 = half * 64;
  u16* Cs = (u16*)smem;
  u16* Hs = (u16*)(smem + 17408);
  u16* Bs = (u16*)(smem + 34816);
  float* acum = (float*)(smem + 69632);
  float* dtv = acum + 128;
  u16* Gs = Hs;
  u16* xT = Bs;
  ConvBuf2<16> cC, cX;
  ConvBuf2<32> cB;
  u32x4 hin[4];
  conv2_load<16>(P, l, c * 128 + l0 + (tid >> 6) * 16, 768 + g * 128 + 2 * (tid & 63), cC);
  conv2_load<32>(P, l, c * 128 + (tid >> 6) * 32, 512 + g * 128 + 2 * (tid & 63), cB);
  conv2_load<16>(P, l, c * 128 + (tid >> 5) * 16, h * 64 + 2 * (tid & 31), cX);
  {
    const u16* HIN = (const u16*)(P.ws + WS_HIN) + (size_t)(c * 8 + h) * 8192;
    const int r = tid >> 2, cq = (tid & 3) * 32;
#pragma unroll
    for (int i = 0; i < 4; ++i) hin[i] = *(const u32x4*)(HIN + r * 128 + cq + i * 8);
  }
  ssd_dt_acum(P, l, c, h, dtv, acum);
  {
    const int cp = tid & 63, rg = tid >> 6;
    conv2_apply<16>(cC, [&](int t, float va, float vb) {
      *(unsigned*)(Cs + (rg * 16 + t) * 136 + 2 * cp) = pack2(va, vb);
    });
    conv2_apply<32>(cB, [&](int t, float va, float vb) {
      *(unsigned*)(Bs + (rg * 32 + t) * 136 + 2 * cp) = pack2(va, vb);
    });
    const int r = tid >> 2, cq = (tid & 3) * 32;
#pragma unroll
    for (int i = 0; i < 4; ++i) *(u32x4*)(Hs + r * 136 + cq + i * 8) = hin[i];
  }
  __syncthreads();
  f32x4 y[4];
  f32x4 cb[8];
  {
    bf16x8 ca[4];
#pragma unroll
    for (int ks = 0; ks < 4; ++ks) ca[ks] = *(const bf16x8*)(Cs + (w * 16 + fr) * 136 + ks * 32 + fq * 8);
#pragma unroll
    for (int nb = 0; nb < 4; ++nb) {
      f32x4 a = (f32x4){0.f, 0.f, 0.f, 0.f};
#pragma unroll
      for (int ks = 0; ks < 4; ++ks) a = mfma16(ca[ks], *(const bf16x8*)(Hs + (nb * 16 + fr) * 136 + ks * 32 + fq * 8), a);
      y[nb] = a;
    }
#pragma unroll
    for (int sbk = 0; sbk < 8; ++sbk) {
      f32x4 a = (f32x4){0.f, 0.f, 0.f, 0.f};
#pragma unroll
      for (int ks = 0; ks < 4; ++ks) a = mfma16(ca[ks], *(const bf16x8*)(Bs + (sbk * 16 + fr) * 136 + ks * 32 + fq * 8), a);
      cb[sbk] = a;
    }
  }
  float al[4];
#pragma unroll
  for (int r = 0; r < 4; ++r) al[r] = acum[l0 + w * 16 + fq * 4 + r];
  __syncthreads();
#pragma unroll
  for (int sbk = 0; sbk < 8; ++sbk) {
    const int s = sbk * 16 + fr;
    const float as = acum[s];
#pragma unroll
    for (int r = 0; r < 4; ++r) {
      const int ll = l0 + w * 16 + fq * 4 + r;
      const float gval = (s <= ll) ? cb[sbk][r] * __expf(al[r] - as) : 0.f;
      Gs[(w * 16 + fq * 4 + r) * 136 + s] = f2bf(gval);
    }
  }
  {
    const int cp = tid & 31, rg = tid >> 5;
    conv2_apply<16>(cX, [&](int t, float va, float vb) {
      const int s = rg * 16 + t;
      xT[(2 * cp) * 136 + s] = f2bf(va * dtv[s]);
      xT[(2 * cp + 1) * 136 + s] = f2bf(vb * dtv[s]);
    });
  }
  __syncthreads();
  f32x4 yd[4];
#pragma unroll
  for (int nb = 0; nb < 4; ++nb) yd[nb] = (f32x4){0.f, 0.f, 0.f, 0.f};
#pragma unroll
  for (int ks = 0; ks < 4; ++ks) {
    const bf16x8 ga = *(const bf16x8*)(Gs + (w * 16 + fr) * 136 + ks * 32 + fq * 8);
#pragma unroll
    for (int nb = 0; nb < 4; ++nb) yd[nb] = mfma16(ga, *(const bf16x8*)(xT + (nb * 16 + fr) * 136 + ks * 32 + fq * 8), yd[nb]);
  }
  const float dsk = P.in[I_DSKIP][l * 8 + h];
  const u16* Z = (const u16*)(P.ws + WS_Z);
  u16* MIX = (u16*)(P.ws + WS_MIX);
#pragma unroll
  for (int r = 0; r < 4; ++r) {
    const int ll = l0 + w * 16 + fq * 4 + r;
    const size_t tok = (size_t)c * 128 + ll;
    const float idt = 1.f / dtv[ll];
    const float eal = __expf(al[r]);
#pragma unroll
    for (int nb = 0; nb < 4; ++nb) {
      const int p = nb * 16 + fr;
      float yv = yd[nb][r] + y[nb][r] * eal + bf2f(xT[p * 136 + ll]) * idt * dsk;
      yv *= siluf(bf2f(Z[tok * 512 + h * 64 + p]));
      MIX[tok * 1024 + h * 64 + p] = f2bf(yv);
    }
  }
  __syncthreads();
}

DEVI void mixnorm_item(const Params& P, int item) {
  const int tid = opaque_tid(), lane = tid & 63, w = tid >> 6;
  const int row = item * 4 + w;
  u16* MIX = (u16*)(P.ws + WS_MIX) + (size_t)row * 1024 + lane * 8;
  const uint4 v = *(const uint4*)MIX;
  float f[8] = {bflo(v.x), bfhi(v.x), bflo(v.y), bfhi(v.y), bflo(v.z), bfhi(v.z), bflo(v.w), bfhi(v.w)};
  float s = 0.f;
#pragma unroll
  for (int i = 0; i < 8; ++i) s += f[i] * f[i];
  s = wave_sum(s);
  const float sc = rsqrtf(s * (1.f / 512.f) + EPS);
  uint4 o;
  o.x = pack2(f[0] * sc, f[1] * sc); o.y = pack2(f[2] * sc, f[3] * sc);
  o.z = pack2(f[4] * sc, f[5] * sc); o.w = pack2(f[6] * sc, f[7] * sc);
  *(uint4*)MIX = o;
}

DEVI void copy_item(const Params& P, int l, int item) {
  const float* src; float* dst; int n4;
  int s4;
  if (item < 4096) {
    const int part = item & 15, kv = (item >> 4) & 1, b = item >> 5;
    const size_t base = (size_t)(l * 128 + b) * 262144;
    src = (kv ? P.in[I_CCV] : P.in[I_CCK]) + base + 512;
    dst = P.out + (kv ? OFF_SCV : OFF_SCK) + base;
    s4 = part * 4096;
    n4 = min(4096, 65408 - s4);
  } else {
    const int it = item - 4096;
    const int kv = it & 1, b = it >> 1;
    const size_t base = (size_t)(l * 128 + b) * 16384;
    src = (kv ? P.in[I_CAV] : P.in[I_CAK]) + base + 512;
    dst = P.out + (kv ? OFF_SAV : OFF_SAK) + base;
    s4 = 0; n4 = 3968;
  }
  const f32x4* s = (const f32x4*)src + s4;
  f32x4* d = (f32x4*)dst + s4;
  const int t = threadIdx.x;
  f32x4 v[16];
#pragma unroll
  for (int i = 0; i < 16; ++i)
    if (i * 256 + t < n4) v[i] = __builtin_nontemporal_load(s + i * 256 + t);
#pragma unroll
  for (int i = 0; i < 16; ++i)
    if (i * 256 + t < n4) __builtin_nontemporal_store(v[i], d + i * 256 + t);
}

DEVI void copy_ptrs(const Params& P, int l, int item, const f32x4*& s, f32x4*& d, int& n4) {
  if (item < 4096) {
    const int part = item & 15, kv = (item >> 4) & 1, b = item >> 5;
    const size_t base = (size_t)(l * 128 + b) * 262144;
    s = (const f32x4*)((kv ? P.in[I_CCV] : P.in[I_CCK]) + base + 512) + part * 4096;
    d = (f32x4*)(P.out + (kv ? OFF_SCV : OFF_SCK) + base) + part * 4096;
    n4 = min(4096, 65408 - part * 4096);
  } else {
    const int it = item - 4096;
    const int kv = it & 1, b = it >> 1;
    const size_t base = (size_t)(l * 128 + b) * 16384;
    s = (const f32x4*)((kv ? P.in[I_CAV] : P.in[I_CAK]) + base + 512);
    d = (f32x4*)(P.out + (kv ? OFF_SAV : OFF_SAK) + base);
    n4 = 3968;
  }
}

struct GBar { unsigned* bar; unsigned epoch; unsigned x; unsigned nloc; unsigned nx; };
DEVI unsigned bar_ld(unsigned* p) { return __hip_atomic_load(p, __ATOMIC_RELAXED, __HIP_MEMORY_SCOPE_AGENT); }
DEVI unsigned bar_add(unsigned* p, unsigned v) { return __hip_atomic_fetch_add(p, v, __ATOMIC_RELAXED, __HIP_MEMORY_SCOPE_AGENT); }
DEVI void gsync_flat(GBar& g) {
  asm volatile("s_waitcnt vmcnt(0) lgkmcnt(0)" ::: "memory");
  __syncthreads();
  if (threadIdx.x == 0) {
    __builtin_amdgcn_fence(__ATOMIC_RELEASE, "agent");
    asm volatile("s_waitcnt vmcnt(0)" ::: "memory");
    bar_add(g.bar, 1u);
    while (bar_ld(g.bar) < gridDim.x) __builtin_amdgcn_s_sleep(2);
    __builtin_amdgcn_fence(__ATOMIC_ACQUIRE, "agent");
    asm volatile("s_waitcnt vmcnt(0)" ::: "memory");
  }
  __syncthreads();
}
DEVI void gsync(GBar& g) {
  asm volatile("s_waitcnt vmcnt(0) lgkmcnt(0)" ::: "memory");
  __syncthreads();
  g.epoch++;
  if (threadIdx.x == 0) {
    const unsigned old = bar_add(g.bar + 32 * (1 + g.x), 1u);
    if (old == g.epoch * g.nloc - 1u) {
      __builtin_amdgcn_fence(__ATOMIC_RELEASE, "agent");
      asm volatile("s_waitcnt vmcnt(0)" ::: "memory");
      bar_add(g.bar + 32 * 9, 1u);
    }
    const unsigned target = g.epoch * g.nx;
    while (bar_ld(g.bar + 32 * 9) < target) __builtin_amdgcn_s_sleep(1);
    __builtin_amdgcn_fence(__ATOMIC_ACQUIRE, "agent");
    asm volatile("s_waitcnt vmcnt(0)" ::: "memory");
  }
  __syncthreads();
}

__global__ void __launch_bounds__(256, 2) hymba_megakernel(Params P) {
  extern __shared__ __attribute__((aligned(16))) unsigned char smem[];
  cg::grid_group cgrid = cg::this_grid();
  GBar grid; grid.bar = (unsigned*)(P.ws + WS_BAR); grid.epoch = 0;
  grid.x = (unsigned)__builtin_amdgcn_s_getreg((3 << 11) | 20) & 7u;
  if (threadIdx.x == 0) bar_add(grid.bar + 32 * 10 + grid.x, 1u);
  const int nb = gridDim.x, bid = blockIdx.x;
  const int vbid = ((nb & 7) == 0) ? (bid & 7) * (nb >> 3) + (bid >> 3) : bid;
  unsigned char* ws = P.ws;

#ifdef NANFILL
  {
    uint4* w4 = (uint4*)ws;
    const size_t n4 = WS_END / 16;
    const uint4 pat = make_uint4(0xffffffffu, 0xffffffffu, 0xffffffffu, 0xffffffffu);
    for (size_t i = (size_t)bid * 256 + threadIdx.x; i < n4; i += (size_t)nb * 256) w4[i] = pat;
    for (int i = threadIdx.x; i < LDS_BYTES / 16; i += 256) ((uint4*)smem)[i] = pat;
  }
  gsync(grid);
#endif
  {
    const int NW = 2 * 3040, NX = 2112, NR = 513;
    for (int it = bid; it < NW + NX + NR; it += nb) {
      if ((PHM & 1) && it < NW) {
        const int l = it / 3040;
        int r = it % 3040;
        if (r < 672) wconv_item(P, 0, l, r / 42, r % 42, smem);
        else if ((r -= 672) < 256) wconv_item(P, 1, l, r / 16, r % 16, smem);
        else if ((r -= 256) < 704) wconv_item(P, 2, l, r / 44, r % 44, smem);
        else if ((r -= 704) < 704) wconv_item(P, 3, l, r / 44, r % 44, smem);
        else { r -= 704; wconv_item(P, 4, l, r / 16, r % 16, smem); }
      } else if (it < NW + NX) { if (PHM & 2) xconv_item(P, it - NW); }
      else if (PHM & 2) rope_item(P, it - NW - NX);
    }
  }
  asm volatile("s_waitcnt vmcnt(0) lgkmcnt(0)" ::: "memory");
  __syncthreads();
  cgrid.sync();
  if (threadIdx.x == 0) __builtin_amdgcn_fence(__ATOMIC_ACQUIRE, "agent");
  asm volatile("s_waitcnt vmcnt(0)" ::: "memory");
  __syncthreads();
  {
    unsigned nx = 0;
#pragma unroll
    for (int i = 0; i < 8; ++i) nx += (bar_ld(grid.bar + 32 * 10 + i) != 0u) ? 1u : 0u;
    grid.nx = nx;
    grid.nloc = bar_ld(grid.bar + 32 * 10 + grid.x);
  }

#ifdef DELAYTEST
  {
    const unsigned long long t0 = wall_clock64();
    while (wall_clock64() - t0 < 200000ull) __builtin_amdgcn_s_sleep(8);
    __syncthreads();
    if (threadIdx.x == 0) __builtin_amdgcn_fence(__ATOMIC_ACQUIRE, "agent");
    asm volatile("s_waitcnt vmcnt(0)" ::: "memory");
    __syncthreads();
  }
#endif
#ifdef E2TEST
  {
    const u16* AHp = (const u16*)(ws + WS_AH);
    const u16* WTp = (const u16*)(ws + WS_WIN);
    for (size_t i = (size_t)bid * 256 + threadIdx.x; i < (size_t)NT * 1024; i += (size_t)nb * 256) P.out[OFF_Y + i] = bf2f(AHp[i]) * 1.2345678f + 0.1f;
    for (size_t i = (size_t)bid * 256 + threadIdx.x; i < (size_t)2 * NINP * 1024; i += (size_t)nb * 256) P.out[OFF_SCK + i] = bf2f(WTp[i]) * 1.2345678f + 0.001f;
    return;
  }
#endif
#pragma unroll 1
  for (int l = 0; l < 2; ++l) {
    {
      const u16* A = (const u16*)(ws + WS_AH);
      const u16* Bt = (const u16*)(ws + WS_WIN) + (size_t)l * NINP * 1024;
      for (int t = vbid; t < 132 * 21; t += nb) {
        const int rt = t / 21, ct = t % 21;
        if (PHM & 4) gemm_tile<EPI_IN>(P, l, A, 1024, Bt, 1024, 1024, XKS, rt * 128, ct * 128, smem);
      }
    }
    gsync(grid);
    if (STOPAT == 1) return;
    {
      const int N_SC = 256, N_SA = 256, N_AT = 4096, N_CS = 1024, N_SM = 1024, N_CP = 1952;
      const int tot = N_SC + N_SA + N_AT + N_CS + N_SM + N_CP;
      for (int it = bid; it < tot; it += nb) {
        int r = it;
        int lq = l;
        asm volatile("" : "+s"(lq));
        if (r < N_SC) { if (PHM & 8) sattn_item(P, lq, 1, r, smem); }
        else if ((r -= N_SC) < N_SA) { if (PHM & 8) sattn_item(P, lq, 0, r, smem); }
        else if ((r -= N_SA) < N_AT) { if (PHM & 16) attn_item(P, lq, r >> 10, r & 1023, smem); }
        else if ((r -= N_AT) < N_CS) { if (PHM & 32) ssd_cs_item(P, lq, r, smem); }
        else if ((r -= N_CS) < N_SM) { if (PHM & 64) smamba_item(P, lq, r, smem); }
        else { r -= N_SM; if (PHM & 128) copy_item(P, lq, r); }
      }
    }
    gsync(grid);
    if (STOPAT == 2) return;
    {
      for (int it = bid; it < 256 + 2048 + 800; it += nb) {
        if (it < 256) { if (PHM & 256) ssd_scan_item(P, l, it); }
        else if (it < 2304) { if (PHM & 256) cmerge_item(P, it - 256); }
        else copy_item(P, l, 1952 + (it - 2304));
      }
    }
    gsync(grid);
    if (STOPAT == 3) return;
    for (int k = 0;; ++k) {
      const int yi = bid + k * nb, ci = 2752 + bid + k * nb;
      if (yi >= 2048 && ci >= 4352) break;
      if (yi < 2048) ssd_y_item(P, l, yi, smem);
      if (ci < 4352) copy_item(P, l, ci);
    }
    gsync(grid);
    for (int it = bid; it < NT / 4; it += nb) mixnorm_item(P, it);
    gsync(grid);
    if (STOPAT == 4) return;
    {
      const u16* A = (const u16*)(ws + WS_MIX);
      const u16* Bt = (const u16*)(ws + WS_WOUT) + (size_t)l * 1024 * 1024;
      for (int t = vbid; t < 132 * 8; t += nb) {
        const int rt = t / 8, ct = t % 8;
        if (PHM & 1024) gemm_tile<EPI_OUT>(P, l, A, 1024, Bt, 1024, 1024, 0, rt * 128, ct * 128, smem);
      }
    }
    gsync(grid);
    if (STOPAT == 5) return;
    {
      const u16* A = (const u16*)(ws + WS_AH1);
      const u16* Bt = (const u16*)(ws + WS_WGU) + (size_t)l * 5632 * 1024;
      const int NCP = 0, NTL = 132 * 44;
      for (int it = vbid; it < NTL + NCP; it += nb) {
        int t;
        if (it < 2 * NCP) {
          if (!(it & 1)) { copy_item(P, l, it >> 1); continue; }
          t = it >> 1;
        } else t = it - NCP;
        const int rt = t / 44, ct = t % 44;
        if (PHM & 2048) gemm_tile<EPI_GU>(P, l, A, 1024, Bt, 1024, 1024, 1024, rt * 128, ct * 128, smem);
      }
    }
    gsync(grid);
    if (STOPAT == 6) return;
    {
      const u16* A = (const u16*)(ws + WS_G);
      const u16* Bt = (const u16*)(ws + WS_WDN) + (size_t)l * 1024 * DFF;
      for (int t = vbid; t < 132 * 8; t += nb) {
        const int rt = t / 8, ct = t % 8;
        if (PHM & 4096) gemm_tile<EPI_DN>(P, l, A, DFF, Bt, DFF, DFF, 0, rt * 128, ct * 128, smem);
      }
    }
    if (l == 0) gsync(grid);
  }
}

extern "C" void kernel_launch(void* const* d_in, const int* in_sizes, int n_in, void* d_out, int out_size, void* d_ws,
                              size_t ws_size, hipStream_t stream) {
  static int grid_blocks = 0;
  if (!grid_blocks) {
    int dev = 0, cus = 0, per_cu = 0;
    (void)hipGetDevice(&dev);
    (void)hipDeviceGetAttribute(&cus, hipDeviceAttributeMultiprocessorCount, dev);
    (void)hipFuncSetAttribute((const void*)hymba_megakernel, hipFuncAttributeMaxDynamicSharedMemorySize, LDS_BYTES);
    (void)hipOccupancyMaxActiveBlocksPerMultiprocessor(&per_cu, hymba_megakernel, 256, LDS_BYTES);
    if (per_cu < 1) per_cu = 1;
    if (per_cu > 2) per_cu = 2;
    grid_blocks = cus * per_cu;
  }
  Params p{};
  for (int i = 0; i < 26; ++i) p.in[i] = (const float*)d_in[i];
  p.out = (float*)d_out;
  p.ws = (unsigned char*)d_ws;
  (void)hipMemsetAsync((unsigned char*)d_ws + WS_BAR, 0, 2048, stream);
  void* args[] = {&p};
  hipError_t e = hipLaunchCooperativeKernel((void*)hymba_megakernel, dim3(grid_blocks), dim3(256), args, LDS_BYTES, stream);
  if (e != hipSuccess) fprintf(stderr, "cooperative launch failed: %s (grid %d)\n", hipGetErrorString(e), grid_blocks);
}
```

```cpp
#include <hip/hip_runtime.h>
#include <hip/hip_bf16.h>
#include <hip/hip_cooperative_groups.h>
#include <cstdio>
namespace cg = cooperative_groups;

typedef unsigned short u16;
using bf16x8 = __attribute__((ext_vector_type(8))) short;
using f32x4 = __attribute__((ext_vector_type(4))) float;
using u32x4 = __attribute__((ext_vector_type(4))) unsigned int;
#define DEVI __device__ __forceinline__

constexpr int DM = 1024, SEQ = 16384, NSAMP = 512, NT = SEQ + NSAMP, NB = 128;
constexpr int NINP = 2688, NIN = 2568, DFF = 2816;
constexpr float EPS = 1e-6f;
constexpr int LDS_BYTES = 73728;
#ifndef XKS
#define XKS 1024
#endif
#ifndef RSOFF
#define RSOFF 0
#endif
#ifndef OUTMASK
#define OUTMASK 0xff
#endif
#ifndef STOPAT
#define STOPAT 0
#endif
#ifndef PHM
#define PHM 0xffff
#endif

constexpr size_t OFF_Y = 0;
constexpr size_t OFF_PAK = (size_t)NT * DM;
constexpr size_t OFF_PAV = OFF_PAK + 32768;
constexpr size_t OFF_PCK = OFF_PAV + 32768;
constexpr size_t OFF_PCV = OFF_PCK + 524288;
constexpr size_t OFF_PSSM = OFF_PCV + 524288;
constexpr size_t OFF_PCONV = OFF_PSSM + 131072;
constexpr size_t OFF_SAK = OFF_PCONV + 6144;
constexpr size_t OFF_SAV = OFF_SAK + 4194304;
constexpr size_t OFF_SCK = OFF_SAV + 4194304;
constexpr size_t OFF_SCV = OFF_SCK + 67108864;
constexpr size_t OFF_SSSM = OFF_SCV + 67108864;
constexpr size_t OFF_SCONV = OFF_SSSM + 16777216;

constexpr size_t al256(size_t x) { return (x + 255) & ~(size_t)255; }
constexpr size_t WS_WIN = 0;
constexpr size_t WS_WOUT = WS_WIN + al256((size_t)2 * NINP * 1024 * 2);
constexpr size_t WS_WGU = WS_WOUT + al256((size_t)2 * 1024 * 1024 * 2);
constexpr size_t WS_WDN = WS_WGU + al256((size_t)2 * 5632 * 1024 * 2);
constexpr size_t WS_AH = WS_WDN + al256((size_t)2 * 1024 * 2816 * 2);
constexpr size_t WS_AH1 = WS_AH + al256((size_t)NT * 1024 * 2);
constexpr size_t WS_HF = WS_AH1 + al256((size_t)NT * 1024 * 2);
constexpr size_t WS_H1 = WS_HF + al256((size_t)NT * 1024 * 4);
constexpr size_t WS_QKV = WS_H1 + al256((size_t)NT * 1024 * 4);
constexpr size_t WS_Z = WS_QKV + al256((size_t)NT * 1024 * 2);
constexpr size_t WS_XBC = WS_Z + al256((size_t)NT * 512 * 2);
constexpr size_t WS_DT = WS_XBC + al256((size_t)NT * 1024 * 2);
constexpr size_t WS_G = WS_DT + al256((size_t)NT * 8 * 4);
constexpr size_t WS_MIX = WS_G + al256((size_t)NT * DFF * 2);
constexpr size_t WS_CO = WS_MIX + al256((size_t)NT * 1024 * 2);
constexpr size_t WS_LSE = WS_CO + al256((size_t)3 * SEQ * 256 * 2);
constexpr size_t WS_CS = WS_LSE + al256((size_t)3 * SEQ * 4 * 4);
constexpr size_t WS_CD = WS_CS + al256((size_t)128 * 65536 * 4);
constexpr size_t WS_HIN = WS_CD + al256((size_t)128 * 8 * 4);
constexpr size_t WS_ROPE = WS_HIN + al256((size_t)128 * 65536 * 2);
constexpr size_t WS_BAR = WS_ROPE + al256((size_t)16388 * 16 * 4);
constexpr size_t WS_END = WS_BAR + 2048;

struct Params {
  const float* in[26];
  float* out;
  unsigned char* ws;
};
enum { I_XP = 0, I_XS, I_CAK, I_CAV, I_CCK, I_CCV, I_SSM, I_SCONV, I_NORM1, I_WIN, I_AQN, I_AKN, I_SINK, I_CQN, I_CKN,
       I_CONVW, I_CONVB, I_DTB, I_ALOG, I_DSKIP, I_SSMN, I_WOUT, I_NORM2, I_WGATE, I_WUP, I_WDOWN };

DEVI int opaque_tid() { int t = threadIdx.x; asm volatile("" : "+v"(t)); return t; }
DEVI u16 f2bf(float f) { unsigned u = __float_as_uint(f); u += 0x7fffu + ((u >> 16) & 1u); return (u16)(u >> 16); }
DEVI float bf2f(u16 h) { return __uint_as_float(((unsigned)h) << 16); }
DEVI unsigned pack2(float a, float b) { return (unsigned)f2bf(a) | ((unsigned)f2bf(b) << 16); }
DEVI float siluf(float x) { return x / (1.f + __expf(-x)); }
DEVI float softplusf(float x) { return x > 20.f ? x : log1pf(__expf(x)); }
DEVI float bflo(unsigned u) { return __uint_as_float(u << 16); }
DEVI float bfhi(unsigned u) { return __uint_as_float(u & 0xffff0000u); }
DEVI u32x4 gload16_async(const void* p) {
  u32x4 v;
  asm volatile("global_load_dwordx4 %0, %1, off" : "=v"(v) : "v"(p) : "memory");
  return v;
}
DEVI void gwait8(u32x4& a0, u32x4& a1, u32x4& a2, u32x4& a3, u32x4& b0, u32x4& b1, u32x4& b2, u32x4& b3) {
  asm volatile("s_waitcnt vmcnt(0)" : "+v"(a0), "+v"(a1), "+v"(a2), "+v"(a3), "+v"(b0), "+v"(b1), "+v"(b2), "+v"(b3) : : "memory");
}
DEVI float sumsq8(u32x4 v) {
  float s = 0.f, t;
  t = bflo(v.x); s += t * t; t = bfhi(v.x); s += t * t;
  t = bflo(v.y); s += t * t; t = bfhi(v.y); s += t * t;
  t = bflo(v.z); s += t * t; t = bfhi(v.z); s += t * t;
  t = bflo(v.w); s += t * t; t = bfhi(v.w); s += t * t;
  return s;
}
DEVI float wave_max(float v) {
#pragma unroll
  for (int o = 32; o >= 1; o >>= 1) v = fmaxf(v, __shfl_xor(v, o));
  return v;
}
DEVI float wave_sum(float v) {
#pragma unroll
  for (int o = 32; o >= 1; o >>= 1) v += __shfl_xor(v, o);
  return v;
}
DEVI f32x4 mfma16(bf16x8 a, bf16x8 b, f32x4 c) { return __builtin_amdgcn_mfma_f32_16x16x32_bf16(a, b, c, 0, 0, 0); }

enum { EPI_IN = 0, EPI_OUT = 1, EPI_GU = 2, EPI_DN = 3 };

DEVI uint2 pack4(float a, float b, float c, float d) { uint2 o; o.x = pack2(a, b); o.y = pack2(c, d); return o; }

template <int EPI>
DEVI void gemm_epilogue(const Params& P, int l, f32x4 (&acc)[4][4], float (&scv)[4], int row0, int col0, int wm, int wn, int fr, int fq) {
  unsigned char* ws = P.ws;
  if (EPI == EPI_IN) {
    const int cb = col0 + wn * 64;
    if (cb < 1024) {
      u16* QKV = (u16*)(ws + WS_QKV);
      const float* ROPE = (const float*)(ws + WS_ROPE);
      const int hh = cb >> 6;
      const bool isv = (hh == 6 || hh == 7 || hh == 14 || hh == 15);
      const float* gain = P.in[I_AQN];
      if (hh >= 4 && hh < 6) gain = P.in[I_AKN];
      else if (hh >= 8 && hh < 12) gain = P.in[I_CQN];
      else if (hh >= 12) gain = P.in[I_CKN];
      gain += l * 64;
      float gv[4][4];
#pragma unroll
      for (int ni = 0; ni < 4; ++ni)
#pragma unroll
        for (int r = 0; r < 4; ++r) gv[ni][r] = isv ? 1.f : gain[ni * 16 + fq * 4 + r];
      const int kind = (hh == 4 || hh == 5) ? 1 : (hh == 6 || hh == 7) ? 2 : (hh == 12 || hh == 13) ? 3 : (hh >= 14) ? 4 : 0;
      const int kvh = hh & 1;
#pragma unroll
      for (int mi = 0; mi < 4; ++mi) {
        const int row = row0 + wm * 64 + mi * 16 + fr;
        float v[4][4];
        float ss = 0.f;
#pragma unroll
        for (int ni = 0; ni < 4; ++ni)
#pragma unroll
          for (int r = 0; r < 4; ++r) { v[ni][r] = acc[mi][ni][r] * scv[mi]; ss += v[ni][r] * v[ni][r]; }
        if (!isv) {
          ss += __shfl_xor(ss, 16); ss += __shfl_xor(ss, 32);
          const float sc = rsqrtf(ss * (1.f / 64.f) + EPS);
#pragma unroll
          for (int ni = 0; ni < 4; ++ni)
#pragma unroll
            for (int r = 0; r < 4; ++r) v[ni][r] *= sc * gv[ni][r];
          const int pos = row < SEQ ? row : SEQ + ((row - SEQ) & 3);
#pragma unroll
          for (int r = 0; r < 4; ++r) {
            const float partner = __shfl_xor(v[0][r], 32);
            const int i = (fq & 1) * 4 + r;
            const float cs = ROPE[pos * 16 + i], sn = ROPE[pos * 16 + 8 + i];
            v[0][r] = (fq < 2) ? (v[0][r] * cs - partner * sn) : (v[0][r] * cs + partner * sn);
          }
        }
#pragma unroll
        for (int ni = 0; ni < 4; ++ni)
          *(uint2*)(QKV + (size_t)row * 1024 + cb + ni * 16 + fq * 4) = pack4(v[ni][0], v[ni][1], v[ni][2], v[ni][3]);
        if (kind) {
          size_t base = 0;
          bool ok = false;
          if (kind <= 2) {
            if (row >= SEQ) {
              const int sb = (row - SEQ) >> 2, t = (row - SEQ) & 3;
              base = (kind == 1 ? OFF_SAK : OFF_SAV) + ((((size_t)(l * 128 + sb) * 128 + 124 + t) * 2 + kvh) * 64);
              ok = true;
            } else if (row >= SEQ - 128) {
              base = (kind == 1 ? OFF_PAK : OFF_PAV) + (((size_t)(l * 128 + (row - (SEQ - 128))) * 2 + kvh) * 64);
              ok = true;
            }
          } else {
            if (row >= SEQ) {
              const int sb = (row - SEQ) >> 2, t = (row - SEQ) & 3;
              base = (kind == 3 ? OFF_SCK : OFF_SCV) + ((((size_t)(l * 128 + sb) * 2048 + 2044 + t) * 2 + kvh) * 64);
              ok = true;
            } else if (row >= SEQ - 2048) {
              base = (kind == 3 ? OFF_PCK : OFF_PCV) + (((size_t)(l * 2048 + (row - (SEQ - 2048))) * 2 + kvh) * 64);
              ok = true;
            }
          }
          if (ok) {
#pragma unroll
            for (int ni = 0; ni < 4; ++ni)
              *(float4*)(P.out + base + ni * 16 + fq * 4) = make_float4(v[ni][0], v[ni][1], v[ni][2], v[ni][3]);
          }
        }
      }
    } else if (cb < 1536) {
      u16* Z = (u16*)(ws + WS_Z);
#pragma unroll
      for (int mi = 0; mi < 4; ++mi) {
        const int row = row0 + wm * 64 + mi * 16 + fr;
        const float sc = scv[mi];
#pragma unroll
        for (int ni = 0; ni < 4; ++ni)
          *(uint2*)(Z + (size_t)row * 512 + (cb - 1024) + ni * 16 + fq * 4) =
              pack4(acc[mi][ni][0] * sc, acc[mi][ni][1] * sc, acc[mi][ni][2] * sc, acc[mi][ni][3] * sc);
      }
    } else if (cb < 2560) {
      u16* XBC = (u16*)(ws + WS_XBC);
#pragma unroll
      for (int mi = 0; mi < 4; ++mi) {
        const int row = row0 + wm * 64 + mi * 16 + fr;
        const float sc = scv[mi];
        size_t cbase = 0;
        bool ok = false;
        if (row >= SEQ) {
          const int sb = (row - SEQ) >> 2, t = (row - SEQ) & 3;
          if (t >= 1) { ok = true; cbase = OFF_SCONV + ((size_t)(l * 128 + sb) * 3 + (t - 1)) * 1024; }
        } else if (row >= SEQ - 3) {
          ok = true; cbase = OFF_PCONV + (size_t)(l * 3 + (row - (SEQ - 3))) * 1024;
        }
#pragma unroll
        for (int ni = 0; ni < 4; ++ni) {
          const int ch = (cb - 1536) + ni * 16 + fq * 4;
          const float x0 = acc[mi][ni][0] * sc, x1 = acc[mi][ni][1] * sc, x2 = acc[mi][ni][2] * sc, x3 = acc[mi][ni][3] * sc;
          *(uint2*)(XBC + (size_t)row * 1024 + ch) = pack4(x0, x1, x2, x3);
          if (ok) *(float4*)(P.out + cbase + ch) = make_float4(x0, x1, x2, x3);
        }
      }
    } else if (cb == 2560) {
      float* DT = (float*)(ws + WS_DT);
      if (fq < 2) {
#pragma unroll
        for (int mi = 0; mi < 4; ++mi) {
          const int row = row0 + wm * 64 + mi * 16 + fr;
          const float sc = scv[mi];
          *(float4*)(DT + (size_t)row * 8 + fq * 4) = make_float4(acc[mi][0][0] * sc, acc[mi][0][1] * sc, acc[mi][0][2] * sc, acc[mi][0][3] * sc);
        }
      }
    }
  } else if (EPI == EPI_OUT) {
    float* H1 = (float*)(ws + WS_H1);
    u16* AH1 = (u16*)(ws + WS_AH1);
    const float* HF = (const float*)(ws + WS_HF);
#pragma unroll
    for (int mi = 0; mi < 4; ++mi) {
      const int row = row0 + wm * 64 + mi * 16 + fr;
      const float* res = (row < SEQ ? P.in[I_XP] + (size_t)row * 1024 : P.in[I_XS] + (size_t)(row - SEQ) * 1024);
      const u16* resb = (const u16*)(ws + WS_AH) + (size_t)row * 1024;
#pragma unroll
      for (int ni = 0; ni < 4; ++ni) {
        const int col = col0 + wn * 64 + ni * 16 + fq * 4;
        const uint2 rb = *(const uint2*)(resb + col);
        const float4 rv = make_float4(bflo(rb.x), bfhi(rb.x), bflo(rb.y), bfhi(rb.y));
        const float h0 = rv.x + acc[mi][ni][0], h1 = rv.y + acc[mi][ni][1], h2 = rv.z + acc[mi][ni][2], h3 = rv.w + acc[mi][ni][3];
        *(uint2*)(AH1 + (size_t)row * 1024 + col) = pack4(h0, h1, h2, h3);
      }
    }
  } else if (EPI == EPI_GU) {
    u16* G = (u16*)(ws + WS_G);
#pragma unroll
    for (int mi = 0; mi < 4; ++mi) {
      const int row = row0 + wm * 64 + mi * 16 + fr;
      const float sc = scv[mi];
#pragma unroll
      for (int q = 0; q < 2; ++q) {
        const int j = ((col0 + wn * 64) >> 1) + q * 16 + fq * 4;
        float o[4];
#pragma unroll
        for (int r = 0; r < 4; ++r) o[r] = siluf(acc[mi][2 * q][r] * sc) * (acc[mi][2 * q + 1][r] * sc);
        *(uint2*)(G + (size_t)row * DFF + j) = pack4(o[0], o[1], o[2], o[3]);
      }
    }
  } else {
    const float* H1 = (const float*)(ws + WS_H1);
    float* HF = (float*)(ws + WS_HF);
    u16* AH = (u16*)(ws + WS_AH);
#pragma unroll
    for (int mi = 0; mi < 4; ++mi) {
      const int row = row0 + wm * 64 + mi * 16 + fr;
#pragma unroll
      for (int ni = 0; ni < 4; ++ni) {
        const int col = col0 + wn * 64 + ni * 16 + fq * 4;
        const uint2 rb = *(const uint2*)((const u16*)(ws + WS_AH1) + (size_t)row * 1024 + col);
        const float4 rv = make_float4(bflo(rb.x), bfhi(rb.x), bflo(rb.y), bfhi(rb.y));
        const float h0 = rv.x + acc[mi][ni][0], h1 = rv.y + acc[mi][ni][1], h2 = rv.z + acc[mi][ni][2], h3 = rv.w + acc[mi][ni][3];
        if (l == 0) {
          *(uint2*)(AH + (size_t)row * 1024 + col) = pack4(h0, h1, h2, h3);
        } else {
          *(float4*)(P.out + OFF_Y + (size_t)row * 1024 + col) = make_float4(h0, h1, h2, h3);
        }
      }
    }
  }
}

template <int EPI>
DEVI void gemm_tile(const Params& P, int l, const u16* __restrict__ A, int lda, const u16* __restrict__ Bt, int ldb,
                          int K, int KS, int row0, int col0, unsigned char* smem) {
  const int tid = opaque_tid(), lane = tid & 63, w = tid >> 6, wm = w >> 1, wn = w & 1;
  const int fr = lane & 15, fq = lane >> 4;
  f32x4 acc[4][4];
#pragma unroll
  for (int mi = 0; mi < 4; ++mi)
#pragma unroll
    for (int ni = 0; ni < 4; ++ni) acc[mi][ni] = (f32x4){0.f, 0.f, 0.f, 0.f};
  const int lrow = tid >> 3, lch = tid & 7;
  const int gch = lch ^ (lrow & 7);
  const u16* Ag = A + (size_t)(row0 + lrow) * lda + gch * 8;
  const u16* Bg = Bt + (size_t)(col0 + lrow) * ldb + gch * 8;
  unsigned char* ldsT = smem + tid * 16;
  f32x4 gr0 = (f32x4){0.f, 0.f, 0.f, 0.f}, gr1 = gr0;
  float scv[4] = {1.f, 1.f, 1.f, 1.f};
  const int nk = K >> 6;
  const int ksS = (KS >> 6) - 1;
#pragma unroll
  for (int i = 0; i < 4; ++i) {
    __builtin_amdgcn_global_load_lds((const unsigned*)(Ag + (size_t)(32 * i) * lda), (unsigned*)(ldsT + i * 4096), 16, 0, 0);
    __builtin_amdgcn_global_load_lds((const unsigned*)(Bg + (size_t)(32 * i) * ldb), (unsigned*)(ldsT + 16384 + i * 4096), 16, 0, 0);
  }
  asm volatile("s_waitcnt vmcnt(0)" ::: "memory");
  __syncthreads();
#pragma unroll 2
  for (int ks = 0; ks < nk; ++ks) {
    const bool more = (ks + 1 < nk);
    if (more) {
      unsigned char* dst = ldsT + ((ks + 1) & 1) * 32768;
#pragma unroll
      for (int i = 0; i < 4; ++i) {
        __builtin_amdgcn_global_load_lds((const unsigned*)(Ag + (size_t)(32 * i) * lda + (ks + 1) * 64), (unsigned*)(dst + i * 4096), 16, 0, 0);
        __builtin_amdgcn_global_load_lds((const unsigned*)(Bg + (size_t)(32 * i) * ldb + (ks + 1) * 64), (unsigned*)(dst + 16384 + i * 4096), 16, 0, 0);
      }
    }
    const unsigned char* As = smem + (ks & 1) * 32768;
    const unsigned char* Bs = As + 16384;
#pragma unroll
    for (int kk = 0; kk < 2; ++kk) {
      bf16x8 af[4], bq[4];
#pragma unroll
      for (int mi = 0; mi < 4; ++mi) {
        const int row = wm * 64 + mi * 16 + fr;
        af[mi] = *(const bf16x8*)(As + row * 128 + (((kk * 4 + fq) ^ (row & 7)) << 4));
      }
#pragma unroll
      for (int ni = 0; ni < 4; ++ni) {
        const int row = wn * 64 + ni * 16 + fr;
        bq[ni] = *(const bf16x8*)(Bs + row * 128 + (((kk * 4 + fq) ^ (row & 7)) << 4));
      }
      if (ks <= ksS) {
        if (wn == 0) { gr0 = mfma16(af[0], af[0], gr0); gr1 = mfma16(af[1], af[1], gr1); }
        else { gr0 = mfma16(af[2], af[2], gr0); gr1 = mfma16(af[3], af[3], gr1); }
      }
      __builtin_amdgcn_s_setprio(1);
#pragma unroll
      for (int mi = 0; mi < 4; ++mi)
#pragma unroll
        for (int ni = 0; ni < 4; ++ni) acc[mi][ni] = mfma16(bq[ni], af[mi], acc[mi][ni]);
      __builtin_amdgcn_s_setprio(0);
    }
    float* rsL = (float*)(smem + ((ks + 1) & 1) * 32768);
    if (ks == ksS) {
      if ((fr >> 2) == fq) {
        const int r = fr & 3;
        const float d0 = r == 0 ? gr0[0] : r == 1 ? gr0[1] : r == 2 ? gr0[2] : gr0[3];
        const float d1 = r == 0 ? gr1[0] : r == 1 ? gr1[1] : r == 2 ? gr1[2] : gr1[3];
        rsL[wm * 64 + (wn * 2) * 16 + fr] = rsqrtf(d0 / (float)KS + EPS);
        rsL[wm * 64 + (wn * 2 + 1) * 16 + fr] = rsqrtf(d1 / (float)KS + EPS);
      }
    }
    asm volatile("s_waitcnt vmcnt(0)" ::: "memory");
    __syncthreads();
    if (ks == ksS) {
#pragma unroll
      for (int mi = 0; mi < 4; ++mi) scv[mi] = rsL[wm * 64 + mi * 16 + fr];
      __syncthreads();
    }
  }
  gemm_epilogue<EPI>(P, l, acc, scv, row0, col0, wm, wn, fr, fq);
}

DEVI void wconv_item(const Params& P, int mode, int l, int kt, int nt, unsigned char* smem) {
  float* tile = (float*)smem;
  const int tid = opaque_tid();
  const float* src; int ldsrc, Nsrc; u16* dst; int lddst;
  const float* gain = nullptr;
  unsigned char* ws = P.ws;
  if (mode == 0) { src = P.in[I_WIN] + (size_t)l * 1024 * NIN; ldsrc = NIN; Nsrc = NIN; dst = (u16*)(ws + WS_WIN) + (size_t)l * NINP * 1024; lddst = 1024; gain = P.in[I_NORM1] + l * 1024; }
  else if (mode == 1) { src = P.in[I_WOUT] + (size_t)l * 1024 * 1024; ldsrc = 1024; Nsrc = 1024; dst = (u16*)(ws + WS_WOUT) + (size_t)l * 1024 * 1024; lddst = 1024; }
  else if (mode == 2) { src = P.in[I_WGATE] + (size_t)l * 1024 * DFF; ldsrc = DFF; Nsrc = DFF; dst = (u16*)(ws + WS_WGU) + (size_t)l * 5632 * 1024; lddst = 1024; gain = P.in[I_NORM2] + l * 1024; }
  else if (mode == 3) { src = P.in[I_WUP] + (size_t)l * 1024 * DFF; ldsrc = DFF; Nsrc = DFF; dst = (u16*)(ws + WS_WGU) + (size_t)l * 5632 * 1024; lddst = 1024; gain = P.in[I_NORM2] + l * 1024; }
  else { src = P.in[I_WDOWN] + (size_t)l * DFF * 1024; ldsrc = 1024; Nsrc = 1024; dst = (u16*)(ws + WS_WDN) + (size_t)l * 1024 * DFF; lddst = DFF; }
  const int k0 = kt * 64, n0 = nt * 64;
  {
    const int j = tid & 63, ig = tid >> 6;
    const int n = n0 + j;
#pragma unroll
    for (int ii = 0; ii < 16; ++ii) {
      const int i = ig * 16 + ii, k = k0 + i;
      float v = 0.f;
      if (n < Nsrc) {
        v = src[(size_t)k * ldsrc + n];
        if (mode == 1) { if (k >= 256 && k < 768) v *= P.in[I_SSMN][l * 512 + (k - 256)]; }
        else if (gain) v *= gain[k];
      }
      tile[i * 65 + j] = v;
    }
  }
  __syncthreads();
  {
    const int i8 = tid & 7;
    int kd = k0 + i8 * 8;
    if (mode == 1) kd = (kd < 256) ? kd + 512 : (kd < 768 ? kd - 256 : kd);
#pragma unroll
    for (int jj = 0; jj < 2; ++jj) {
      const int j = (tid >> 3) + 32 * jj;
      const int n = n0 + j;
      int nd = n;
      if (mode == 2) nd = ((n >> 4) << 5) + (n & 15);
      else if (mode == 3) nd = ((n >> 4) << 5) + (n & 15) + 16;
      uint4 o;
      o.x = pack2(tile[(i8 * 8 + 0) * 65 + j], tile[(i8 * 8 + 1) * 65 + j]);
      o.y = pack2(tile[(i8 * 8 + 2) * 65 + j], tile[(i8 * 8 + 3) * 65 + j]);
      o.z = pack2(tile[(i8 * 8 + 4) * 65 + j], tile[(i8 * 8 + 5) * 65 + j]);
      o.w = pack2(tile[(i8 * 8 + 6) * 65 + j], tile[(i8 * 8 + 7) * 65 + j]);
      *(uint4*)(dst + (size_t)nd * lddst + kd) = o;
    }
  }
  __syncthreads();
}

DEVI void xconv_item(const Params& P, int item) {
  u16* AH = (u16*)(P.ws + WS_AH);
#pragma unroll
  for (int i = 0; i < 4; ++i) {
    const size_t e = ((size_t)item * 1024 + i * 256 + threadIdx.x) * 8;
    const float* src = (e < (size_t)SEQ * 1024) ? P.in[I_XP] + e : P.in[I_XS] + (e - (size_t)SEQ * 1024);
    const float4 a = *(const float4*)src, b = *(const float4*)(src + 4);
    uint4 o;
    o.x = pack2(a.x, a.y); o.y = pack2(a.z, a.w); o.z = pack2(b.x, b.y); o.w = pack2(b.z, b.w);
    *(uint4*)(AH + e) = o;
  }
}

DEVI void rope_item(const Params& P, int item) {
  const int e = item * 256 + threadIdx.x;
  if (e >= 16388 * 8) return;
  const int pos = e >> 3, i = e & 7;
  const double inv[8] = {1.0, 0.19392274474868576, 0.03760603093086393, 0.007292664737217109,
                         0.001414213562373095, 0.0002742481756762073, 5.318295896944988e-05, 1.031338537721246e-05};
  double invv = inv[0];
#pragma unroll
  for (int q = 1; q < 8; ++q) invv = (i == q) ? inv[q] : invv;
  const double ang = (double)pos * invv;
  const double n = rint(ang * 0.15915494309189535);
  double r = fma(-n, 6.283185307179586, ang);
  r = fma(-n, 2.4492935982947064e-16, r);
  const double r2 = r * r;
  double S = 1.0, C = 1.0;
#pragma unroll
  for (int k = 14; k >= 1; --k) {
    S = 1.0 - r2 * (1.0 / ((2.0 * k) * (2.0 * k + 1.0))) * S;
    C = 1.0 - r2 * (1.0 / ((2.0 * k - 1.0) * (2.0 * k))) * C;
  }
  float* ROPE = (float*)(P.ws + WS_ROPE);
  ROPE[pos * 16 + i] = (float)C;
  ROPE[pos * 16 + 8 + i] = (float)(r * S);
}

DEVI void attn_item(const Params& P, int l, int variant, int idx, unsigned char* smem) {
  const int tid = opaque_tid(), lane = tid & 63, w = tid >> 6, fr = lane & 15, fq = lane >> 4;
  const int h = idx & 3, qb = idx >> 2;
  const int dil = (variant <= 1) ? 1 : (variant == 2 ? 4 : 16);
  const int maxd = (variant == 0) ? 127 : 128;
  const int nbr = SEQ / dil / 64;
  const int res = qb / nbr, ib = qb % nbr;
  const int i0 = ib * 64;
  const int qofs = (variant == 0 ? 0 : 512) + h * 64;
  const int kofs = (variant == 0 ? 256 : 768) + (h >> 1) * 64;
  const int vofs = kofs + 128;
  const u16* QKV = (const u16*)(P.ws + WS_QKV);
  u16* Qs = (u16*)smem;
  u16* Ks = (u16*)(smem + 9216);
  u16* Vt = (u16*)(smem + 9216 + 27648);
  u16* Ps = Ks;
  {
    const int r = tid >> 2, c = (tid & 3) * 16;
    {
      const size_t pos = (size_t)res + (size_t)dil * (i0 + r);
      const uint4* g = (const uint4*)(QKV + pos * 1024 + qofs + c);
      const uint4 a = g[0], b = g[1];
      *(uint4*)(Qs + r * 72 + c) = a;
      *(uint4*)(Qs + r * 72 + c + 8) = b;
    }
#pragma unroll
    for (int pss = 0; pss < 3; ++pss) {
      const int kk = pss * 64 + r;
      const int ik = i0 - 128 + kk;
      uint4 a = make_uint4(0, 0, 0, 0), b = a, va = a, vb = a;
      if (ik >= 0) {
        const size_t pos = (size_t)res + (size_t)dil * ik;
        const uint4* g = (const uint4*)(QKV + pos * 1024 + kofs + c);
        a = g[0]; b = g[1];
        const uint4* gv = (const uint4*)(QKV + pos * 1024 + vofs + c);
        va = gv[0]; vb = gv[1];
      }
      *(uint4*)(Ks + kk * 72 + c) = a;
      *(uint4*)(Ks + kk * 72 + c + 8) = b;
      const unsigned vv[8] = {va.x, va.y, va.z, va.w, vb.x, vb.y, vb.z, vb.w};
#pragma unroll
      for (int e = 0; e < 8; ++e) {
        Vt[(c + 2 * e) * 200 + kk] = (u16)(vv[e] & 0xffffu);
        Vt[(c + 2 * e + 1) * 200 + kk] = (u16)(vv[e] >> 16);
      }
    }
  }
  __syncthreads();
  f32x4 s[12];
  {
    bf16x8 qa[2];
#pragma unroll
    for (int kk = 0; kk < 2; ++kk) qa[kk] = *(const bf16x8*)(Qs + (w * 16 + fr) * 72 + kk * 32 + fq * 8);
#pragma unroll
    for (int kb = 0; kb < 12; ++kb) {
      f32x4 a = (f32x4){0.f, 0.f, 0.f, 0.f};
#pragma unroll
      for (int kk = 0; kk < 2; ++kk) {
        const bf16x8 kf = *(const bf16x8*)(Ks + (kb * 16 + fr) * 72 + kk * 32 + fq * 8);
        a = mfma16(kf, qa[kk], a);
      }
      s[kb] = a;
    }
  }
  float sink = 0.f;
  if (variant == 0) sink = P.in[I_SINK][l * 4 + h];
  const int iq = i0 + w * 16 + fr;
  float mx = -INFINITY;
#pragma unroll
  for (int kb = 0; kb < 12; ++kb)
#pragma unroll
    for (int r = 0; r < 4; ++r) {
      const int ik = i0 - 128 + kb * 16 + fq * 4 + r;
      const int dist = iq - ik;
      const bool valid = (dist >= 0) && (dist <= maxd) && (ik >= 0);
      const float v = valid ? s[kb][r] * 0.125f : -INFINITY;
      s[kb][r] = v;
      mx = fmaxf(mx, v);
    }
  mx = fmaxf(mx, __shfl_xor(mx, 16)); mx = fmaxf(mx, __shfl_xor(mx, 32));
  if (variant == 0) mx = fmaxf(mx, sink);
  float den = 0.f;
#pragma unroll
  for (int kb = 0; kb < 12; ++kb)
#pragma unroll
    for (int r = 0; r < 4; ++r) {
      const float e = __expf(s[kb][r] - mx);
      s[kb][r] = e;
      den += e;
    }
  den += __shfl_xor(den, 16); den += __shfl_xor(den, 32);
  if (variant == 0) den += __expf(sink - mx);
  __syncthreads();
#pragma unroll
  for (int kb = 0; kb < 12; ++kb)
    *(uint2*)(Ps + (w * 16 + fr) * 200 + kb * 16 + fq * 4) = pack4(s[kb][0], s[kb][1], s[kb][2], s[kb][3]);
  __syncthreads();
  f32x4 o[4];
#pragma unroll
  for (int nb = 0; nb < 4; ++nb) o[nb] = (f32x4){0.f, 0.f, 0.f, 0.f};
#pragma unroll
  for (int ks = 0; ks < 6; ++ks) {
    const bf16x8 pa = *(const bf16x8*)(Ps + (w * 16 + fr) * 200 + ks * 32 + fq * 8);
#pragma unroll
    for (int nb = 0; nb < 4; ++nb) {
      const bf16x8 vf = *(const bf16x8*)(Vt + (nb * 16 + fr) * 200 + ks * 32 + fq * 8);
      o[nb] = mfma16(vf, pa, o[nb]);
    }
  }
  {
    const size_t pos = (size_t)res + (size_t)dil * iq;
    const float inv = 1.f / den;
    if (variant == 0) {
      u16* MIX = (u16*)(P.ws + WS_MIX);
#pragma unroll
      for (int nb = 0; nb < 4; ++nb)
        *(uint2*)(MIX + pos * 1024 + 512 + h * 64 + nb * 16 + fq * 4) = pack4(o[nb][0] * inv, o[nb][1] * inv, o[nb][2] * inv, o[nb][3] * inv);
    } else {
      u16* CO = (u16*)(P.ws + WS_CO) + (size_t)(variant - 1) * SEQ * 256;
#pragma unroll
      for (int nb = 0; nb < 4; ++nb)
        *(uint2*)(CO + pos * 256 + h * 64 + nb * 16 + fq * 4) = pack4(o[nb][0] * inv, o[nb][1] * inv, o[nb][2] * inv, o[nb][3] * inv);
      if (fq == 0) {
        float* LSE = (float*)(P.ws + WS_LSE) + (size_t)(variant - 1) * SEQ * 4;
        LSE[pos * 4 + h] = mx + __logf(den);
      }
    }
  }
  __syncthreads();
}

DEVI void cmerge_item(const Params& P, int item) {
  const int tid = opaque_tid();
  const int tok = item * 8 + (tid >> 5), ch = tid & 31;
  const int h = ch >> 3;
  const float* LSE = (const float*)(P.ws + WS_LSE);
  const u16* CO = (const u16*)(P.ws + WS_CO);
  const float l0 = LSE[(size_t)tok * 4 + h], l1 = LSE[(size_t)(SEQ + tok) * 4 + h], l2 = LSE[(size_t)(2 * SEQ + tok) * 4 + h];
  const float mx = fmaxf(l0, fmaxf(l1, l2));
  float w0 = __expf(l0 - mx), w1 = __expf(l1 - mx), w2 = __expf(l2 - mx);
  const float inv = 1.f / (w0 + w1 + w2);
  w0 *= inv; w1 *= inv; w2 *= inv;
  const uint4 a = *(const uint4*)(CO + (size_t)tok * 256 + ch * 8);
  const uint4 b = *(const uint4*)(CO + ((size_t)SEQ + tok) * 256 + ch * 8);
  const uint4 c = *(const uint4*)(CO + ((size_t)2 * SEQ + tok) * 256 + ch * 8);
  uint4 o;
  o.x = pack2(w0 * bflo(a.x) + w1 * bflo(b.x) + w2 * bflo(c.x), w0 * bfhi(a.x) + w1 * bfhi(b.x) + w2 * bfhi(c.x));
  o.y = pack2(w0 * bflo(a.y) + w1 * bflo(b.y) + w2 * bflo(c.y), w0 * bfhi(a.y) + w1 * bfhi(b.y) + w2 * bfhi(c.y));
  o.z = pack2(w0 * bflo(a.z) + w1 * bflo(b.z) + w2 * bflo(c.z), w0 * bfhi(a.z) + w1 * bfhi(b.z) + w2 * bfhi(c.z));
  o.w = pack2(w0 * bflo(a.w) + w1 * bflo(b.w) + w2 * bflo(c.w), w0 * bfhi(a.w) + w1 * bfhi(b.w) + w2 * bfhi(c.w));
  u16* MIX = (u16*)(P.ws + WS_MIX);
  *(uint4*)(MIX + (size_t)tok * 1024 + 768 + ch * 8) = o;
}

DEVI void sattn_item(const Params& P, int l, int isC, int item, unsigned char* smem) {
  const int tid = opaque_tid(), lane = tid & 63, t = tid >> 6;
  const int b = item >> 1, kvh = item & 1;
  float* qf = (float*)smem + t * 128;
  float* sb = (float*)smem + 512 + t * 784;
  const int row = SEQ + b * 4 + t;
  const u16* QKV = (const u16*)(P.ws + WS_QKV);
  const int nkeys = isC ? 387 : 128;
  const int buf = isC ? 2048 : 128;
  const float* cK = (isC ? P.in[I_CCK] : P.in[I_CAK]) + ((size_t)(l * 128 + b) * buf) * 128 + kvh * 64;
  const float* cV = (isC ? P.in[I_CCV] : P.in[I_CAV]) + ((size_t)(l * 128 + b) * buf) * 128 + kvh * 64;
  const float* nK = P.out + (isC ? OFF_SCK : OFF_SAK) + ((size_t)(l * 128 + b) * buf + (buf - 4)) * 128 + kvh * 64;
  const float* nV = P.out + (isC ? OFF_SCV : OFF_SAV) + ((size_t)(l * 128 + b) * buf + (buf - 4)) * 128 + kvh * 64;
#pragma unroll
  for (int hh = 0; hh < 2; ++hh)
    qf[hh * 64 + lane] = bf2f(QKV[(size_t)row * 1024 + (isC ? 512 : 0) + (kvh * 2 + hh) * 64 + lane]);
  __syncthreads();
  float m0 = -INFINITY, m1 = -INFINITY;
  for (int j = lane; j < nkeys; j += 64) {
    int idx;
    if (isC) { const int pi = j / 129, jj = j - pi * 129; const int d = (pi == 0) ? 1 : (pi == 1 ? 4 : 16); idx = 2048 + t - d * jj; }
    else idx = t + 1 + j;
    const float* kp = (idx < buf) ? cK + (size_t)idx * 128 : nK + (size_t)(idx - buf) * 128;
    float s0 = 0.f, s1 = 0.f;
#pragma unroll
    for (int c4 = 0; c4 < 16; ++c4) {
      const float4 kv = ((const float4*)kp)[c4];
      const float4 q0 = ((const float4*)qf)[c4], q1 = ((const float4*)(qf + 64))[c4];
      s0 += kv.x * q0.x + kv.y * q0.y + kv.z * q0.z + kv.w * q0.w;
      s1 += kv.x * q1.x + kv.y * q1.y + kv.z * q1.z + kv.w * q1.w;
    }
    s0 *= 0.125f; s1 *= 0.125f;
    sb[j] = s0; sb[392 + j] = s1;
    m0 = fmaxf(m0, s0); m1 = fmaxf(m1, s1);
  }
  m0 = wave_max(m0); m1 = wave_max(m1);
  float sk0 = 0.f, sk1 = 0.f;
  if (!isC) {
    sk0 = P.in[I_SINK][l * 4 + kvh * 2]; sk1 = P.in[I_SINK][l * 4 + kvh * 2 + 1];
    m0 = fmaxf(m0, sk0); m1 = fmaxf(m1, sk1);
  }
  float d0 = 0.f, d1 = 0.f;
  for (int j = lane; j < nkeys; j += 64) {
    const float e0 = __expf(sb[j] - m0), e1 = __expf(sb[392 + j] - m1);
    sb[j] = e0; sb[392 + j] = e1;
    d0 += e0; d1 += e1;
  }
  d0 = wave_sum(d0); d1 = wave_sum(d1);
  if (!isC) { d0 += __expf(sk0 - m0); d1 += __expf(sk1 - m1); }
  __syncthreads();
  const int g4 = lane >> 4, c4 = lane & 15;
  float a0[4] = {0.f, 0.f, 0.f, 0.f}, a1[4] = {0.f, 0.f, 0.f, 0.f};
  const int nsteps = (nkeys + 3) >> 2;
#pragma unroll 8
  for (int js = 0; js < nsteps; ++js) {
    const int jraw = js * 4 + g4;
    const int j = jraw < nkeys ? jraw : nkeys - 1;
    int idx;
    if (isC) { const int pi = j / 129, jj = j - pi * 129; const int d = (pi == 0) ? 1 : (pi == 1 ? 4 : 16); idx = 2048 + t - d * jj; }
    else idx = t + 1 + j;
    const float* vp = (idx < buf) ? cV + (size_t)idx * 128 : nV + (size_t)(idx - buf) * 128;
    const float4 v = ((const float4*)vp)[c4];
    const float p0 = jraw < nkeys ? sb[j] : 0.f, p1 = jraw < nkeys ? sb[392 + j] : 0.f;
    a0[0] += p0 * v.x; a0[1] += p0 * v.y; a0[2] += p0 * v.z; a0[3] += p0 * v.w;
    a1[0] += p1 * v.x; a1[1] += p1 * v.y; a1[2] += p1 * v.z; a1[3] += p1 * v.w;
  }
#pragma unroll
  for (int i = 0; i < 4; ++i) {
    a0[i] += __shfl_xor(a0[i], 16); a0[i] += __shfl_xor(a0[i], 32);
    a1[i] += __shfl_xor(a1[i], 16); a1[i] += __shfl_xor(a1[i], 32);
  }
  u16* MIX = (u16*)(P.ws + WS_MIX);
  const int mo = isC ? 768 : 512;
  if (g4 == 0) {
    const float i0 = 1.f / d0, i1 = 1.f / d1;
    uint2 w0, w1;
    w0.x = pack2(a0[0] * i0, a0[1] * i0); w0.y = pack2(a0[2] * i0, a0[3] * i0);
    w1.x = pack2(a1[0] * i1, a1[1] * i1); w1.y = pack2(a1[2] * i1, a1[3] * i1);
    *(uint2*)(MIX + (size_t)row * 1024 + mo + (kvh * 2) * 64 + c4 * 4) = w0;
    *(uint2*)(MIX + (size_t)row * 1024 + mo + (kvh * 2 + 1) * 64 + c4 * 4) = w1;
  }
  __syncthreads();
}

DEVI void smamba_item(const Params& P, int l, int item, unsigned char* smem) {
  const int tid = opaque_tid();
  const int b = item >> 3, h = item & 7, g = h >> 2;
  float* xa = (float*)smem;
  float* Ba = xa + 256;
  float* Ca = Ba + 512;
  const u16* XBC = (const u16*)(P.ws + WS_XBC);
  const float* DT = (const float*)(P.ws + WS_DT);
  const u16* Z = (const u16*)(P.ws + WS_Z);
  const int row0 = SEQ + b * 4;
  for (int ci = tid; ci < 320; ci += 256) {
    int ch; float* dst; int dl;
    if (ci < 64) { ch = h * 64 + ci; dst = xa + ci; dl = 64; }
    else if (ci < 192) { ch = 512 + g * 128 + (ci - 64); dst = Ba + (ci - 64); dl = 128; }
    else { ch = 768 + g * 128 + (ci - 192); dst = Ca + (ci - 192); dl = 128; }
    float sq[7];
#pragma unroll
    for (int j = 0; j < 3; ++j) sq[j] = P.in[I_SCONV][((size_t)(l * 128 + b) * 3 + j) * 1024 + ch];
#pragma unroll
    for (int j = 0; j < 4; ++j) sq[3 + j] = bf2f(XBC[(size_t)(row0 + j) * 1024 + ch]);
    const float w0 = P.in[I_CONVW][(l * 4 + 0) * 1024 + ch], w1 = P.in[I_CONVW][(l * 4 + 1) * 1024 + ch];
    const float w2 = P.in[I_CONVW][(l * 4 + 2) * 1024 + ch], w3 = P.in[I_CONVW][(l * 4 + 3) * 1024 + ch];
    const float bs = P.in[I_CONVB][l * 1024 + ch];
#pragma unroll
    for (int t = 0; t < 4; ++t) dst[t * dl] = siluf(bs + w0 * sq[t] + w1 * sq[t + 1] + w2 * sq[t + 2] + w3 * sq[t + 3]);
  }
  __syncthreads();
  const int p = tid >> 2, nq = tid & 3;
  float hs[32];
  const float* sp = P.in[I_SSM] + (((size_t)(l * 128 + b) * 8 + h) * 64 + p) * 128 + nq * 32;
#pragma unroll
  for (int i = 0; i < 8; ++i) {
    const float4 v = ((const float4*)sp)[i];
    hs[4 * i] = v.x; hs[4 * i + 1] = v.y; hs[4 * i + 2] = v.z; hs[4 * i + 3] = v.w;
  }
  const float dtb = P.in[I_DTB][l * 8 + h], aneg = -__expf(P.in[I_ALOG][l * 8 + h]), dsk = P.in[I_DSKIP][l * 8 + h];
  u16* MIX = (u16*)(P.ws + WS_MIX);
#pragma unroll
  for (int t = 0; t < 4; ++t) {
    const float dt = softplusf(DT[(size_t)(row0 + t) * 8 + h] + dtb);
    const float dA = __expf(aneg * dt);
    const float xv = xa[t * 64 + p];
    const float xdt = xv * dt;
    float yp = 0.f;
#pragma unroll
    for (int i = 0; i < 32; ++i) {
      hs[i] = hs[i] * dA + xdt * Ba[t * 128 + nq * 32 + i];
      yp += Ca[t * 128 + nq * 32 + i] * hs[i];
    }
    yp += __shfl_xor(yp, 1); yp += __shfl_xor(yp, 2);
    float y = yp + xv * dsk;
    y *= siluf(bf2f(Z[(size_t)(row0 + t) * 512 + h * 64 + p]));
    if (nq == 0) MIX[(size_t)(row0 + t) * 1024 + h * 64 + p] = f2bf(y);
  }
  float* op = P.out + OFF_SSSM + (((size_t)(l * 128 + b) * 8 + h) * 64 + p) * 128 + nq * 32;
#pragma unroll
  for (int i = 0; i < 8; ++i) ((float4*)op)[i] = make_float4(hs[4 * i], hs[4 * i + 1], hs[4 * i + 2], hs[4 * i + 3]);
  __syncthreads();
}

DEVI void ssd_dt_acum(const Params& P, int l, int c, int h, float* dtv, float* acum) {
  const int tid = opaque_tid(), lane = tid & 63;
  const float* DT = (const float*)(P.ws + WS_DT);
  const float aneg = -__expf(P.in[I_ALOG][l * 8 + h]);
  float a = 0.f;
  if (tid < 128) {
    const float dt = softplusf(DT[(size_t)(c * 128 + tid) * 8 + h] + P.in[I_DTB][l * 8 + h]);
    dtv[tid] = dt;
    a = aneg * dt;
  }
#pragma unroll
  for (int o = 1; o < 64; o <<= 1) {
    const float n = __shfl_up(a, o);
    if (lane >= o) a += n;
  }
  if (tid == 63) dtv[128] = a;
  __syncthreads();
  if (tid >= 64 && tid < 128) a += dtv[128];
  if (tid < 128) acum[tid] = a;
  __syncthreads();
}

template <class F>
DEVI void conv_rows(const Params& P, int l, int tok0, int n, int ch, F f) {
  const u16* XBC = (const u16*)(P.ws + WS_XBC);
  const float w0 = P.in[I_CONVW][(l * 4 + 0) * 1024 + ch], w1 = P.in[I_CONVW][(l * 4 + 1) * 1024 + ch];
  const float w2 = P.in[I_CONVW][(l * 4 + 2) * 1024 + ch], w3 = P.in[I_CONVW][(l * 4 + 3) * 1024 + ch];
  const float bs = P.in[I_CONVB][l * 1024 + ch];
  float x0 = (tok0 - 3 >= 0) ? bf2f(XBC[(size_t)(tok0 - 3) * 1024 + ch]) : 0.f;
  float x1 = (tok0 - 2 >= 0) ? bf2f(XBC[(size_t)(tok0 - 2) * 1024 + ch]) : 0.f;
  float x2 = (tok0 - 1 >= 0) ? bf2f(XBC[(size_t)(tok0 - 1) * 1024 + ch]) : 0.f;
  for (int b = 0; b < n; b += 32) {
    u16 raw[32];
#pragma unroll
    for (int t = 0; t < 32; ++t) raw[t] = XBC[(size_t)(tok0 + b + t) * 1024 + ch];
#pragma unroll
    for (int t = 0; t < 32; ++t) {
      const float x3 = bf2f(raw[t]);
      f(b + t, siluf(bs + w0 * x0 + w1 * x1 + w2 * x2 + w3 * x3));
      x0 = x1; x1 = x2; x2 = x3;
    }
  }
}

template <int N>
struct ConvBuf2 { unsigned raw[N + 3]; float wa[5], wb[5]; };
template <int N>
DEVI void conv2_load(const Params& P, int l, int tok0, int ch, ConvBuf2<N>& cb) {
  const u16* XBC = (const u16*)(P.ws + WS_XBC);
#pragma unroll
  for (int j = 0; j < 3; ++j) cb.raw[j] = (tok0 - 3 + j >= 0) ? *(const unsigned*)(XBC + (size_t)(tok0 - 3 + j) * 1024 + ch) : 0u;
#pragma unroll
  for (int t = 0; t < N; ++t) cb.raw[3 + t] = *(const unsigned*)(XBC + (size_t)(tok0 + t) * 1024 + ch);
#pragma unroll
  for (int j = 0; j < 4; ++j) {
    cb.wa[j] = P.in[I_CONVW][(l * 4 + j) * 1024 + ch];
    cb.wb[j] = P.in[I_CONVW][(l * 4 + j) * 1024 + ch + 1];
  }
  cb.wa[4] = P.in[I_CONVB][l * 1024 + ch];
  cb.wb[4] = P.in[I_CONVB][l * 1024 + ch + 1];
}
template <int N, class F>
DEVI void conv2_apply(const ConvBuf2<N>& cb, F f) {
#pragma unroll
  for (int t = 0; t < N; ++t) {
    const float va = siluf(cb.wa[4] + cb.wa[0] * bflo(cb.raw[t]) + cb.wa[1] * bflo(cb.raw[t + 1]) + cb.wa[2] * bflo(cb.raw[t + 2]) + cb.wa[3] * bflo(cb.raw[t + 3]));
    const float vb = siluf(cb.wb[4] + cb.wb[0] * bfhi(cb.raw[t]) + cb.wb[1] * bfhi(cb.raw[t + 1]) + cb.wb[2] * bfhi(cb.raw[t + 2]) + cb.wb[3] * bfhi(cb.raw[t + 3]));
    f(t, va, vb);
  }
}

DEVI void ssd_cs_item(const Params& P, int l, int item, unsigned char* smem) {
  const int tid = opaque_tid(), lane = tid & 63, w = tid >> 6, fr = lane & 15, fq = lane >> 4;
  const int c = item >> 3, h = item & 7, g = h >> 2;
  u16* xT = (u16*)smem;
  u16* BT = (u16*)(smem + 17408);
  float* acum = (float*)(smem + 17408 + 34816);
  float* dtv = acum + 128;
  ConvBuf2<16> cX;
  ConvBuf2<32> cB;
  conv2_load<16>(P, l, c * 128 + (tid >> 5) * 16, h * 64 + 2 * (tid & 31), cX);
  conv2_load<32>(P, l, c * 128 + (tid >> 6) * 32, 512 + g * 128 + 2 * (tid & 63), cB);
  ssd_dt_acum(P, l, c, h, dtv, acum);
  const float aend = acum[127];
  {
    const int cp = tid & 31, rg = tid >> 5;
    conv2_apply<16>(cX, [&](int t, float va, float vb) {
      const int s = rg * 16 + t;
      const float e = dtv[s] * __expf(aend - acum[s]);
      xT[(2 * cp) * 136 + s] = f2bf(va * e);
      xT[(2 * cp + 1) * 136 + s] = f2bf(vb * e);
    });
  }
  {
    const int cp = tid & 63, rg = tid >> 6;
    conv2_apply<32>(cB, [&](int t, float va, float vb) {
      BT[(2 * cp) * 136 + rg * 32 + t] = f2bf(va);
      BT[(2 * cp + 1) * 136 + rg * 32 + t] = f2bf(vb);
    });
  }
  __syncthreads();
  float* CS = (float*)(P.ws + WS_CS) + (size_t)(c * 8 + h) * 8192;
  bf16x8 xa[4];
#pragma unroll
  for (int ks = 0; ks < 4; ++ks) xa[ks] = *(const bf16x8*)(xT + (w * 16 + fr) * 136 + ks * 32 + fq * 8);
#pragma unroll
  for (int nb = 0; nb < 8; ++nb) {
    f32x4 a = (f32x4){0.f, 0.f, 0.f, 0.f};
#pragma unroll
    for (int ks = 0; ks < 4; ++ks) {
      const bf16x8 bfg = *(const bf16x8*)(BT + (nb * 16 + fr) * 136 + ks * 32 + fq * 8);
      a = mfma16(xa[ks], bfg, a);
    }
#pragma unroll
    for (int r = 0; r < 4; ++r) CS[(w * 16 + fq * 4 + r) * 128 + nb * 16 + fr] = a[r];
  }
  if (tid == 0) ((float*)(P.ws + WS_CD))[c * 8 + h] = __expf(aend);
  __syncthreads();
}

DEVI void ssd_scan_item(const Params& P, int l, int item) {
  const int e = item * 256 + threadIdx.x;
  const int h = e >> 13;
  const float* CS = (const float*)(P.ws + WS_CS);
  const float* CD = (const float*)(P.ws + WS_CD);
  u16* HIN = (u16*)(P.ws + WS_HIN);
  float hc = 0.f;
#pragma unroll 32
  for (int c = 0; c < 128; ++c) {
    HIN[(size_t)c * 65536 + e] = f2bf(hc);
    hc = hc * CD[c * 8 + h] + CS[(size_t)c * 65536 + e];
  }
  P.out[OFF_PSSM + (size_t)l * 65536 + e] = hc;
}

DEVI void ssd_y_item(const Params& P, int l, int item, unsigned char* smem) {
  const int tid = opaque_tid(), lane = tid & 63, w = tid >> 6, fr = lane & 15, fq = lane >> 4;
  const int half = item & 1, h = (item >> 1) & 7, c = item >> 4, g = h >> 2;
  const int l0 = half * 64;
  u16* Cs = (u16*)smem;
  u16* Hs = (u16*)(smem + 17408);
  u16* Bs = (u16*)(smem + 34816);
  float* acum = (float*)(smem + 69632);
  float* dtv = acum + 128;
  u16* Gs = Hs;
  u16* xT = Bs;
  ConvBuf2<16> cC, cX;
  ConvBuf2<32> cB;
  u32x4 hin[4];
  conv2_load<16>(P, l, c * 128 + l0 + (tid >> 6) * 16, 768 + g * 128 + 2 * (tid & 63), cC);
  conv2_load<32>(P, l, c * 128 + (tid >> 6) * 32, 512 + g * 128 + 2 * (tid & 63), cB);
  conv2_load<16>(P, l, c * 128 + (tid >> 5) * 16, h * 64 + 2 * (tid & 31), cX);
  {
    const u16* HIN = (const u16*)(P.ws + WS_HIN) + (size_t)(c * 8 + h) * 8192;
    const int r = tid >> 2, cq = (tid & 3) * 32;
#pragma unroll
    for (int i = 0; i < 4; ++i) hin[i] = *(const u32x4*)(HIN + r * 128 + cq + i * 8);
  }
  ssd_dt_acum(P, l, c, h, dtv, acum);
  {
    const int cp = tid & 63, rg = tid >> 6;
    conv2_apply<16>(cC, [&](int t, float va, float vb) {
      *(unsigned*)(Cs + (rg * 16 + t) * 136 + 2 * cp) = pack2(va, vb);
    });
    conv2_apply<32>(cB, [&](int t, float va, float vb) {
      *(unsigned*)(Bs + (rg * 32 + t) * 136 + 2 * cp) = pack2(va, vb);
    });
    const int r = tid >> 2, cq = (tid & 3) * 32;
#pragma unroll
    for (int i = 0; i < 4; ++i) *(u32x4*)(Hs + r * 136 + cq + i * 8) = hin[i];
  }
  __syncthreads();
  f32x4 y[4];
  f32x4 cb[8];
  {
    bf16x8 ca[4];
#pragma unroll
    for (int ks = 0; ks < 4; ++ks) ca[ks] = *(const bf16x8*)(Cs + (w * 16 + fr) * 136 + ks * 32 + fq * 8);
#pragma unroll
    for (int nb = 0; nb < 4; ++nb) {
      f32x4 a = (f32x4){0.f, 0.f, 0.f, 0.f};
#pragma unroll
      for (int ks = 0; ks < 4; ++ks) a = mfma16(ca[ks], *(const bf16x8*)(Hs + (nb * 16 + fr) * 136 + ks * 32 + fq * 8), a);
      y[nb] = a;
    }
#pragma unroll
    for (int sbk = 0; sbk < 8; ++sbk) {
      f32x4 a = (f32x4){0.f, 0.f, 0.f, 0.f};
#pragma unroll
      for (int ks = 0; ks < 4; ++ks) a = mfma16(ca[ks], *(const bf16x8*)(Bs + (sbk * 16 + fr) * 136 + ks * 32 + fq * 8), a);
      cb[sbk] = a;
    }
  }
  float al[4];
#pragma unroll
  for (int r = 0; r < 4; ++r) al[r] = acum[l0 + w * 16 + fq * 4 + r];
  __syncthreads();
#pragma unroll
  for (int sbk = 0; sbk < 8; ++sbk) {
    const int s = sbk * 16 + fr;
    const float as = acum[s];
#pragma unroll
    for (int r = 0; r < 4; ++r) {
      const int ll = l0 + w * 16 + fq * 4 + r;
      const float gval = (s <= ll) ? cb[sbk][r] * __expf(al[r] - as) : 0.f;
      Gs[(w * 16 + fq * 4 + r) * 136 + s] = f2bf(gval);
    }
  }
  {
    const int cp = tid & 31, rg = tid >> 5;
    conv2_apply<16>(cX, [&](int t, float va, float vb) {
      const int s = rg * 16 + t;
      xT[(2 * cp) * 136 + s] = f2bf(va * dtv[s]);
      xT[(2 * cp + 1) * 136 + s] = f2bf(vb * dtv[s]);
    });
  }
  __syncthreads();
  f32x4 yd[4];
#pragma unroll
  for (int nb = 0; nb < 4; ++nb) yd[nb] = (f32x4){0.f, 0.f, 0.f, 0.f};
#pragma unroll
  for (int ks = 0; ks < 4; ++ks) {
    const bf16x8 ga = *(const bf16x8*)(Gs + (w * 16 + fr) * 136 + ks * 32 + fq * 8);
#pragma unroll
    for (int nb = 0; nb < 4; ++nb) yd[nb] = mfma16(ga, *(const bf16x8*)(xT + (nb * 16 + fr) * 136 + ks * 32 + fq * 8), yd[nb]);
  }
  const float dsk = P.in[I_DSKIP][l * 8 + h];
  const u16* Z = (const u16*)(P.ws + WS_Z);
  u16* MIX = (u16*)(P.ws + WS_MIX);
#pragma unroll
  for (int r = 0; r < 4; ++r) {
    const int ll = l0 + w * 16 + fq * 4 + r;
    const size_t tok = (size_t)c * 128 + ll;
    const float idt = 1.f / dtv[ll];
    const float eal = __expf(al[r]);
#pragma unroll
    for (int nb = 0; nb < 4; ++nb) {
      const int p = nb * 16 + fr;
      float yv = yd[nb][r] + y[nb][r] * eal + bf2f(xT[p * 136 + ll]) * idt * dsk;
      yv *= siluf(bf2f(Z[tok * 512 + h * 64 + p]));
      MIX[tok * 1024 + h * 64 + p] = f2bf(yv);
    }
  }
  __syncthreads();
}

DEVI void mixnorm_item(const Params& P, int item) {
  const int tid = opaque_tid(), lane = tid & 63, w = tid >> 6;
  const int row = item * 4 + w;
  u16* MIX = (u16*)(P.ws + WS_MIX) + (size_t)row * 1024 + lane * 8;
  const uint4 v = *(const uint4*)MIX;
  float f[8] = {bflo(v.x), bfhi(v.x), bflo(v.y), bfhi(v.y), bflo(v.z), bfhi(v.z), bflo(v.w), bfhi(v.w)};
  float s = 0.f;
#pragma unroll
  for (int i = 0; i < 8; ++i) s += f[i] * f[i];
  s = wave_sum(s);
  const float sc = rsqrtf(s * (1.f / 512.f) + EPS);
  uint4 o;
  o.x = pack2(f[0] * sc, f[1] * sc); o.y = pack2(f[2] * sc, f[3] * sc);
  o.z = pack2(f[4] * sc, f[5] * sc); o.w = pack2(f[6] * sc, f[7] * sc);
  *(uint4*)MIX = o;
}

DEVI void copy_item(const Params& P, int l, int item) {
  const float* src; float* dst; int n4;
  int s4;
  if (item < 4096) {
    const int part = item & 15, kv = (item >> 4) & 1, b = item >> 5;
    const size_t base = (size_t)(l * 128 + b) * 262144;
    src = (kv ? P.in[I_CCV] : P.in[I_CCK]) + base + 512;
    dst = P.out + (kv ? OFF_SCV : OFF_SCK) + base;
    s4 = part * 4096;
    n4 = min(4096, 65408 - s4);
  } else {
    const int it = item - 4096;
    const int kv = it & 1, b = it >> 1;
    const size_t base = (size_t)(l * 128 + b) * 16384;
    src = (kv ? P.in[I_CAV] : P.in[I_CAK]) + base + 512;
    dst = P.out + (kv ? OFF_SAV : OFF_SAK) + base;
    s4 = 0; n4 = 3968;
  }
  const f32x4* s = (const f32x4*)src + s4;
  f32x4* d = (f32x4*)dst + s4;
  const int t = threadIdx.x;
  f32x4 v[16];
#pragma unroll
  for (int i = 0; i < 16; ++i)
    if (i * 256 + t < n4) v[i] = __builtin_nontemporal_load(s + i * 256 + t);
#pragma unroll
  for (int i = 0; i < 16; ++i)
    if (i * 256 + t < n4) __builtin_nontemporal_store(v[i], d + i * 256 + t);
}

DEVI void copy_ptrs(const Params& P, int l, int item, const f32x4*& s, f32x4*& d, int& n4) {
  if (item < 4096) {
    const int part = item & 15, kv = (item >> 4) & 1, b = item >> 5;
    const size_t base = (size_t)(l * 128 + b) * 262144;
    s = (const f32x4*)((kv ? P.in[I_CCV] : P.in[I_CCK]) + base + 512) + part * 4096;
    d = (f32x4*)(P.out + (kv ? OFF_SCV : OFF_SCK) + base) + part * 4096;
    n4 = min(4096, 65408 - part * 4096);
  } else {
    const int it = item - 4096;
    const int kv = it & 1, b = it >> 1;
    const size_t base = (size_t)(l * 128 + b) * 16384;
    s = (const f32x4*)((kv ? P.in[I_CAV] : P.in[I_CAK]) + base + 512);
    d = (f32x4*)(P.out + (kv ? OFF_SAV : OFF_SAK) + base);
    n4 = 3968;
  }
}

struct GBar { unsigned* bar; unsigned epoch; unsigned x; unsigned nloc; unsigned nx; };
DEVI unsigned bar_ld(unsigned* p) { return __hip_atomic_load(p, __ATOMIC_RELAXED, __HIP_MEMORY_SCOPE_AGENT); }
DEVI unsigned bar_add(unsigned* p, unsigned v) { return __hip_atomic_fetch_add(p, v, __ATOMIC_RELAXED, __HIP_MEMORY_SCOPE_AGENT); }
DEVI void gsync_flat(GBar& g) {
  asm volatile("s_waitcnt vmcnt(0) lgkmcnt(0)" ::: "memory");
  __syncthreads();
  if (threadIdx.x == 0) {
    __builtin_amdgcn_fence(__ATOMIC_RELEASE, "agent");
    asm volatile("s_waitcnt vmcnt(0)" ::: "memory");
    bar_add(g.bar, 1u);
    while (bar_ld(g.bar) < gridDim.x) __builtin_amdgcn_s_sleep(2);
    __builtin_amdgcn_fence(__ATOMIC_ACQUIRE, "agent");
    asm volatile("s_waitcnt vmcnt(0)" ::: "memory");
  }
  __syncthreads();
}
DEVI void gsync(GBar& g) {
  asm volatile("s_waitcnt vmcnt(0) lgkmcnt(0)" ::: "memory");
  __syncthreads();
  g.epoch++;
  if (threadIdx.x == 0) {
    const unsigned old = bar_add(g.bar + 32 * (1 + g.x), 1u);
    if (old == g.epoch * g.nloc - 1u) {
      __builtin_amdgcn_fence(__ATOMIC_RELEASE, "agent");
      asm volatile("s_waitcnt vmcnt(0)" ::: "memory");
      bar_add(g.bar + 32 * 9, 1u);
    }
    const unsigned target = g.epoch * g.nx;
    while (bar_ld(g.bar + 32 * 9) < target) __builtin_amdgcn_s_sleep(1);
    __builtin_amdgcn_fence(__ATOMIC_ACQUIRE, "agent");
    asm volatile("s_waitcnt vmcnt(0)" ::: "memory");
  }
  __syncthreads();
}

__global__ void __launch_bounds__(256, 2) hymba_megakernel(Params P) {
  extern __shared__ __attribute__((aligned(16))) unsigned char smem[];
  cg::grid_group cgrid = cg::this_grid();
  GBar grid; grid.bar = (unsigned*)(P.ws + WS_BAR); grid.epoch = 0;
  grid.x = (unsigned)__builtin_amdgcn_s_getreg((3 << 11) | 20) & 7u;
  if (threadIdx.x == 0) bar_add(grid.bar + 32 * 10 + grid.x, 1u);
  const int nb = gridDim.x, bid = blockIdx.x;
  const int vbid = ((nb & 7) == 0) ? (bid & 7) * (nb >> 3) + (bid >> 3) : bid;
  unsigned char* ws = P.ws;

#ifdef NANFILL
  {
    uint4* w4 = (uint4*)ws;
    const size_t n4 = WS_END / 16;
    const uint4 pat = make_uint4(0xffffffffu, 0xffffffffu, 0xffffffffu, 0xffffffffu);
    for (size_t i = (size_t)bid * 256 + threadIdx.x; i < n4; i += (size_t)nb * 256) w4[i] = pat;
    for (int i = threadIdx.x; i < LDS_BYTES / 16; i += 256) ((uint4*)smem)[i] = pat;
  }
  gsync(grid);
#endif
  {
    const int NW = 2 * 3040, NX = 2112, NR = 513;
    for (int it = bid; it < NW + NX + NR; it += nb) {
      if ((PHM & 1) && it < NW) {
        const int l = it / 3040;
        int r = it % 3040;
        if (r < 672) wconv_item(P, 0, l, r / 42, r % 42, smem);
        else if ((r -= 672) < 256) wconv_item(P, 1, l, r / 16, r % 16, smem);
        else if ((r -= 256) < 704) wconv_item(P, 2, l, r / 44, r % 44, smem);
        else if ((r -= 704) < 704) wconv_item(P, 3, l, r / 44, r % 44, smem);
        else { r -= 704; wconv_item(P, 4, l, r / 16, r % 16, smem); }
      } else if (it < NW + NX) { if (PHM & 2) xconv_item(P, it - NW); }
      else if (PHM & 2) rope_item(P, it - NW - NX);
    }
  }
  asm volatile("s_waitcnt vmcnt(0) lgkmcnt(0)" ::: "memory");
  __syncthreads();
  cgrid.sync();
  if (threadIdx.x == 0) __builtin_amdgcn_fence(__ATOMIC_ACQUIRE, "agent");
  asm volatile("s_waitcnt vmcnt(0)" ::: "memory");
  __syncthreads();
  {
    unsigned nx = 0;
#pragma unroll
    for (int i = 0; i < 8; ++i) nx += (bar_ld(grid.bar + 32 * 10 + i) != 0u) ? 1u : 0u;
    grid.nx = nx;
    grid.nloc = bar_ld(grid.bar + 32 * 10 + grid.x);
  }

#ifdef DELAYTEST
  {
    const unsigned long long t0 = wall_clock64();
    while (wall_clock64() - t0 < 200000ull) __builtin_amdgcn_s_sleep(8);
    __syncthreads();
    if (threadIdx.x == 0) __builtin_amdgcn_fence(__ATOMIC_ACQUIRE, "agent");
    asm volatile("s_waitcnt vmcnt(0)" ::: "memory");
    __syncthreads();
  }
#endif
#ifdef E2TEST
  {
    const u16* AHp = (const u16*)(ws + WS_AH);
    const u16* WTp = (const u16*)(ws + WS_WIN);
    for (size_t i = (size_t)bid * 256 + threadIdx.x; i < (size_t)NT * 1024; i += (size_t)nb * 256) P.out[OFF_Y + i] = bf2f(AHp[i]) * 1.2345678f + 0.1f;
    for (size_t i = (size_t)bid * 256 + threadIdx.x; i < (size_t)2 * NINP * 1024; i += (size_t)nb * 256) P.out[OFF_SCK + i] = bf2f(WTp[i]) * 1.2345678f + 0.001f;
    return;
  }
#endif
#pragma unroll 1
  for (int l = 0; l < 2; ++l) {
    {
      const u16* A = (const u16*)(ws + WS_AH);
      const u16* Bt = (const u16*)(ws + WS_WIN) + (size_t)l * NINP * 1024;
      for (int t = vbid; t < 132 * 21; t += nb) {
        const int rt = t / 21, ct = t % 21;
        if (PHM & 4) gemm_tile<EPI_IN>(P, l, A, 1024, Bt, 1024, 1024, XKS, rt * 128, ct * 128, smem);
      }
    }
    gsync(grid);
    if (STOPAT == 1) return;
    {
      const int N_SC = 256, N_SA = 256, N_AT = 4096, N_CS = 1024, N_SM = 1024, N_CP = 1952;
      const int tot = N_SC + N_SA + N_AT + N_CS + N_SM + N_CP;
      for (int it = bid; it < tot; it += nb) {
        int r = it;
        int lq = l;
        asm volatile("" : "+s"(lq));
        if (r < N_SC) { if (PHM & 8) sattn_item(P, lq, 1, r, smem); }
        else if ((r -= N_SC) < N_SA) { if (PHM & 8) sattn_item(P, lq, 0, r, smem); }
        else if ((r -= N_SA) < N_AT) { if (PHM & 16) attn_item(P, lq, r >> 10, r & 1023, smem); }
        else if ((r -= N_AT) < N_CS) { if (PHM & 32) ssd_cs_item(P, lq, r, smem); }
        else if ((r -= N_CS) < N_SM) { if (PHM & 64) smamba_item(P, lq, r, smem); }
        else { r -= N_SM; if (PHM & 128) copy_item(P, lq, r); }
      }
    }
    gsync(grid);
    if (STOPAT == 2) return;
    {
      for (int it = bid; it < 256 + 2048 + 800; it += nb) {
        if (it < 256) { if (PHM & 256) ssd_scan_item(P, l, it); }
        else if (it < 2304) { if (PHM & 256) cmerge_item(P, it - 256); }
        else copy_item(P, l, 1952 + (it - 2304));
      }
    }
    gsync(grid);
    if (STOPAT == 3) return;
    for (int k = 0;; ++k) {
      const int yi = bid + k * nb, ci = 2752 + bid + k * nb;
      if (yi >= 2048 && ci >= 4352) break;
      if (yi < 2048) ssd_y_item(P, l, yi, smem);
      if (ci < 4352) copy_item(P, l, ci);
    }
    gsync(grid);
    for (int it = bid; it < NT / 4; it += nb) mixnorm_item(P, it);
    gsync(grid);
    if (STOPAT == 4) return;
    {
      const u16* A = (const u16*)(ws + WS_MIX);
      const u16* Bt = (const u16*)(ws + WS_WOUT) + (size_t)l * 1024 * 1024;
      for (int t = vbid; t < 132 * 8; t += nb) {
        const int rt = t / 8, ct = t % 8;
        if (PHM & 1024) gemm_tile<EPI_OUT>(P, l, A, 1024, Bt, 1024, 1024, 0, rt * 128, ct * 128, smem);
      }
    }
    gsync(grid);
    if (STOPAT == 5) return;
    {
      const u16* A = (const u16*)(ws + WS_AH1);
      const u16* Bt = (const u16*)(ws + WS_WGU) + (size_t)l * 5632 * 1024;
      const int NCP = 0, NTL = 132 * 44;
      for (int it = vbid; it < NTL + NCP; it += nb) {
        int t;
        if (it < 2 * NCP) {
          if (!(it & 1)) { copy_item(P, l, it >> 1); continue; }
          t = it >> 1;
        } else t = it - NCP;
        const int rt = t / 44, ct = t % 44;
        if (PHM & 2048) gemm_tile<EPI_GU>(P, l, A, 1024, Bt, 1024, 1024, 1024, rt * 128, ct * 128, smem);
      }
    }
    gsync(grid);
    if (STOPAT == 6) return;
    {
      const u16* A = (const u16*)(ws + WS_G);
      const u16* Bt = (const u16*)(ws + WS_WDN) + (size_t)l * 1024 * DFF;
      for (int t = vbid; t < 132 * 8; t += nb) {
        const int rt = t / 8, ct = t % 8;
        if (PHM & 4096) gemm_tile<EPI_DN>(P, l, A, DFF, Bt, DFF, DFF, 0, rt * 128, ct * 128, smem);
      }
    }
    if (l == 0) gsync(grid);
  }
}

extern "C" void kernel_launch(void* const* d_in, const int* in_sizes, int n_in, void* d_out, int out_size, void* d_ws,
                              size_t ws_size, hipStream_t stream) {
  static int grid_blocks = 0;
  if (!grid_blocks) {
    int dev = 0, cus = 0, per_cu = 0;
    (void)hipGetDevice(&dev);
    (void)hipDeviceGetAttribute(&cus, hipDeviceAttributeMultiprocessorCount, dev);
    (void)hipFuncSetAttribute((const void*)hymba_megakernel, hipFuncAttributeMaxDynamicSharedMemorySize, LDS_BYTES);
    (void)hipOccupancyMaxActiveBlocksPerMultiprocessor(&per_cu, hymba_megakernel, 256, LDS_BYTES);
    if (per_cu < 1) per_cu = 1;
    if (per_cu > 2) per_cu = 2;
    grid_blocks = cus * per_cu;
  }
  Params p{};
  for (int i = 0; i < 26; ++i) p.in[i] = (const float*)d_in[i];
  p.out = (float*)d_out;
  p.ws = (unsigned char*)d_ws;
  (void)hipMemsetAsync((unsigned char*)d_ws + WS_BAR, 0, 2048, stream);
  void* args[] = {&p};
  hipError_t e = hipLaunchCooperativeKernel((void*)hymba_megakernel, dim3(grid_blocks), dim3(256), args, LDS_BYTES, stream);
  if (e != hipSuccess) fprintf(stderr, "cooperative launch failed: %s (grid %d)\n", hipGetErrorString(e), grid_blocks);
}
```
